# Optimizing an MI355X kernel written in HIP

```python
import jax, jax.numpy as jnp
from jax import lax
import numpy as np

D_MODEL = 1024
BATCH = 8
SEQ = 4096
DEPTH = 2
DEC_BATCH = 32
DEC_SEQ = 32
PAST_LEN = 4096

CHUNK = 64
N_EVEN = (DEPTH + 1) // 2
N_ODD = DEPTH // 2
MIX_WIDTH = D_MODEL
SB_WIDTH = MIX_WIDTH // 2
SB_HEAD_DIM = 64
N_SB_HEADS = SB_WIDTH // SB_HEAD_DIM
SB_SCALE = SB_HEAD_DIM ** -0.5
Q_BLOCK = 128
D_RNN = MIX_WIDTH // 2
N_LRU_BLOCKS = 8
LRU_BLOCK = D_RNN // N_LRU_BLOCKS
CONV_W = 4
LRU_C = 8.0
IN_WIDTH = 3 * SB_WIDTH + 2 * D_RNN
POOL_WINDOWS = (2, 4, 8, 16)
N_POOL_GROUPS = len(POOL_WINDOWS)
POOL_GROUP = D_MODEL // N_POOL_GROUPS
POOL_BUF = max(POOL_WINDOWS) - 1
D_FF = -(-8 * D_MODEL // (3 * 256)) * 256
EPS = 1e-6

kernel_name = "stickbreak_rglru_pool_streaming_step"


def rmsnorm(x, g):
    xf = x.astype(jnp.float32)
    y = xf * lax.rsqrt(jnp.mean(xf * xf, axis=-1, keepdims=True) + EPS)
    return (y * g.astype(jnp.float32)).astype(x.dtype)


def swiglu(x, w_gate, w_up, w_down):
    return (jax.nn.silu(x @ w_gate) * (x @ w_up)) @ w_down


def sb_block(q, k, v, q_pos, k_pos):
    z = jnp.einsum('bqhd,bkhd->bhqk', q, k).astype(jnp.float32) * SB_SCALE
    before = (k_pos[None, :] < q_pos[:, None])[None, None]
    log_not = jnp.where(before, jax.nn.log_sigmoid(-z), 0.0)
    between = lax.cumsum(log_not, axis=3, reverse=True) - log_not
    w = jnp.where(before, jnp.exp(jax.nn.log_sigmoid(z) + between), 0.0)
    return jnp.einsum('bhqk,bkhd->bqhd', w.astype(v.dtype), v)


def sb_prompt(q, k, v):
    b, s = q.shape[0], q.shape[1]
    nb = s // Q_BLOCK
    qb = q.reshape(b, nb, Q_BLOCK, N_SB_HEADS, SB_HEAD_DIM).swapaxes(0, 1)
    pos_b = jnp.arange(s).reshape(nb, Q_BLOCK)
    k_pos = jnp.arange(s)
    out = lax.map(lambda a: sb_block(a[0], k, v, a[1], k_pos), (qb, pos_b))
    return out.swapaxes(0, 1).reshape(b, s, N_SB_HEADS, SB_HEAD_DIM)


def causal_conv(u, buf, w, b):
    t = u.shape[1]
    up = jnp.concatenate([buf.astype(u.dtype), u], axis=1)
    y = b + sum(up[:, i:i + t] * w[i] for i in range(CONV_W))
    return y, up[:, -(CONV_W - 1):]


def rg_lru(u, h0, rg_w, rg_b, ig_w, ig_b, lam):
    b, t, _ = u.shape
    ub = u.reshape(b, t, N_LRU_BLOCKS, LRU_BLOCK)
    r = jax.nn.sigmoid(jnp.einsum('btnc,ncd->btnd', ub, rg_w).reshape(b, t, D_RNN) + rg_b)
    i = jax.nn.sigmoid(jnp.einsum('btnc,ncd->btnd', ub, ig_w).reshape(b, t, D_RNN) + ig_b)
    log_a = (-LRU_C * r * jax.nn.softplus(-lam)).astype(jnp.float32)
    a = jnp.exp(log_a)
    x_in = jnp.sqrt(-jnp.expm1(2.0 * log_a)) * (i * u).astype(jnp.float32)

    def combine(left, right):
        a1, b1 = left
        a2, b2 = right
        return a1 * a2, a2 * b1 + b2

    a_cum, h_zero = lax.associative_scan(combine, (a, x_in), axis=1)
    h = h_zero + a_cum * h0[:, None].astype(jnp.float32)
    return h.astype(u.dtype), h[:, -1].astype(u.dtype)


def hybrid_mixer(xn, past_k, past_v, h0, conv_buf, w_in, conv_w, conv_b, rg_w, rg_b, ig_w, ig_b, lam, w_out):
    b, t, _ = xn.shape
    proj = xn @ w_in
    q, k, v, u, g = jnp.split(proj, [SB_WIDTH, 2 * SB_WIDTH, 3 * SB_WIDTH, 3 * SB_WIDTH + D_RNN], axis=-1)
    q = q.reshape(b, t, N_SB_HEADS, SB_HEAD_DIM)
    k = k.reshape(b, t, N_SB_HEADS, SB_HEAD_DIM)
    v = v.reshape(b, t, N_SB_HEADS, SB_HEAD_DIM)
    if past_k is None:
        attn = sb_prompt(q, k, v)
    else:
        p = past_k.shape[1]
        k_all = jnp.concatenate([past_k.astype(k.dtype), k], axis=1)
        v_all = jnp.concatenate([past_v.astype(v.dtype), v], axis=1)
        attn = sb_block(q, k_all, v_all, p + jnp.arange(t), jnp.arange(p + t))
    uc, conv_new = causal_conv(u, conv_buf, conv_w, conv_b)
    h, h_last = rg_lru(uc, h0, rg_w, rg_b, ig_w, ig_b, lam)
    lru_out = h * jax.nn.gelu(g)
    y = jnp.concatenate([attn.reshape(b, t, SB_WIDTH), lru_out], axis=-1) @ w_out
    return y.astype(xn.dtype), k, v, h_last, conv_new


def pool_mixer(xn, buf, start_pos, pool_w, pool_scale):
    b, t, _ = xn.shape
    xcat = jnp.concatenate([buf.astype(xn.dtype), xn], axis=1)
    xf = xcat.astype(jnp.float32)
    cs = jnp.concatenate([jnp.zeros((b, 1, D_MODEL), jnp.float32), jnp.cumsum(xf, axis=1)], axis=1)
    pos = start_pos + jnp.arange(t)
    outs = []
    for gi, win in enumerate(POOL_WINDOWS):
        sl = slice(gi * POOL_GROUP, (gi + 1) * POOL_GROUP)
        end = cs[:, POOL_BUF + 1:POOL_BUF + 1 + t, sl]
        begin = cs[:, POOL_BUF + 1 - win:POOL_BUF + 1 - win + t, sl]
        cnt = jnp.minimum(win, pos + 1).astype(jnp.float32)[None, :, None]
        outs.append((end - begin) / cnt - xf[:, POOL_BUF:, sl])
    d = jnp.stack(outs, axis=2)
    y = jnp.einsum('btgc,gcd->btgd', d, pool_w.astype(jnp.float32)).reshape(b, t, D_MODEL)
    y = y * pool_scale.astype(jnp.float32)
    return y.astype(xn.dtype), xcat[:, -POOL_BUF:]


def trunk(x, past_k, past_v, h0, conv0, pool0, start_pos,
          hyb_w_in, hyb_conv_w, hyb_conv_b, hyb_rg_w, hyb_rg_b, hyb_ig_w, hyb_ig_b, hyb_lambda, hyb_w_out,
          pool_w, pool_scale, norm_mix, norm_ffn, ffn_gate, ffn_up, ffn_down, norm_final):
    ks, vs, hs, cs, ps = [], [], [], [], []
    for layer in range(DEPTH):
        j = layer // 2
        xn = rmsnorm(x, norm_mix[layer])
        if layer % 2 == 0:
            pk = None if past_k is None else past_k[j]
            pv = None if past_v is None else past_v[j]
            y, k_new, v_new, h_new, c_new = hybrid_mixer(
                xn, pk, pv, h0[j], conv0[j], hyb_w_in[j], hyb_conv_w[j], hyb_conv_b[j],
                hyb_rg_w[j], hyb_rg_b[j], hyb_ig_w[j], hyb_ig_b[j], hyb_lambda[j], hyb_w_out[j])
            ks.append(k_new)
            vs.append(v_new)
            hs.append(h_new)
            cs.append(c_new)
        else:
            y, p_new = pool_mixer(xn, pool0[j], start_pos, pool_w[j], pool_scale[j])
            ps.append(p_new)
        x = x + y
        x = x + swiglu(rmsnorm(x, norm_ffn[layer]), ffn_gate[layer], ffn_up[layer], ffn_down[layer]).astype(x.dtype)
    return (rmsnorm(x, norm_final), jnp.stack(ks), jnp.stack(vs), jnp.stack(hs), jnp.stack(cs), jnp.stack(ps))


def setup_inputs(seed: int = 0) -> dict:
    key = jax.random.key(seed)
    ks = jax.random.split(key, 32)

    def nrm(k, shape, scale=1.0):
        return jax.random.normal(k, shape, jnp.float32) * scale

    a0 = jax.random.uniform(ks[14], (N_EVEN, D_RNN), jnp.float32, minval=0.9, maxval=0.999) ** (1.0 / LRU_C)
    return {
        "x_prompt": nrm(ks[0], (BATCH, SEQ, D_MODEL)),
        "x_sample": nrm(ks[1], (DEC_BATCH, DEC_SEQ, D_MODEL)),
        "cache_sb_k": nrm(ks[2], (N_EVEN, DEC_BATCH, PAST_LEN, N_SB_HEADS, SB_HEAD_DIM)),
        "cache_sb_v": nrm(ks[3], (N_EVEN, DEC_BATCH, PAST_LEN, N_SB_HEADS, SB_HEAD_DIM)),
        "state_lru_h": nrm(ks[4], (N_EVEN, DEC_BATCH, D_RNN), 0.5),
        "state_lru_conv": nrm(ks[5], (N_EVEN, DEC_BATCH, CONV_W - 1, D_RNN)),
        "state_pool": nrm(ks[6], (N_ODD, DEC_BATCH, POOL_BUF, D_MODEL)),
        "hyb_w_in": nrm(ks[7], (N_EVEN, D_MODEL, IN_WIDTH), D_MODEL ** -0.5),
        "hyb_conv_w": nrm(ks[8], (N_EVEN, CONV_W, D_RNN), CONV_W ** -0.5),
        "hyb_conv_b": nrm(ks[9], (N_EVEN, D_RNN), 0.01),
        "hyb_rg_w": nrm(ks[10], (N_EVEN, N_LRU_BLOCKS, LRU_BLOCK, LRU_BLOCK), LRU_BLOCK ** -0.5),
        "hyb_rg_b": nrm(ks[11], (N_EVEN, D_RNN), 0.01),
        "hyb_ig_w": nrm(ks[12], (N_EVEN, N_LRU_BLOCKS, LRU_BLOCK, LRU_BLOCK), LRU_BLOCK ** -0.5),
        "hyb_ig_b": nrm(ks[13], (N_EVEN, D_RNN), 0.01),
        "hyb_lambda": jnp.log(a0) - jnp.log1p(-a0),
        "hyb_w_out": nrm(ks[15], (N_EVEN, MIX_WIDTH, D_MODEL), MIX_WIDTH ** -0.5),
        "pool_w": nrm(ks[16], (N_ODD, N_POOL_GROUPS, POOL_GROUP, POOL_GROUP), POOL_GROUP ** -0.5),
        "pool_scale": 1.0 + nrm(ks[17], (N_ODD, D_MODEL), 0.1),
        "norm_mix": 1.0 + nrm(ks[18], (DEPTH, D_MODEL), 0.1),
        "norm_ffn": 1.0 + nrm(ks[19], (DEPTH, D_MODEL), 0.1),
        "ffn_gate": nrm(ks[20], (DEPTH, D_MODEL, D_FF), D_MODEL ** -0.5),
        "ffn_up": nrm(ks[21], (DEPTH, D_MODEL, D_FF), D_MODEL ** -0.5),
        "ffn_down": nrm(ks[22], (DEPTH, D_FF, D_MODEL), D_FF ** -0.5),
        "norm_final": 1.0 + nrm(ks[23], (D_MODEL,), 0.1),
    }


def reference(x_prompt, x_sample, cache_sb_k, cache_sb_v, state_lru_h, state_lru_conv, state_pool,
              hyb_w_in, hyb_conv_w, hyb_conv_b, hyb_rg_w, hyb_rg_b, hyb_ig_w, hyb_ig_b, hyb_lambda, hyb_w_out,
              pool_w, pool_scale, norm_mix, norm_ffn, ffn_gate, ffn_up, ffn_down, norm_final):
    b = x_prompt.shape[0]
    dt = x_prompt.dtype
    h0_p = jnp.zeros((N_EVEN, b, D_RNN), dt)
    conv0_p = jnp.zeros((N_EVEN, b, CONV_W - 1, D_RNN), dt)
    pool0_p = jnp.zeros((N_ODD, b, POOL_BUF, D_MODEL), dt)
    y_prompt, k_p, v_p, h_p, conv_p, pool_p = trunk(
        x_prompt, None, None, h0_p, conv0_p, pool0_p, 0,
        hyb_w_in, hyb_conv_w, hyb_conv_b, hyb_rg_w, hyb_rg_b, hyb_ig_w, hyb_ig_b, hyb_lambda, hyb_w_out,
        pool_w, pool_scale, norm_mix, norm_ffn, ffn_gate, ffn_up, ffn_down, norm_final)
    y_sample, k_s, v_s, h_s, conv_s, pool_s = trunk(
        x_sample, cache_sb_k, cache_sb_v, state_lru_h, state_lru_conv, state_pool, cache_sb_k.shape[2],
        hyb_w_in, hyb_conv_w, hyb_conv_b, hyb_rg_w, hyb_rg_b, hyb_ig_w, hyb_ig_b, hyb_lambda, hyb_w_out,
        pool_w, pool_scale, norm_mix, norm_ffn, ffn_gate, ffn_up, ffn_down, norm_final)
    return (y_prompt, y_sample, k_p, v_p, h_p, conv_p, pool_p, k_s, v_s, h_s, conv_s, pool_s)
```

```cpp
#include <hip/hip_runtime.h>
#include <hip/hip_cooperative_groups.h>
#include <cstdio>
#include <cstdint>
namespace cg = cooperative_groups;

constexpr int MP = 32768;
constexpr int MS = 1024;
constexpr int M = MP + MS;
constexpr int D = 1024, NIN = 2560, FF = 2816, NGU = 2 * FF;
constexpr float EPS = 1e-6f;
constexpr size_t OFF_Y = 0, OFF_KP = 34603008, OFF_VP = 51380224, OFF_HP = 68157440, OFF_CP = 68161536, OFF_PP = 68173824,
                 OFF_KS = 68296704, OFF_VS = 68820992, OFF_HS = 69345280, OFF_CS = 69361664, OFF_PS = 69410816, OUT_TOTAL = 69902336;
constexpr size_t MiB = 1u << 20;
constexpr size_t WS_SSQ = 0, WS_SUM = 1 * MiB, WS_SPL = 3 * MiB, WS_BAR = 3 * MiB + 512 * 1024, WS_WIN = 4 * MiB, WS_WG = 9 * MiB, WS_WOUT = 10 * MiB, WS_WGU = 12 * MiB, WS_WD = 34 * MiB, WS_WP = 45 * MiB,
                 WS_XB = 48 * MiB, WS_QB = 114 * MiB, WS_GG = 147 * MiB, WS_UCB = 180 * MiB, WS_U = 213 * MiB, WS_UC = 279 * MiB, WS_KB = 279 * MiB  , WS_VT = 312 * MiB  , WS_AA = 345 * MiB, WS_XIN = 411 * MiB,
                 WS_AO = 477 * MiB, WS_H = 213 * MiB  , WS_PART = 543 * MiB  , WS_END = 587 * MiB;
static_assert(WS_H + (size_t)M * FF * 2 <= WS_AO, "H overlay");
constexpr int LDS_BYTES = 147456;

namespace pg8 {
#define PG8_LAS __attribute__((address_space(3)))
typedef unsigned short bf16_t;
typedef short bf16x8 __attribute__((ext_vector_type(8)));
typedef float f32x4 __attribute__((ext_vector_type(4)));
typedef unsigned u32x4 __attribute__((ext_vector_type(4)));
typedef unsigned u32x2 __attribute__((ext_vector_type(2)));
constexpr int BM = 256, BK = 64, HALF = 128, HTB = HALF * BK * 2, STAGE_BYTES = 8 * HTB, NXCD = 8, WGM = 8;

__host__ __device__ __forceinline__ int lds_byte(int r, int c) { const int st = (r >> 4) * 2 + (c >> 5), rr = r & 15, cc = c & 31, ob = rr * 64 + cc * 2; return st * 1024 + (ob ^ (((ob >> 9) & 1) << 5)); }
__host__ __device__ __forceinline__ void stage_rc(int b, int& R, int& C) { const int st = b / 1024, sb = b % 1024, swz = sb ^ (((sb >> 9) & 1) << 5); R = (st >> 1) * 16 + swz / 64; C = (st & 1) * 32 + (swz % 64) / 2; }
__host__ __device__ __forceinline__ int perm32(int rho) { const int n = rho >> 4, i = rho & 15; return 8 * (i >> 2) + 4 * n + (i & 3); }

struct Unit { int pm, pn, kb, nk; };
struct Gemm { const bf16_t* A; const bf16_t* Bt; int M, N, K, lda, acs; };

__device__ __forceinline__ bool static_tile(int i, int nM, int nN, int G, int c, int& pm, int& pn) {
    const int nwg = nM * nN; const long Lx = (long)i * G + c; if (Lx >= nwg) return false;
    int wgid = (int)Lx; { const int q = nwg / NXCD, r = nwg % NXCD, xcd = wgid % NXCD, off = wgid / NXCD; wgid = (xcd < r ? xcd * (q + 1) : r * (q + 1) + (xcd - r) * q) + off; }
    const int nig = WGM * nN, gid = wgid / nig, fm = gid * WGM, gsz = (nM - fm) < WGM ? (nM - fm) : WGM;
    pm = fm + ((wgid % nig) % gsz); pn = (wgid % nig) / gsz; return true;
}
struct StaticOrder {
    static constexpr bool SPLIT = false;
    int nM, nN, G, c;
    __device__ __forceinline__ void init(int M_, int N_, int G_, int c_) { nM = M_ / BM; nN = N_ / BM; G = G_; c = c_; }
    __device__ __forceinline__ bool next(int i, Unit& u) const { u.kb = 0; u.nk = 0; return static_tile(i, nM, nN, G, c, u.pm, u.pn); }
};

struct G1Order {
    static constexpr bool SPLIT = false;
    int G, c;
    __device__ __forceinline__ void init(int G_, int c_) { G = G_; c = c_; }
    __device__ __forceinline__ bool next(int i, Unit& u) const { u.kb = 0; u.nk = 0; const int Lx = i * G + c; if (Lx >= 1280) return false;
        if (Lx < 1056) { static_tile(0, 132, 8, 0, Lx, u.pm, u.pn); return true; }
        const int idx = Lx - 1056; u.pm = idx >> 1; u.pn = 8 + (idx & 1); return true; }
};
struct G1Tail {
    static constexpr bool SPLIT = false;
    int G, c;
    __device__ __forceinline__ void init(int G_, int c_) { G = G_; c = c_; }
    __device__ __forceinline__ bool next(int i, Unit& u) const { u.kb = 0; u.nk = 0; const int idx = i * G + ((c + G - 16) % G); if (idx >= 40) return false;
        u.pm = 112 + (idx >> 1); u.pn = 8 + (idx & 1); return true; }
};

struct TailOrder {
    static constexpr bool SPLIT = true;
    int G, c, nm, nkfull;
    __device__ __forceinline__ void init(int K_, int G_, int c_) { G = G_; c = c_; nm = (c_ < 512) ? (512 - c_ + G_ - 1) / G_ : 0; nkfull = K_ / BK; }
    __device__ __forceinline__ bool next(int i, Unit& u) const {
        if (i < nm) { static_tile(i, 128, 4, G, c, u.pm, u.pn); u.kb = 0; u.nk = nkfull; return true; }
        const int t = (i - nm) * G + c; if (t >= 16 * 11) return false;
        const int tile = t / 11, ks = t - tile * 11; u.pm = 128 + (tile >> 2); u.pn = tile & 3; u.kb = ks * 4; u.nk = 4; return true;
    }
};

__device__ __forceinline__ unsigned cvt_pk_bf16(float lo, float hi) { unsigned r; asm volatile("v_cvt_pk_bf16_f32 %0, %1, %2" : "=v"(r) : "v"(lo), "v"(hi)); return r; }

template <class Epi, class Sched>
__device__ __forceinline__ void gemm_phase(PG8_LAS unsigned char* lds, const Gemm g, const Sched& S, const Epi& E) {
    int tid = threadIdx.x; asm volatile("" : "+v"(tid));
    const int wid = __builtin_amdgcn_readfirstlane(tid >> 6), lane = tid & 63, wr = wid >> 2, wc = wid & 3, fr = lane & 15, fq = lane >> 4;
    int K = g.K; asm volatile("" : "+s"(K));
    const int ntfull = K / BK;
    unsigned voffA[2], voffB[2];
#pragma unroll
    for (int i = 0; i < 2; ++i) { int R, C; stage_rc(tid * 16 + i * 8192, R, C); const int Rb = (R & ~31) + perm32(R & 31);
        voffA[i] = (unsigned)(R * g.lda + C) * 2u; voffB[i] = (unsigned)(Rb * K + C) * 2u; }
    const size_t kstep = (size_t)(BK * 2);
    const size_t hstepA = (size_t)HALF * g.lda * 2, hstepB = (size_t)HALF * K * 2;
    const unsigned ldsw = (unsigned)wid * 1024u;
    const int aoff = lds_byte(wr * 64 + fr, fq * 8), boff = lds_byte(wc * 32 + fr, fq * 8);
#define PG8_TA(u) ((const char*)g.A + ((size_t)(u).pm * BM * g.lda + (size_t)(u).pn * g.acs) * 2 + (Sched::SPLIT ? (size_t)(u).kb * (BK * 2) : 0))
#define PG8_TB(u) ((const char*)g.Bt + (size_t)(u).pn * BM * K * 2 + (Sched::SPLIT ? (size_t)(u).kb * (BK * 2) : 0))
#define PG8_SA(b, h) (((b) * 2 + (h)) * HTB)
#define PG8_SB(b, h) ((4 + (b) * 2 + (h)) * HTB)
#define PG8_STAGE(bufoff, gbase, voff) do { _Pragma("unroll") for (int _i = 0; _i < 2; ++_i) \
        __builtin_amdgcn_global_load_lds((const unsigned*)((const char*)(gbase) + (voff)[_i]), (PG8_LAS unsigned*)(lds + (bufoff) + ldsw + _i * 8192), 16, 0, 0); } while (0)
#define PG8_LDA(dst, b, h) do { _Pragma("unroll") for (int m = 0; m < 4; ++m) _Pragma("unroll") for (int k = 0; k < 2; ++k) dst[m][k] = *(const PG8_LAS bf16x8*)(lds + PG8_SA(b, h) + aoff + m * 2048 + k * 1024); } while (0)
#define PG8_LDB(dst, b, h) do { _Pragma("unroll") for (int n = 0; n < 2; ++n) _Pragma("unroll") for (int k = 0; k < 2; ++k) dst[n][k] = *(const PG8_LAS bf16x8*)(lds + PG8_SB(b, h) + boff + n * 2048 + k * 1024); } while (0)
#define PG8_MMA(ai, bj, At, Bt) do { __builtin_amdgcn_s_setprio(1); _Pragma("unroll") for (int m = 0; m < 4; ++m) _Pragma("unroll") for (int n = 0; n < 2; ++n) _Pragma("unroll") for (int k = 0; k < 2; ++k) \
        acc[ai][bj][m][n] = __builtin_amdgcn_mfma_f32_16x16x32_bf16(Bt[n][k], At[m][k], acc[ai][bj][m][n], 0, 0, 0); __builtin_amdgcn_s_setprio(0); } while (0)
#define PG8_WAIT_V(n) asm volatile("s_waitcnt vmcnt(" #n ")" ::: "memory")
#define PG8_WAIT_L(n) asm volatile("s_waitcnt lgkmcnt(" #n ")" ::: "memory")
#define PG8_BAR __builtin_amdgcn_s_barrier()
#define PG8_SCHED __builtin_amdgcn_sched_barrier(0)
    Unit cur, nxt; int ui = 0;
    if (!S.next(0, cur)) return;
    f32x4 acc[2][2][4][2];
    E.init(acc, cur, wr, wc, fr, fq);
    bf16x8 At[4][2], B0[2][2], B1[2][2];
    const char* cA = PG8_TA(cur); const char* cB = PG8_TB(cur);
    PG8_STAGE(PG8_SB(0, 0), cB, voffB); PG8_STAGE(PG8_SB(0, 1), cB + hstepB, voffB); PG8_STAGE(PG8_SA(0, 0), cA, voffA); PG8_STAGE(PG8_SA(0, 1), cA + hstepA, voffA);
    if (wr == 1) PG8_BAR;
    PG8_WAIT_V(2); PG8_BAR;
    PG8_STAGE(PG8_SB(1, 0), cB + kstep, voffB); PG8_STAGE(PG8_SA(1, 0), cA + kstep, voffA); PG8_STAGE(PG8_SB(1, 1), cB + hstepB + kstep, voffB);
    PG8_WAIT_V(6); PG8_BAR;
    for (;;) {
        const bool has_next = S.next(ui + 1, nxt);
        const char* nA = has_next ? PG8_TA(nxt) : cA; const char* nB = has_next ? PG8_TB(nxt) : cB;
        const int nt = Sched::SPLIT ? cur.nk : ntfull;
        for (int t = 0; t < nt; t += 2) {
            const bool last = (t == nt - 2);
            const char* a1 = cA + (size_t)(t + 1) * kstep;
            const char* a2 = last ? nA : cA + (size_t)(t + 2) * kstep; const char* b2 = last ? nB : cB + (size_t)(t + 2) * kstep;
            const char* a3 = a2 + kstep; const char* b3 = b2 + kstep;
            PG8_LDB(B0, 0, 0); PG8_LDB(B1, 0, 1); PG8_SCHED; PG8_LDA(At, 0, 0); PG8_STAGE(PG8_SA(1, 1), a1 + hstepA, voffA);
            PG8_WAIT_V(8); PG8_WAIT_L(0); PG8_BAR; PG8_MMA(0, 0, At, B0); PG8_MMA(0, 1, At, B1); PG8_BAR; PG8_SCHED;
            PG8_LDA(At, 0, 1); PG8_STAGE(PG8_SB(0, 0), b2, voffB); PG8_STAGE(PG8_SB(0, 1), b2 + hstepB, voffB); PG8_STAGE(PG8_SA(0, 0), a2, voffA);
            PG8_WAIT_V(8); PG8_WAIT_L(0); PG8_BAR; PG8_MMA(1, 0, At, B0); PG8_MMA(1, 1, At, B1); PG8_BAR; PG8_SCHED;
            PG8_LDB(B0, 1, 0); PG8_LDB(B1, 1, 1); PG8_SCHED; PG8_LDA(At, 1, 0); PG8_STAGE(PG8_SA(0, 1), a2 + hstepA, voffA);
            PG8_WAIT_V(8); PG8_WAIT_L(0); PG8_BAR; PG8_MMA(0, 0, At, B0); PG8_MMA(0, 1, At, B1); PG8_BAR; PG8_SCHED;
            PG8_LDA(At, 1, 1); PG8_STAGE(PG8_SB(1, 0), b3, voffB); PG8_STAGE(PG8_SB(1, 1), b3 + hstepB, voffB); PG8_STAGE(PG8_SA(1, 0), a3, voffA);
            PG8_WAIT_V(8); PG8_WAIT_L(0); PG8_BAR; PG8_MMA(1, 0, At, B0); PG8_MMA(1, 1, At, B1); PG8_BAR; PG8_SCHED;
        }
        if (wr == 0) PG8_BAR;
        E(acc, cur, wr, wc, fr, fq);
        if (!has_next) break;
        E.init(acc, nxt, wr, wc, fr, fq);
        cur = nxt; cA = nA; cB = nB; ++ui;
        if (wr == 1) PG8_BAR;
    }
    PG8_WAIT_V(0);
    PG8_BAR;
#undef PG8_TA
#undef PG8_TB
#undef PG8_SA
#undef PG8_SB
#undef PG8_STAGE
#undef PG8_LDA
#undef PG8_LDB
#undef PG8_MMA
#undef PG8_WAIT_V
#undef PG8_WAIT_L
#undef PG8_BAR
#undef PG8_SCHED
}
}

using pg8::bf16_t; using pg8::bf16x8; using pg8::f32x4; using pg8::u32x4; using pg8::u32x2; using pg8::Unit; using pg8::cvt_pk_bf16;
typedef float f32x16 __attribute__((ext_vector_type(16)));
#define LAS __attribute__((address_space(3)))

__device__ __forceinline__ float bf2f(bf16_t v) { return __uint_as_float((unsigned)v << 16); }
__device__ __forceinline__ float sigmoidf_(float x) { return 1.f / (1.f + __expf(-x)); }
__device__ __forceinline__ float gelu_tanh(float x) { const float y2 = 1.5957691216f * (x + 0.044715f * x * x * x); return x / (1.f + __expf(-y2)); }
__device__ __forceinline__ bf16x8 pack8(float a0, float a1, float a2, float a3, float a4, float a5, float a6, float a7) {
    u32x4 w; w.x = cvt_pk_bf16(a0, a1); w.y = cvt_pk_bf16(a2, a3); w.z = cvt_pk_bf16(a4, a5); w.w = cvt_pk_bf16(a6, a7); return __builtin_bit_cast(bf16x8, w); }

__device__ __forceinline__ f32x4 bf4lo(u32x4 r) { return (f32x4){__uint_as_float(r.x << 16), __uint_as_float(r.x & 0xffff0000u), __uint_as_float(r.y << 16), __uint_as_float(r.y & 0xffff0000u)}; }
__device__ __forceinline__ f32x4 bf4hi(u32x4 r) { return (f32x4){__uint_as_float(r.z << 16), __uint_as_float(r.z & 0xffff0000u), __uint_as_float(r.w << 16), __uint_as_float(r.w & 0xffff0000u)}; }
__device__ __forceinline__ f32x4 bf4(u32x2 r) { return (f32x4){__uint_as_float(r.x << 16), __uint_as_float(r.x & 0xffff0000u), __uint_as_float(r.y << 16), __uint_as_float(r.y & 0xffff0000u)}; }
__device__ __forceinline__ void acc_zero(f32x4 (&acc)[2][2][4][2]) {
#pragma unroll
    for (int a = 0; a < 2; ++a)
#pragma unroll
        for (int b = 0; b < 2; ++b)
#pragma unroll
            for (int m = 0; m < 4; ++m)
#pragma unroll
                for (int n = 0; n < 2; ++n) acc[a][b][m][n] = (f32x4){0.f, 0.f, 0.f, 0.f};
}
struct EpiG1 {
    bf16_t* QB; bf16_t* GG; bf16_t* U; float* out; bf16_t* KBp; bf16_t* VTp;
    __device__ __forceinline__ void init(f32x4 (&acc)[2][2][4][2], const Unit&, int, int, int, int) const { acc_zero(acc); }
    __device__ __forceinline__ void operator()(const f32x4 (&acc)[2][2][4][2], const Unit& u, int wr, int wc, int fr, int fq) const {
        const int region = u.pn >> 1; const int cb = (u.pn & 1) * 256 + wc * 32 + 8 * fq; const int row0 = u.pm * 256 + wr * 64 + fr;
        const bool samp = u.pm >= 128;
#pragma unroll
        for (int ai = 0; ai < 2; ++ai)
#pragma unroll
            for (int m = 0; m < 4; ++m) { const int row = row0 + ai * 128 + m * 16;
#pragma unroll
                for (int bj = 0; bj < 2; ++bj) { const int col = cb + bj * 128; const f32x4 v0 = acc[ai][bj][m][0], v1 = acc[ai][bj][m][1];
                    if (region == 0) { u32x4 w; const float qs = 0.125f * 1.44269504089f;     w.x = cvt_pk_bf16(v0[0] * qs, v0[1] * qs); w.y = cvt_pk_bf16(v0[2] * qs, v0[3] * qs); w.z = cvt_pk_bf16(v1[0] * qs, v1[1] * qs); w.w = cvt_pk_bf16(v1[2] * qs, v1[3] * qs);
                        *(u32x4*)(QB + (size_t)row * 512 + col) = w; }
                    else if (region == 1 || region == 2) {
                        float* o = out + (region == 1 ? (samp ? OFF_KS : OFF_KP) : (samp ? OFF_VS : OFF_VP)) + (size_t)(samp ? row - MP : row) * 512 + col;
                        *(f32x4*)o = v0; *(f32x4*)(o + 4) = v1;
                        if (!samp) { const unsigned w0 = cvt_pk_bf16(v0[0], v0[1]), w1 = cvt_pk_bf16(v0[2], v0[3]), w2 = cvt_pk_bf16(v1[0], v1[1]), w3 = cvt_pk_bf16(v1[2], v1[3]);
                            const int bh = (row >> 12) * 8 + (col >> 6), pos = row & 4095, d0 = col & 63;
                            if (region == 1) { u32x4 w; w.x = w0; w.y = w1; w.z = w2; w.w = w3; *(u32x4*)(KBp + ((size_t)((bh * 128 + (pos >> 5)) * 4 + (d0 >> 4)) * 512 + (pos & 31) * 16 + (d0 & 15))) = w; }
                            else { bf16_t* vt = VTp + ((size_t)(bh * 1024 + (pos >> 2)) * 64 + d0) * 4 + (pos & 3);
                                vt[0] = (bf16_t)(w0 & 0xffffu); vt[4] = (bf16_t)(w0 >> 16); vt[8] = (bf16_t)(w1 & 0xffffu); vt[12] = (bf16_t)(w1 >> 16);
                                vt[16] = (bf16_t)(w2 & 0xffffu); vt[20] = (bf16_t)(w2 >> 16); vt[24] = (bf16_t)(w3 & 0xffffu); vt[28] = (bf16_t)(w3 >> 16); } } }
                    else if (region == 3) { u32x4 w; w.x = cvt_pk_bf16(v0[0], v0[1]); w.y = cvt_pk_bf16(v0[2], v0[3]); w.z = cvt_pk_bf16(v1[0], v1[1]); w.w = cvt_pk_bf16(v1[2], v1[3]); *(u32x4*)(U + (size_t)row * 512 + col) = w; }
                    else { u32x4 w; w.x = cvt_pk_bf16(gelu_tanh(v0[0]), gelu_tanh(v0[1])); w.y = cvt_pk_bf16(gelu_tanh(v0[2]), gelu_tanh(v0[3])); w.z = cvt_pk_bf16(gelu_tanh(v1[0]), gelu_tanh(v1[1])); w.w = cvt_pk_bf16(gelu_tanh(v1[2]), gelu_tanh(v1[3]));
                        *(u32x4*)(GG + (size_t)row * 512 + col) = w; }
                } asm volatile("" ::: "memory"); }
    }
};
struct EpiGate {
    const float *rgb, *igb, *lam; const bf16_t* UCBp; unsigned* AX;
    __device__ __forceinline__ void init(f32x4 (&acc)[2][2][4][2], const Unit&, int, int, int, int) const { acc_zero(acc); }
    __device__ __forceinline__ void operator()(const f32x4 (&acc)[2][2][4][2], const Unit& u, int wr, int wc, int fr, int fq) const {
        const int row0 = u.pm * 256 + wr * 64 + fr; const int cb = u.pn * 128 + wc * 32 + 8 * fq;
        const f32x4 sp0 = *(const f32x4*)(lam + cb), sp1 = *(const f32x4*)(lam + cb + 4), rb0 = *(const f32x4*)(rgb + cb), rb1 = *(const f32x4*)(rgb + cb + 4), ib0 = *(const f32x4*)(igb + cb), ib1 = *(const f32x4*)(igb + cb + 4);
#pragma unroll
        for (int ai = 0; ai < 2; ++ai) {
            f32x4 ucv[4][2];
#pragma unroll
            for (int m = 0; m < 4; ++m) { const u32x4 raw = *(const u32x4*)(UCBp + (size_t)(row0 + ai * 128 + m * 16) * 512 + cb); ucv[m][0] = bf4lo(raw); ucv[m][1] = bf4hi(raw); }
#pragma unroll
            for (int m = 0; m < 4; ++m)
#pragma unroll
                for (int n = 0; n < 2; ++n) { const size_t off = (size_t)(row0 + ai * 128 + m * 16) * 512 + cb + 4 * n;
                    const f32x4 uv = ucv[m][n], sp = n ? sp1 : sp0, rb = n ? rb1 : rb0, ib = n ? ib1 : ib0; u32x4 pk;
#pragma unroll
                    for (int j = 0; j < 4; ++j) { const float r = sigmoidf_(acc[ai][0][m][n][j] + rb[j]), ig = sigmoidf_(acc[ai][1][m][n][j] + ib[j]);
                        const float la = sp[j] * r; const float ae = __expf(la); const float om = 1.f - ae; pk[j] = cvt_pk_bf16(om, sqrtf(om * (1.f + ae)) * ig * uv[j]); }
                    *(u32x4*)(AX + off) = pk; }
            asm volatile("" ::: "memory"); }
    }
};
template <bool FROMX, bool TAIL = false> struct EpiRes {
    const float* xP; const float* xS; bf16_t* XB; float* ssq; float* part;
    __device__ __forceinline__ void init(f32x4 (&acc)[2][2][4][2], const Unit& u, int wr, int wc, int fr, int fq) const {
        const bool samp = u.pm >= 128;
        if (TAIL && samp) { acc_zero(acc); return; }
        const int cb = u.pn * 256 + wc * 32 + 8 * fq; const int row0 = u.pm * 256 + wr * 64 + fr;
        if (FROMX) { const float* rbase = (samp ? xS : xP) + (size_t)(row0 - (samp ? MP : 0)) * D + cb;
#pragma unroll
            for (int ai = 0; ai < 2; ++ai)
#pragma unroll
                for (int m = 0; m < 4; ++m)
#pragma unroll
                    for (int bj = 0; bj < 2; ++bj) { const float* rp = rbase + (size_t)(ai * 128 + m * 16) * D + bj * 128; acc[ai][bj][m][0] = *(const f32x4*)rp; acc[ai][bj][m][1] = *(const f32x4*)(rp + 4); } }
        else { const bf16_t* rbase = XB + (size_t)row0 * D + cb;
#pragma unroll
            for (int ai = 0; ai < 2; ++ai)
#pragma unroll
                for (int m = 0; m < 4; ++m)
#pragma unroll
                    for (int bj = 0; bj < 2; ++bj) { const u32x4 raw = *(const u32x4*)(rbase + (size_t)(ai * 128 + m * 16) * D + bj * 128); acc[ai][bj][m][0] = bf4lo(raw); acc[ai][bj][m][1] = bf4hi(raw); } }
    }
    __device__ __forceinline__ void operator()(const f32x4 (&acc)[2][2][4][2], const Unit& u, int wr, int wc, int fr, int fq) const {
        const int cb = u.pn * 256 + wc * 32 + 8 * fq; const int row0 = u.pm * 256 + wr * 64 + fr; const bool samp = u.pm >= 128;
        if (TAIL && samp) {
#pragma unroll
            for (int ai = 0; ai < 2; ++ai)
#pragma unroll
                for (int m = 0; m < 4; ++m) { const int row = row0 + ai * 128 + m * 16;
#pragma unroll
                    for (int bj = 0; bj < 2; ++bj) { float* xo = part + ((size_t)(u.kb >> 2) * MS + (row - MP)) * D + cb + bj * 128;
                        *(f32x4*)xo = acc[ai][bj][m][0]; *(f32x4*)(xo + 4) = acc[ai][bj][m][1]; } }
            return;
        }
#pragma unroll
        for (int ai = 0; ai < 2; ++ai)
#pragma unroll
            for (int m = 0; m < 4; ++m) { const int row = row0 + ai * 128 + m * 16; float s = 0.f;
#pragma unroll
                for (int bj = 0; bj < 2; ++bj) { const int col = cb + bj * 128; const f32x4 v0 = acc[ai][bj][m][0], v1 = acc[ai][bj][m][1];
                    u32x4 w; w.x = cvt_pk_bf16(v0[0], v0[1]); w.y = cvt_pk_bf16(v0[2], v0[3]); w.z = cvt_pk_bf16(v1[0], v1[1]); w.w = cvt_pk_bf16(v1[2], v1[3]); *(u32x4*)(XB + (size_t)row * D + col) = w;
                    s += (v0[0] * v0[0] + v0[1] * v0[1]) + (v0[2] * v0[2] + v0[3] * v0[3]) + (v1[0] * v1[0] + v1[1] * v1[1]) + (v1[2] * v1[2] + v1[3] * v1[3]); }
                s += __shfl_xor(s, 16); s += __shfl_xor(s, 32);
                if (fq == 0) atomicAdd(ssq + row, s); }
    }
};
struct EpiSwiglu {
    const float* ssq; bf16_t* H;
    __device__ __forceinline__ void init(f32x4 (&acc)[2][2][4][2], const Unit&, int, int, int, int) const { acc_zero(acc); }
    __device__ __forceinline__ void operator()(const f32x4 (&acc)[2][2][4][2], const Unit& u, int wr, int wc, int fr, int fq) const {
        const int col = u.pn * 128 + wc * 32 + 8 * fq; const int row0 = u.pm * 256 + wr * 64 + fr;
        float rsv[8];
#pragma unroll
        for (int i = 0; i < 8; ++i) rsv[i] = ssq[row0 + (i >> 2) * 128 + (i & 3) * 16];
#pragma unroll
        for (int ai = 0; ai < 2; ++ai)
#pragma unroll
            for (int m = 0; m < 4; ++m) { const int row = row0 + ai * 128 + m * 16; const float rs = rsqrtf(rsv[ai * 4 + m] * (1.f / D) + EPS); float h[8];
#pragma unroll
                for (int j = 0; j < 8; ++j) { const float gv = acc[ai][0][m][j >> 2][j & 3] * rs, uv = acc[ai][1][m][j >> 2][j & 3] * rs; h[j] = gv / (1.f + __expf(-gv)) * uv; }
                u32x4 w; w.x = cvt_pk_bf16(h[0], h[1]); w.y = cvt_pk_bf16(h[2], h[3]); w.z = cvt_pk_bf16(h[4], h[5]); w.w = cvt_pk_bf16(h[6], h[7]);
                *(u32x4*)(H + (size_t)row * FF + col) = w; }
    }
};

struct Args { const float* in[24]; float* out; unsigned char* ws; };
enum { I_XP = 0, I_XS, I_CK, I_CV, I_LH, I_LC, I_SP, I_WIN, I_CW, I_CB, I_RGW, I_RGB, I_IGW, I_IGB, I_LAM, I_WOUT, I_PW, I_PS, I_NM, I_NF, I_FG, I_FU, I_FD, I_NFIN };

__device__ __forceinline__ void transpose_tile(const float* W, int ldw, int srccol0, int k0, const float* gamma, bf16_t* WT, int ldwt, int dstrow0, LAS float* scr, int lane, const float* nscale = nullptr) {
    const float ns = nscale ? nscale[dstrow0 + (lane & 31)] : 1.f;
#pragma unroll
    for (int i = 0; i < 32; ++i) { const int kk = 2 * i + (lane >> 5); float v = W[(size_t)(k0 + kk) * ldw + srccol0 + (lane & 31)]; if (gamma) v *= gamma[k0 + kk]; scr[kk * 33 + (lane & 31)] = v * ns; }
    asm volatile("s_waitcnt lgkmcnt(0)" ::: "memory");
    const int c = lane & 7;
#pragma unroll
    for (int j = 0; j < 4; ++j) { const int n = (lane >> 3) + 8 * j; const LAS float* s = scr + (8 * c) * 33 + n;
        u32x4 o; o.x = cvt_pk_bf16(s[0 * 33], s[1 * 33]); o.y = cvt_pk_bf16(s[2 * 33], s[3 * 33]); o.z = cvt_pk_bf16(s[4 * 33], s[5 * 33]); o.w = cvt_pk_bf16(s[6 * 33], s[7 * 33]);
        *(u32x4*)(WT + (size_t)(dstrow0 + n) * ldwt + k0 + 8 * c) = o; }
    asm volatile("s_waitcnt lgkmcnt(0)" ::: "memory");
}
__device__ __forceinline__ float wave_sum(float v) {
#pragma unroll
    for (int o = 1; o < 64; o <<= 1) v += __shfl_xor(v, o);
    return v;
}
__device__ __forceinline__ int crow(int r, int hi) { return (r & 3) + 8 * (r >> 2) + 4 * hi; }

template <bool PR>
__device__ __forceinline__ void attn_unit(const Args& a, const bf16_t* QB, bf16_t* AO, const bf16_t* KBp, const bf16_t* VTp, int qt, int h, int lane) {
    const int r32 = lane & 31, hi = lane >> 5;
    const float *Kd, *Vd, *Kc, *Vc; int nprev; size_t qrow0;
    if (qt < 1024) { const int b = qt >> 7, tq = qt & 127; qrow0 = (size_t)qt * 32;
        Kc = a.out + OFF_KP + (size_t)b * 4096 * 512 + h * 64; Vc = a.out + OFF_VP + (size_t)b * 4096 * 512 + h * 64;
        Kd = Kc + (size_t)tq * 32 * 512; Vd = Vc + (size_t)tq * 32 * 512; nprev = tq; }
    else { const int bs = qt - 1024; qrow0 = (size_t)MP + (size_t)bs * 32;
        Kd = a.out + OFF_KS + (size_t)bs * 32 * 512 + h * 64; Vd = a.out + OFF_VS + (size_t)bs * 32 * 512 + h * 64;
        Kc = a.in[I_CK] + (size_t)bs * 4096 * 512 + h * 64; Vc = a.in[I_CV] + (size_t)bs * 4096 * 512 + h * 64; nprev = 128; }
    bf16x8 qf[4];
    { const bf16_t* Qp = QB + (qrow0 + r32) * 512 + h * 64 + hi * 8;
#pragma unroll
      for (int kk = 0; kk < 4; ++kk) qf[kk] = *(const bf16x8*)(Qp + kk * 16); }
    f32x16 o0, o1;
#pragma unroll
    for (int r = 0; r < 16; ++r) { o0[r] = 0.f; o1[r] = 0.f; }
    float Cm = 1.f; int Ce = 0;
    constexpr int DP = PR ? 3 : 1;
    f32x4 kr[8]; float vr[32];
    bf16x8 krb[DP][4]; u32x2 vrb[DP][8];
    const bf16_t* Kbb = KBp + (size_t)(((qt >> 7) * 8 + h) * 128) * 2048 + r32 * 16 + hi * 8;
    const bf16_t* Vtb = VTp + ((size_t)(((qt >> 7) * 8 + h) * 1024 + hi) * 64 + r32) * 4;
#define ATT_LOAD(Kt_, Vt_) do { const float* kp_ = (Kt_) + (size_t)r32 * 512 + hi * 8; \
        _Pragma("unroll") for (int kk = 0; kk < 4; ++kk) { kr[2 * kk] = *(const f32x4*)(kp_ + kk * 16); kr[2 * kk + 1] = *(const f32x4*)(kp_ + kk * 16 + 4); } \
        const float* vp_ = (Vt_) + (size_t)(4 * hi) * 512 + r32; \
        _Pragma("unroll") for (int sI = 0; sI < 2; ++sI) _Pragma("unroll") for (int dh = 0; dh < 2; ++dh) _Pragma("unroll") for (int i = 0; i < 8; ++i) \
            vr[(sI * 2 + dh) * 8 + i] = vp_[(size_t)(16 * sI + (i & 3) + 8 * (i >> 2)) * 512 + dh * 32]; } while (0)
#define ATT_LOADB(J_, key0_) do { const bf16_t* kp_ = Kbb + (size_t)((key0_) >> 5) * 2048; \
        _Pragma("unroll") for (int kk = 0; kk < 4; ++kk) krb[J_][kk] = *(const bf16x8*)(kp_ + kk * 512); \
        _Pragma("unroll") for (int sI = 0; sI < 2; ++sI) _Pragma("unroll") for (int dh = 0; dh < 2; ++dh) { const bf16_t* vp_ = Vtb + ((size_t)(((key0_) >> 2) + 4 * sI) * 64 + 32 * dh) * 4; \
            vrb[J_][(sI * 2 + dh) * 2] = *(const u32x2*)vp_; vrb[J_][(sI * 2 + dh) * 2 + 1] = *(const u32x2*)(vp_ + 2 * 64 * 4); } } while (0)
    if (PR) {
#pragma unroll
        for (int j = 0; j < DP; ++j) if (j <= nprev) ATT_LOADB(j, (nprev - j) * 32);
    } else ATT_LOAD(Kd, Vd);
    bool done = false;
    for (int it0 = 0; it0 <= nprev && !done; it0 += DP) {
#pragma unroll
      for (int j = 0; j < DP; ++j) { const int it = it0 + j; if (it > nprev) { done = true; break; }
        bf16x8 kf[4], vb[4];
        if (PR) {
#pragma unroll
            for (int kk = 0; kk < 4; ++kk) kf[kk] = krb[j][kk];
#pragma unroll
            for (int q = 0; q < 4; ++q) { u32x4 w; w.x = vrb[j][2 * q].x; w.y = vrb[j][2 * q].y; w.z = vrb[j][2 * q + 1].x; w.w = vrb[j][2 * q + 1].y; vb[q] = __builtin_bit_cast(bf16x8, w); }
            if (it + DP <= nprev) ATT_LOADB(j, (nprev - it - DP) * 32);
        } else {
#pragma unroll
            for (int kk = 0; kk < 4; ++kk) kf[kk] = pack8(kr[2 * kk][0], kr[2 * kk][1], kr[2 * kk][2], kr[2 * kk][3], kr[2 * kk + 1][0], kr[2 * kk + 1][1], kr[2 * kk + 1][2], kr[2 * kk + 1][3]);
#pragma unroll
            for (int q = 0; q < 4; ++q) vb[q] = pack8(vr[q * 8 + 0], vr[q * 8 + 1], vr[q * 8 + 2], vr[q * 8 + 3], vr[q * 8 + 4], vr[q * 8 + 5], vr[q * 8 + 6], vr[q * 8 + 7]);
            if (it < nprev) { const size_t toff = (size_t)(nprev - it - 1) * 32 * 512; ATT_LOAD(Kc + toff, Vc + toff); }
        }
        f32x16 s;
#pragma unroll
        for (int r = 0; r < 16; ++r) s[r] = 0.f;
#pragma unroll
        for (int kk = 0; kk < 4; ++kk) s = __builtin_amdgcn_mfma_f32_32x32x16_bf16(kf[kk], qf[kk], s, 0, 0, 0);
        float sg[16], om[16];
#pragma unroll
        for (int r = 0; r < 16; ++r) { const float z2 = s[r]; const float e = __builtin_amdgcn_exp2f(-fabsf(z2)); const float rc = __builtin_amdgcn_rcpf(1.f + e); const float t = e * rc;
            const bool pos = z2 >= 0.f; const bool valid = (it != 0) || (crow(r, hi) < r32);
            sg[r] = valid ? (pos ? rc : t) : 0.f; om[r] = valid ? (pos ? t : rc) : 1.f; }
        const float G0 = (om[0] * om[1]) * (om[2] * om[3]), G1 = (om[4] * om[5]) * (om[6] * om[7]), G2 = (om[8] * om[9]) * (om[10] * om[11]), G3 = (om[12] * om[13]) * (om[14] * om[15]);
        const float P0 = __shfl_xor(G0, 32), P1 = __shfl_xor(G1, 32), P2 = __shfl_xor(G2, 32), P3 = __shfl_xor(G3, 32);
        const float t3 = G3 * P3, t2 = G2 * P2, t1 = G1 * P1, t0 = G0 * P0;
        const float Cs = ldexpf(Cm, Ce);
        float base[4];
        base[3] = Cs * (hi ? 1.f : P3); base[2] = Cs * t3 * (hi ? 1.f : P2); base[1] = Cs * (t3 * t2) * (hi ? 1.f : P1); base[0] = Cs * ((t3 * t2) * t1) * (hi ? 1.f : P0);
        float w[16];
#pragma unroll
        for (int g = 0; g < 4; ++g) { float bt = base[g];
#pragma unroll
            for (int rr = 3; rr >= 0; --rr) { const int r = 4 * g + rr; w[r] = sg[r] * bt; bt *= om[r]; } }
        { const float nc = Cm * ((t0 * t1) * (t2 * t3)); Cm = __builtin_amdgcn_frexp_mantf(nc); Ce += __builtin_amdgcn_frexp_expf(nc); }
        const bf16x8 wa0 = pack8(w[0], w[1], w[2], w[3], w[4], w[5], w[6], w[7]), wa1 = pack8(w[8], w[9], w[10], w[11], w[12], w[13], w[14], w[15]);
        o0 = __builtin_amdgcn_mfma_f32_32x32x16_bf16(wa0, vb[0], o0, 0, 0, 0); o0 = __builtin_amdgcn_mfma_f32_32x32x16_bf16(wa1, vb[2], o0, 0, 0, 0);
        o1 = __builtin_amdgcn_mfma_f32_32x32x16_bf16(wa0, vb[1], o1, 0, 0, 0); o1 = __builtin_amdgcn_mfma_f32_32x32x16_bf16(wa1, vb[3], o1, 0, 0, 0);
        if (__all(Cm == 0.f || Ce < -150)) { done = true; break; }
      }
    }
#undef ATT_LOAD
#undef ATT_LOADB
    bf16_t* op = AO + qrow0 * D + h * 64 + r32;
#pragma unroll
    for (int r = 0; r < 16; ++r) { const size_t ro = (size_t)crow(r, hi) * D; op[ro] = (bf16_t)(cvt_pk_bf16(o0[r], 0.f) & 0xffffu); op[ro + 32] = (bf16_t)(cvt_pk_bf16(o1[r], 0.f) & 0xffffu); }
}


constexpr int PR = 8;
template <int W, bool SAMP>
__device__ __forceinline__ void pool_strip(const bf16_t* XRp, bf16_t* XBp, float* pout, const float* ssq2, const LAS float* ldsrs, const float* pbuf, const float* gm,
                                           int row0, int pos0, int seq, int Tseq, int c4) {
    const f32x4 gv = *(const f32x4*)(gm + c4);
    f32x4 xn[PR + W - 1];
#pragma unroll
    for (int j = 0; j < PR + W - 1; ++j) { const int p = pos0 - (W - 1) + j, rr = row0 - (W - 1) + j;
        if (p >= 0) { const float rs = SAMP ? ldsrs[p] : rsqrtf(ssq2[rr] * (1.f / D) + EPS); xn[j] = bf4(*(const u32x2*)(XRp + (size_t)rr * D + c4)) * rs * gv; }
        else if (SAMP) xn[j] = *(const f32x4*)(pbuf + ((size_t)seq * 15 + (15 + p)) * D + c4);
        else xn[j] = (f32x4){0.f, 0.f, 0.f, 0.f}; }
    f32x4 Sw = (f32x4){0.f, 0.f, 0.f, 0.f};
#pragma unroll
    for (int j = 0; j < W - 1; ++j) Sw = Sw + xn[j];
#pragma unroll
    for (int t = 0; t < PR; ++t) { const int pos = pos0 + t; const f32x4 x = xn[t + W - 1]; Sw = Sw + x;
        const float cnt = SAMP ? (float)W : (float)((pos + 1 < W) ? pos + 1 : W); const f32x4 dv = Sw * (1.f / cnt) - x;
        u32x2 wv; wv.x = cvt_pk_bf16(dv[0], dv[1]); wv.y = cvt_pk_bf16(dv[2], dv[3]); *(u32x2*)(XBp + (size_t)(row0 + t) * D + c4) = wv;
        if (pos >= Tseq - 15) *(f32x4*)(pout + ((size_t)seq * 15 + (pos - (Tseq - 15))) * D + c4) = x;
        Sw = Sw - xn[t]; }
}

#define XB_TMO      128
#define XB_XCNT(j)  (256  + 64 * (j))
#define XB_XSUB(j)  (1280 + 64 * (j))
#define XB_XGEN(j)  (2304 + 64 * (j))
#define XB_TOP      3328
#define XB_TOPGEN   3392
#define XCD_BAR_WORDS 3456
#define XB_SPIN_CAP (1u << 18)

__device__ __forceinline__ unsigned xb_ld(unsigned* p)              { return __hip_atomic_load(p, __ATOMIC_RELAXED, __HIP_MEMORY_SCOPE_AGENT); }
__device__ __forceinline__ unsigned xb_add(unsigned* p, unsigned v) { return __hip_atomic_fetch_add(p, v, __ATOMIC_RELAXED, __HIP_MEMORY_SCOPE_AGENT); }
__device__ __forceinline__ unsigned xb_xcc_id() { return (unsigned)__builtin_amdgcn_s_getreg((3 << 11) | 20) & 0xFu; }
#define XB_SPIN(cond, bar) do { unsigned _sp = 0; while (cond) { __builtin_amdgcn_s_sleep(1); \
    if ((++_sp & 255u) == 0u) { if (xb_ld(&(bar)[XB_TMO])) break; if (_sp > XB_SPIN_CAP) { atomicAdd(&(bar)[XB_TMO], 1u); break; } } } } while (0)

struct XcdBarrier {
    unsigned* bar; unsigned x;
    volatile LAS unsigned* st;
};

__device__ __forceinline__ XcdBarrier xcd_barrier_post(unsigned* bar, volatile LAS unsigned* st) {
    XcdBarrier b; b.bar = bar; b.x = xb_xcc_id(); b.st = st;
    if (threadIdx.x == 0) (void)xb_add(&bar[XB_XCNT(b.x)], 1u);
    return b;
}
__device__ __forceinline__ void xcd_barrier_complete(unsigned* bar, unsigned x, unsigned& nloc, unsigned& nx) {
    const unsigned G = gridDim.x * gridDim.y * gridDim.z;
    unsigned sum, cnt, mine, sp = 0u;
    for (;;) {
        sum = 0u; cnt = 0u; mine = 0u;
#pragma unroll
        for (unsigned j = 0; j < 16; ++j) { const unsigned c = xb_ld(&bar[XB_XCNT(j)]); sum += c; cnt += (c > 0u) ? 1u : 0u; mine = (j == x) ? c : mine; }
        if (sum == G) break;
        __builtin_amdgcn_s_sleep(1);
        if ((++sp & 255u) == 0u) { if (xb_ld(&bar[XB_TMO])) break; if (sp > XB_SPIN_CAP) { atomicAdd(&bar[XB_TMO], 1u); break; } }
    }
    nloc = mine > 0u ? mine : 1u; nx = cnt > 0u ? cnt : 1u;
}

__device__ __forceinline__ void xcd_barrier(const XcdBarrier& b) {
    asm volatile("s_waitcnt vmcnt(0)" ::: "memory");
    __syncthreads();
    if (threadIdx.x == 0) {
        unsigned* bar = b.bar;
        __builtin_amdgcn_s_waitcnt(0);
        unsigned nloc = b.st[0], nx = b.st[1];
        if (nloc == 0u) { xcd_barrier_complete(bar, b.x, nloc, nx); b.st[0] = nloc; b.st[1] = nx; }
        const unsigned old = xb_add(&bar[XB_XSUB(b.x)], 1u);
        const unsigned gen = old / nloc;
        if (old + 1u == (gen + 1u) * nloc) {
            __builtin_amdgcn_fence(__ATOMIC_RELEASE, "agent");
            asm volatile("s_waitcnt vmcnt(0)" ::: "memory");
            const unsigned og = xb_add(&bar[XB_TOP], 1u);
            const unsigned tg = og / nx;
            if (og + 1u == (tg + 1u) * nx) xb_add(&bar[XB_TOPGEN], 1u);
            else XB_SPIN(xb_ld(&bar[XB_TOPGEN]) == tg, bar);
            __builtin_amdgcn_fence(__ATOMIC_ACQUIRE, "agent");
            xb_add(&bar[XB_XGEN(b.x)], 1u);
            asm volatile("s_waitcnt vmcnt(0)" ::: "memory");
        } else {
            XB_SPIN(xb_ld(&bar[XB_XGEN(b.x)]) == gen, bar);
            __builtin_amdgcn_fence(__ATOMIC_ACQUIRE, "agent");
            asm volatile("s_waitcnt vmcnt(0)" ::: "memory");
        }
    }
    __syncthreads();
}


#ifndef SKIPMASK
#define SKIPMASK 0
#endif
#define PH(n) if (!((SKIPMASK >> (n)) & 1))
__global__ void __launch_bounds__(512, 2) fwd_kernel(Args a) {
    extern __shared__ __attribute__((aligned(16))) unsigned char lds[];
    cg::grid_group grid = cg::this_grid();
    PG8_LAS unsigned char* L = (PG8_LAS unsigned char*)lds;
    const int tid = threadIdx.x, lane = tid & 63, wave = __builtin_amdgcn_readfirstlane(tid >> 6);
    const int G = gridDim.x, bx = blockIdx.x;
    const int gw = bx * 8 + wave, NGW = G * 8; const int gt = bx * 512 + tid, NGT = G * 512;
    float* const out = a.out;
    volatile LAS unsigned* bst = (volatile LAS unsigned*)(L + 131072 + 64);
    if (tid < 4) bst[tid] = 0u;
    __syncthreads();
    const XcdBarrier xbar = xcd_barrier_post((unsigned*)(a.ws + WS_BAR), bst);
#define ws (a.ws)
#define SSQ ((float*)(ws + WS_SSQ))
#define SUMA ((float*)(ws + WS_SUM))
#define SUMH (SUMA + 512 * 512)
#define SPL ((float*)(ws + WS_SPL))
#define WIN ((bf16_t*)(ws + WS_WIN))
#define WG ((bf16_t*)(ws + WS_WG))
#define WOUT ((bf16_t*)(ws + WS_WOUT))
#define WGU ((bf16_t*)(ws + WS_WGU))
#define WD ((bf16_t*)(ws + WS_WD))
#define WP ((bf16_t*)(ws + WS_WP))
#define XB ((bf16_t*)(ws + WS_XB))
#define QB ((bf16_t*)(ws + WS_QB))
#define GG ((bf16_t*)(ws + WS_GG))
#define UCB ((bf16_t*)(ws + WS_UCB))
#define KB ((bf16_t*)(ws + WS_KB))
#define VT ((bf16_t*)(ws + WS_VT))
#define U ((bf16_t*)(ws + WS_U))
#define AX ((unsigned*)(ws + WS_AA))
#define AO ((bf16_t*)(ws + WS_AO))
#define H ((bf16_t*)(ws + WS_H))
#define PART ((float*)(ws + WS_PART))

    PH(0)
    {
        for (int i = gt; i < 4 * M; i += NGT) SSQ[i] = 0.f;
        if (gt < 512) SPL[gt] = -8.f * log1pf(expf(-a.in[I_LAM][gt]));
        LAS float* scr = (LAS float*)(L + wave * 16384);
        constexpr int IT_WIN = 16 * 80, IT_WOUT = 16 * 32, IT_WGU = 16 * 176, IT_WD = 44 * 32, IT_WP = 4 * 8;
        constexpr int NITEMS = IT_WIN + IT_WOUT + 2 * IT_WGU + 2 * IT_WD + 4 * IT_WP;
        for (int it = gw; it < NITEMS; it += NGW) {
            int r = it;
            if (r >= IT_WIN) break;
            if (r < IT_WIN) { const int kb = r / 80, nb = r % 80; transpose_tile(a.in[I_WIN], NIN, nb * 32, kb * 64, a.in[I_NM], WIN, D, nb * 32, scr, lane); continue; } r -= IT_WIN;
            if (r < IT_WOUT) { const int kb = r / 32, nb = r % 32; transpose_tile(a.in[I_WOUT], D, nb * 32, kb * 64, nullptr, WOUT, D, nb * 32, scr, lane); continue; } r -= IT_WOUT;
            if (r < 2 * IT_WGU) { const int l = r / IT_WGU; r -= l * IT_WGU; const int kb = r / 176, nb = r % 176; const int n0 = nb * 32;
                const float* src = ((n0 & 128) ? a.in[I_FU] : a.in[I_FG]) + (size_t)l * D * FF; const int sc0 = (n0 >> 8) * 128 + (n0 & 127);
                transpose_tile(src, FF, sc0, kb * 64, a.in[I_NF] + l * D, WGU + (size_t)l * NGU * D, D, n0, scr, lane); continue; } r -= 2 * IT_WGU;
            if (r < 2 * IT_WD) { const int l = r / IT_WD; r -= l * IT_WD; const int kb = r / 32, nb = r % 32;
                transpose_tile(a.in[I_FD] + (size_t)l * FF * D, D, nb * 32, kb * 64, nullptr, WD + (size_t)l * D * FF, FF, nb * 32, scr, lane); continue; } r -= 2 * IT_WD;
            { const int g = r / IT_WP; r -= g * IT_WP; const int kb = r / 8, nb = r % 8;
                transpose_tile(a.in[I_PW] + (size_t)g * 256 * 256, 256, nb * 32, kb * 64, nullptr, WP, 256, g * 256 + nb * 32, scr, lane, a.in[I_PS]); }
        }
        for (int i = gt; i < 1024 * 128; i += NGT) { const int np = i >> 7, kk = i & 127; const int pn = np >> 8, bj = (np >> 7) & 1, j = np & 127; const int c = 128 * pn + j, cin = 128 * pn + kk;
            float v = 0.f; if ((cin >> 6) == (c >> 6)) v = (bj ? a.in[I_IGW] : a.in[I_RGW])[(size_t)(c >> 6) * 4096 + (cin & 63) * 64 + (c & 63)];
            WG[i] = (bf16_t)(cvt_pk_bf16(v, 0.f) & 0xffffu); }
        for (int m0 = gw; m0 < M; m0 += 2 * NGW) { const int m1 = m0 + NGW; const bool has1 = m1 < M;
            const float* xr0 = (m0 < MP) ? a.in[I_XP] + (size_t)m0 * D : a.in[I_XS] + (size_t)(m0 - MP) * D;
            const float* xr1 = has1 ? ((m1 < MP) ? a.in[I_XP] + (size_t)m1 * D : a.in[I_XS] + (size_t)(m1 - MP) * D) : xr0;
            f32x4 v0[4], v1[4]; float s0 = 0.f, s1 = 0.f;
#pragma unroll
            for (int j = 0; j < 4; ++j) { v0[j] = ((const f32x4*)xr0)[lane + 64 * j]; v1[j] = ((const f32x4*)xr1)[lane + 64 * j]; }
#pragma unroll
            for (int j = 0; j < 4; ++j) { s0 += (v0[j][0] * v0[j][0] + v0[j][1] * v0[j][1]) + (v0[j][2] * v0[j][2] + v0[j][3] * v0[j][3]); s1 += (v1[j][0] * v1[j][0] + v1[j][1] * v1[j][1]) + (v1[j][2] * v1[j][2] + v1[j][3] * v1[j][3]); }
            const float rs0 = rsqrtf(wave_sum(s0) * (1.f / D) + EPS), rs1 = rsqrtf(wave_sum(s1) * (1.f / D) + EPS);
#pragma unroll
            for (int j = 0; j < 4; ++j) { u32x2 w; w.x = cvt_pk_bf16(v0[j][0] * rs0, v0[j][1] * rs0); w.y = cvt_pk_bf16(v0[j][2] * rs0, v0[j][3] * rs0); ((u32x2*)(XB + (size_t)m0 * D))[lane + 64 * j] = w; }
            if (has1) {
#pragma unroll
                for (int j = 0; j < 4; ++j) { u32x2 w; w.x = cvt_pk_bf16(v1[j][0] * rs1, v1[j][1] * rs1); w.y = cvt_pk_bf16(v1[j][2] * rs1, v1[j][3] * rs1); ((u32x2*)(XB + (size_t)m1 * D))[lane + 64 * j] = w; } } }
    }
    xcd_barrier(xbar);
    if (a.out == nullptr) grid.sync();
    pg8::StaticOrder S;
    PH(1)
    { pg8::Gemm g{XB, WIN, M, NIN, D, D, 0}; pg8::G1Order S1; S1.init(G, bx); EpiG1 E{QB, GG, U, out, KB, VT}; pg8::gemm_phase(L, g, S1, E); }
    xcd_barrier(xbar);
    PH(2)
    {
        const float* cw = a.in[I_CW]; const float* cbias = a.in[I_CB];
        for (int idx = gt; idx < (M / 8) * 128; idx += NGT) { const int strip = idx >> 7, c4 = (idx & 127) * 4; const int row0 = strip * 8;
            int pos0, T, seq; const bool samp = row0 >= MP; if (!samp) { pos0 = row0 & 4095; T = 4096; seq = row0 >> 12; } else { pos0 = (row0 - MP) & 31; T = 32; seq = (row0 - MP) >> 5; }
            f32x4 uu[11];
#pragma unroll
            for (int j = 0; j < 11; ++j) { const int p = pos0 - 3 + j;
                if (p >= 0) uu[j] = bf4(*(const u32x2*)(U + (size_t)(row0 - 3 + j) * 512 + c4));
                else if (samp) uu[j] = *(const f32x4*)(a.in[I_LC] + ((size_t)seq * 3 + (3 + p)) * 512 + c4);
                else uu[j] = (f32x4){0.f, 0.f, 0.f, 0.f}; }
            const f32x4 cb4 = *(const f32x4*)(cbias + c4), w0 = *(const f32x4*)(cw + c4), w1 = *(const f32x4*)(cw + 512 + c4), w2 = *(const f32x4*)(cw + 1024 + c4), w3 = *(const f32x4*)(cw + 1536 + c4);
#pragma unroll
            for (int t = 0; t < 8; ++t) { const f32x4 accv = cb4 + uu[t] * w0 + uu[t + 1] * w1 + uu[t + 2] * w2 + uu[t + 3] * w3;
                u32x2 w; w.x = cvt_pk_bf16(accv[0], accv[1]); w.y = cvt_pk_bf16(accv[2], accv[3]); *(u32x2*)(UCB + (size_t)(row0 + t) * 512 + c4) = w;
                if (pos0 + t >= T - 3) *(f32x4*)(out + (samp ? OFF_CS : OFF_CP) + ((size_t)seq * 3 + (pos0 + t - (T - 3))) * 512 + c4) = uu[t + 3]; } }
    }
    xcd_barrier(xbar);
    PH(3)
    { pg8::Gemm g{UCB, WG, M, 1024, 128, 512, 128}; S.init(M, 1024, G, bx); EpiGate E{a.in[I_RGB], a.in[I_IGB], SPL, UCB, AX}; pg8::gemm_phase(L, g, S, E); }
    PH(3)
    { pg8::Gemm g{XB, WIN, M, NIN, D, D, 0}; pg8::G1Tail S2; S2.init(G, bx); EpiG1 E{QB, GG, U, out, KB, VT}; pg8::gemm_phase(L, g, S2, E); }
    PH(3)
    { const int b0 = (G > 56) ? 56 : 0; if (bx >= b0) { LAS float* scr = (LAS float*)(L + wave * 16384); const int dw = (bx - b0) * 8 + wave, NDW = (G - b0) * 8;
        for (int it = dw; it < 16 * 32; it += NDW) { const int kb = it / 32, nb = it % 32; transpose_tile(a.in[I_WOUT], D, nb * 32, kb * 64, nullptr, WOUT, D, nb * 32, scr, lane); } } }
    PH(14) { unsigned* actr = (unsigned*)(ws + WS_BAR) + 3584;
        unsigned u = (unsigned)gw;
        while (u < 1056u * 8u) {
            unsigned nx = 0; if (lane == 0) nx = atomicAdd(actr, 1u) + (unsigned)NGW;
            if (u < 256u) { const int uu = (int)(8192u + u); attn_unit<false>(a, QB, AO, KB, VT, uu >> 3, uu & 7, lane); } else { const int uu = (int)(u - 256u); attn_unit<true>(a, QB, AO, KB, VT, uu >> 3, uu & 7, lane); }
            u = (unsigned)__builtin_amdgcn_readfirstlane((int)nx); } }
    xcd_barrier(xbar);
    PH(4)
    for (int u = gw; u < 512 * 8; u += NGW) { const int chunk = u >> 3, c = (u & 7) * 64 + lane; const size_t base = (size_t)chunk * 64 * 512 + c;
        float hl = 0.f, ap = 1.f;
#pragma unroll 32
        for (int t = 0; t < 64; ++t) { const unsigned pk = AX[base + (size_t)t * 512]; const float av = 1.f - __uint_as_float(pk << 16), xv = __uint_as_float(pk & 0xffff0000u); hl = av * hl + xv; ap *= av; }
        SUMA[chunk * 512 + c] = ap; SUMH[chunk * 512 + c] = hl; }
    xcd_barrier(xbar);
    PH(5)
    for (int u = gw; u < 512 * 8 + 32 * 8; u += NGW) {
        const bool samp = u >= 4096; int row0, nt, c; float hcur; bool lastc; float* hout;
        if (!samp) { const int chunk = u >> 3; c = (u & 7) * 64 + lane; const int b = chunk >> 6, ci = chunk & 63; row0 = chunk * 64; nt = 64; hcur = 0.f;
            for (int j0 = 0; j0 < ci; j0 += 8) { float sa[8], sh[8];
#pragma unroll
                for (int k = 0; k < 8; ++k) { const bool ok = (j0 + k) < ci; const int jj = ok ? (j0 + k) : j0; sa[k] = SUMA[(b * 64 + jj) * 512 + c]; sh[k] = SUMH[(b * 64 + jj) * 512 + c]; if (!ok) { sa[k] = 1.f; sh[k] = 0.f; } }
#pragma unroll
                for (int k = 0; k < 8; ++k) hcur = sa[k] * hcur + sh[k]; }
            lastc = (ci == 63); hout = out + OFF_HP + b * 512 + c; }
        else { const int v = u - 4096; const int bs = v >> 3; c = (v & 7) * 64 + lane; row0 = MP + bs * 32; nt = 32; hcur = a.in[I_LH][bs * 512 + c]; lastc = true; hout = out + OFF_HS + bs * 512 + c; }
        const size_t base = (size_t)row0 * 512 + c;
        for (int t0 = 0; t0 < nt; t0 += 32) { unsigned pk[32]; bf16_t gg[32];
#pragma unroll
            for (int k = 0; k < 32; ++k) { pk[k] = AX[base + (size_t)(t0 + k) * 512]; gg[k] = GG[base + (size_t)(t0 + k) * 512]; }
#pragma unroll
            for (int k = 0; k < 32; ++k) { const float av = 1.f - __uint_as_float(pk[k] << 16), xv = __uint_as_float(pk[k] & 0xffff0000u); hcur = av * hcur + xv;
                AO[(size_t)(row0 + t0 + k) * D + 512 + c] = (bf16_t)(cvt_pk_bf16(hcur * bf2f(gg[k]), 0.f) & 0xffffu); } }
        if (lastc) *hout = hcur; }
    xcd_barrier(xbar);
    PH(6)
    { pg8::Gemm g{AO, WOUT, M, D, D, D, 0}; S.init(M, D, G, bx); EpiRes<true> E{a.in[I_XP], a.in[I_XS], XB, SSQ, nullptr}; pg8::gemm_phase(L, g, S, E); }
    PH(6)
    { const int rem = (M / 256 * (D / 256)) % G; const int b0 = rem; const int nblk = G - b0;
      if (bx >= b0) { LAS float* scr = (LAS float*)(L + wave * 16384); const int dw = (bx - b0) * 8 + wave, NDW = nblk * 8;
        constexpr int IT_WGU = 16 * 176, IT_WD = 44 * 32, IT_WP = 4 * 8;
        for (int it = dw; it < IT_WGU + IT_WD + 4 * IT_WP; it += NDW) {
            int r = it;
            if (r < IT_WGU) { const int kb = r / 176, nb = r % 176; const int n0 = nb * 32;
                const float* src = (n0 & 128) ? a.in[I_FU] : a.in[I_FG]; const int sc0 = (n0 >> 8) * 128 + (n0 & 127);
                transpose_tile(src, FF, sc0, kb * 64, a.in[I_NF], WGU, D, n0, scr, lane); continue; } r -= IT_WGU;
            if (r < IT_WD) { const int kb = r / 32, nb = r % 32; transpose_tile(a.in[I_FD], D, nb * 32, kb * 64, nullptr, WD, FF, nb * 32, scr, lane); continue; } r -= IT_WD;
            { const int g = r / IT_WP; r -= g * IT_WP; const int kb = r / 8, nb = r % 8;
                transpose_tile(a.in[I_PW] + (size_t)g * 256 * 256, 256, nb * 32, kb * 64, nullptr, WP, 256, g * 256 + nb * 32, scr, lane, a.in[I_PS]); }
        } } }
    xcd_barrier(xbar);
    PH(7)
    { pg8::Gemm g{XB, WGU, M, NGU, D, D, 0}; S.init(M, NGU, G, bx); EpiSwiglu E{SSQ, H}; pg8::gemm_phase(L, g, S, E); }
    PH(7)
    { const int rem = (M / 256 * (NGU / 256)) % G; const int b0 = rem; const int nblk = G - b0;
      if (bx >= b0) { LAS float* scr = (LAS float*)(L + wave * 16384); const int dw = (bx - b0) * 8 + wave, NDW = nblk * 8;
        constexpr int IT_WGU = 16 * 176, IT_WD = 44 * 32;
        for (int it = dw; it < IT_WGU + IT_WD; it += NDW) {
            int r = it;
            if (r < IT_WGU) { const int kb = r / 176, nb = r % 176; const int n0 = nb * 32;
                const float* src = ((n0 & 128) ? a.in[I_FU] : a.in[I_FG]) + (size_t)D * FF; const int sc0 = (n0 >> 8) * 128 + (n0 & 127);
                transpose_tile(src, FF, sc0, kb * 64, a.in[I_NF] + D, WGU + (size_t)NGU * D, D, n0, scr, lane); continue; } r -= IT_WGU;
            { const int kb = r / 32, nb = r % 32; transpose_tile(a.in[I_FD] + (size_t)FF * D, D, nb * 32, kb * 64, nullptr, WD + (size_t)D * FF, FF, nb * 32, scr, lane); }
        } } }
    xcd_barrier(xbar);
    PH(8)
    { pg8::Gemm g{H, WD, M, D, FF, FF, 0}; pg8::TailOrder ST; ST.init(FF, G, bx); EpiRes<false, true> E{nullptr, nullptr, XB, SSQ + M, PART}; pg8::gemm_phase(L, g, ST, E); }
    xcd_barrier(xbar);
    PH(9)
    {
        const float* ssq2 = SSQ + M; const float* gm = a.in[I_NM] + D; const float* pbuf = a.in[I_SP]; const LAS float* ldsrs = (const LAS float*)L;
        for (int idx = gt; idx < (MP / PR) * 256; idx += NGT) { const int strip = idx >> 8, c4 = (idx & 255) * 4; const int row0 = strip * PR, pos0 = row0 & 4095, seq = row0 >> 12;
            switch (c4 >> 8) {
                case 0: pool_strip<2, false>(XB, AO, out + OFF_PP, ssq2, ldsrs, pbuf, gm, row0, pos0, seq, 4096, c4); break;
                case 1: pool_strip<4, false>(XB, AO, out + OFF_PP, ssq2, ldsrs, pbuf, gm, row0, pos0, seq, 4096, c4); break;
                case 2: pool_strip<8, false>(XB, AO, out + OFF_PP, ssq2, ldsrs, pbuf, gm, row0, pos0, seq, 4096, c4); break;
                default: pool_strip<16, false>(XB, AO, out + OFF_PP, ssq2, ldsrs, pbuf, gm, row0, pos0, seq, 4096, c4); break; } }
        for (int sidx = bx; sidx < 32; sidx += G) {
            __syncthreads();
#pragma unroll
            for (int j = 0; j < 4; ++j) { const int r = wave * 4 + j; u32x2* xr = (u32x2*)(XB + (size_t)(MP + sidx * 32 + r) * D); const f32x4* pr = (const f32x4*)(PART + (size_t)(sidx * 32 + r) * D); float sq = 0.f;
#pragma unroll
                for (int q = 0; q < 4; ++q) { f32x4 v = bf4(xr[lane + 64 * q]);
#pragma unroll
                    for (int ks = 0; ks < 11; ++ks) v = v + pr[(size_t)ks * (MS * D / 4) + lane + 64 * q];
                    u32x2 wv; wv.x = cvt_pk_bf16(v[0], v[1]); wv.y = cvt_pk_bf16(v[2], v[3]); xr[lane + 64 * q] = wv; sq += (v[0] * v[0] + v[1] * v[1]) + (v[2] * v[2] + v[3] * v[3]); }
                sq = wave_sum(sq); if (lane == 0) ((LAS float*)L)[r] = rsqrtf(sq * (1.f / D) + EPS); }
            asm volatile("s_waitcnt vmcnt(0)" ::: "memory"); __threadfence_block(); __syncthreads();
            const int c4 = (tid & 255) * 4, half = tid >> 8;
            for (int sub = 0; sub < 16 / PR; ++sub) { const int pos0 = half * 16 + sub * PR, row0 = MP + sidx * 32 + pos0;
            switch (c4 >> 8) {
                case 0: pool_strip<2, true>(XB, AO, out + OFF_PS, ssq2, ldsrs, pbuf, gm, row0, pos0, sidx, 32, c4); break;
                case 1: pool_strip<4, true>(XB, AO, out + OFF_PS, ssq2, ldsrs, pbuf, gm, row0, pos0, sidx, 32, c4); break;
                case 2: pool_strip<8, true>(XB, AO, out + OFF_PS, ssq2, ldsrs, pbuf, gm, row0, pos0, sidx, 32, c4); break;
                default: pool_strip<16, true>(XB, AO, out + OFF_PS, ssq2, ldsrs, pbuf, gm, row0, pos0, sidx, 32, c4); break; } } }
    }
    xcd_barrier(xbar);
    PH(10)
    { pg8::Gemm g{AO  , WP, M, D, 256, D, 256}; S.init(M, D, G, bx); EpiRes<false> E{nullptr, nullptr, XB, SSQ + 2 * M, nullptr}; pg8::gemm_phase(L, g, S, E); }
    xcd_barrier(xbar);
    PH(11)
    { pg8::Gemm g{XB, WGU + (size_t)NGU * D, M, NGU, D, D, 0}; S.init(M, NGU, G, bx); EpiSwiglu E{SSQ + 2 * M, H}; pg8::gemm_phase(L, g, S, E); }
    xcd_barrier(xbar);
    PH(12)
    { pg8::Gemm g{H, WD + (size_t)D * FF, M, D, FF, FF, 0}; pg8::TailOrder ST; ST.init(FF, G, bx); EpiRes<false, true> E{nullptr, nullptr, XB, SSQ + 3 * M, PART}; pg8::gemm_phase(L, g, ST, E); }
    xcd_barrier(xbar);
    PH(13)
    { const float* ssq4 = SSQ + 3 * M; const f32x4* gf = (const f32x4*)a.in[I_NFIN];
      for (int m0 = gw; m0 < M; m0 += 2 * NGW) {
          const int m1 = (m0 + NGW < M) ? m0 + NGW : m0; const bool has1 = m0 + NGW < M;
          const u32x2* p0 = (const u32x2*)(XB + (size_t)m0 * D); const u32x2* p1 = (const u32x2*)(XB + (size_t)m1 * D); u32x2 r0[4], r1[4];
#pragma unroll
          for (int q = 0; q < 4; ++q) { r0[q] = p0[lane + 64 * q]; r1[q] = p1[lane + 64 * q]; }
#pragma unroll
          for (int rr = 0; rr < 2; ++rr) { if (rr == 1 && !has1) break; const int m = rr ? m1 : m0; f32x4 v[4]; float sq = 0.f;
#pragma unroll
              for (int q = 0; q < 4; ++q) v[q] = bf4(rr ? r1[q] : r0[q]);
              if (m >= MP) { const f32x4* pr = (const f32x4*)(PART + (size_t)(m - MP) * D);
#pragma unroll
                  for (int ks = 0; ks < 11; ++ks)
#pragma unroll
                      for (int q = 0; q < 4; ++q) v[q] = v[q] + pr[(size_t)ks * (MS * D / 4) + lane + 64 * q]; }
#pragma unroll
              for (int q = 0; q < 4; ++q) sq += (v[q][0] * v[q][0] + v[q][1] * v[q][1]) + (v[q][2] * v[q][2] + v[q][3] * v[q][3]);
              const float ss = (m >= MP) ? wave_sum(sq) : ssq4[m]; const float rs = rsqrtf(ss * (1.f / D) + EPS);
              f32x4* yo = (f32x4*)(out + OFF_Y + (size_t)m * D);
#pragma unroll
              for (int q = 0; q < 4; ++q) yo[lane + 64 * q] = v[q] * rs * gf[lane + 64 * q]; } } }
}

#undef ws
#undef SSQ
#undef SUMA
#undef SUMH
#undef KB
#undef VT
#undef PART
#undef SPL
#undef WIN
#undef WG
#undef WOUT
#undef WGU
#undef WD
#undef WP
#undef XB
#undef QB
#undef GG
#undef UCB
#undef U
#undef AX
#undef AO
#undef H
extern "C" void kernel_launch(void* const* d_in, const int* in_sizes, int n_in, void* d_out, int out_size, void* d_ws, size_t ws_size, hipStream_t stream) {
    static int grid = 0;
    if (grid == 0) {
        if (n_in != 24 || out_size != (int)OUT_TOTAL || ws_size < WS_END) { fprintf(stderr, "kernel_launch: unexpected shapes (n_in %d out %d ws %zu)\n", n_in, out_size, ws_size); grid = -1; return; }
        int dev = 0, cus = 0, per_cu = 0;
        hipGetDevice(&dev); hipDeviceGetAttribute(&cus, hipDeviceAttributeMultiprocessorCount, dev);
        hipFuncSetAttribute((const void*)fwd_kernel, hipFuncAttributeMaxDynamicSharedMemorySize, LDS_BYTES);
        hipOccupancyMaxActiveBlocksPerMultiprocessor(&per_cu, (const void*)fwd_kernel, 512, LDS_BYTES);
        if (per_cu < 1) { fprintf(stderr, "kernel_launch: occupancy query says %d blocks/CU\n", per_cu); per_cu = 1; }
        (void)hipGetLastError();
        grid = cus * per_cu;
    }
    if (grid < 0) return;
    (void)hipMemsetAsync((char*)d_ws + WS_BAR, 0, 16384, stream);
    Args a{};
    for (int i = 0; i < 24; ++i) a.in[i] = (const float*)d_in[i];
    a.out = (float*)d_out; a.ws = (unsigned char*)d_ws;
    void* params[] = {&a};
    hipError_t e = hipLaunchCooperativeKernel((const void*)fwd_kernel, dim3(grid), dim3(512), params, LDS_BYTES, stream);
    if (e != hipSuccess) fprintf(stderr, "cooperative launch failed: %s (grid %d)\n", hipGetErrorString(e), grid);
}
```

```cpp
#include <hip/hip_runtime.h>
#include <hip/hip_cooperative_groups.h>
#include <cstdio>
#include <cstdint>
namespace cg = cooperative_groups;

constexpr int MP = 32768;
constexpr int MS = 1024;
constexpr int M = MP + MS;
constexpr int D = 1024, NIN = 2560, FF = 2816, NGU = 2 * FF;
constexpr float EPS = 1e-6f;
constexpr size_t OFF_Y = 0, OFF_KP = 34603008, OFF_VP = 51380224, OFF_HP = 68157440, OFF_CP = 68161536, OFF_PP = 68173824,
                 OFF_KS = 68296704, OFF_VS = 68820992, OFF_HS = 69345280, OFF_CS = 69361664, OFF_PS = 69410816, OUT_TOTAL = 69902336;
constexpr size_t MiB = 1u << 20;
constexpr size_t WS_SSQ = 0, WS_SUM = 1 * MiB, WS_SPL = 3 * MiB, WS_BAR = 3 * MiB + 512 * 1024, WS_WIN = 4 * MiB, WS_WG = 9 * MiB, WS_WOUT = 10 * MiB, WS_WGU = 12 * MiB, WS_WD = 34 * MiB, WS_WP = 45 * MiB,
                 WS_XB = 48 * MiB, WS_QB = 114 * MiB, WS_GG = 147 * MiB, WS_UCB = 180 * MiB, WS_U = 213 * MiB, WS_UC = 279 * MiB, WS_KB = 279 * MiB  , WS_VT = 312 * MiB  , WS_AA = 345 * MiB, WS_XIN = 411 * MiB,
                 WS_AO = 477 * MiB, WS_H = 213 * MiB  , WS_PART = 543 * MiB  , WS_END = 587 * MiB;
static_assert(WS_H + (size_t)M * FF * 2 <= WS_AO, "H overlay");
constexpr int LDS_BYTES = 147456;

namespace pg8 {
#define PG8_LAS __attribute__((address_space(3)))
typedef unsigned short bf16_t;
typedef short bf16x8 __attribute__((ext_vector_type(8)));
typedef float f32x4 __attribute__((ext_vector_type(4)));
typedef unsigned u32x4 __attribute__((ext_vector_type(4)));
typedef unsigned u32x2 __attribute__((ext_vector_type(2)));
constexpr int BM = 256, BK = 64, HALF = 128, HTB = HALF * BK * 2, STAGE_BYTES = 8 * HTB, NXCD = 8, WGM = 8;

__host__ __device__ __forceinline__ int lds_byte(int r, int c) { const int st = (r >> 4) * 2 + (c >> 5), rr = r & 15, cc = c & 31, ob = rr * 64 + cc * 2; return st * 1024 + (ob ^ (((ob >> 9) & 1) << 5)); }
__host__ __device__ __forceinline__ void stage_rc(int b, int& R, int& C) { const int st = b / 1024, sb = b % 1024, swz = sb ^ (((sb >> 9) & 1) << 5); R = (st >> 1) * 16 + swz / 64; C = (st & 1) * 32 + (swz % 64) / 2; }
__host__ __device__ __forceinline__ int perm32(int rho) { const int n = rho >> 4, i = rho & 15; return 8 * (i >> 2) + 4 * n + (i & 3); }

struct Unit { int pm, pn, kb, nk; };
struct Gemm { const bf16_t* A; const bf16_t* Bt; int M, N, K, lda, acs; };

__device__ __forceinline__ bool static_tile(int i, int nM, int nN, int G, int c, int& pm, int& pn) {
    const int nwg = nM * nN; const long Lx = (long)i * G + c; if (Lx >= nwg) return false;
    int wgid = (int)Lx; { const int q = nwg / NXCD, r = nwg % NXCD, xcd = wgid % NXCD, off = wgid / NXCD; wgid = (xcd < r ? xcd * (q + 1) : r * (q + 1) + (xcd - r) * q) + off; }
    const int nig = WGM * nN, gid = wgid / nig, fm = gid * WGM, gsz = (nM - fm) < WGM ? (nM - fm) : WGM;
    pm = fm + ((wgid % nig) % gsz); pn = (wgid % nig) / gsz; return true;
}
struct StaticOrder {
    static constexpr bool SPLIT = false;
    int nM, nN, G, c;
    __device__ __forceinline__ void init(int M_, int N_, int G_, int c_) { nM = M_ / BM; nN = N_ / BM; G = G_; c = c_; }
    __device__ __forceinline__ bool next(int i, Unit& u) const { u.kb = 0; u.nk = 0; return static_tile(i, nM, nN, G, c, u.pm, u.pn); }
};

struct G1Order {
    static constexpr bool SPLIT = false;
    int G, c;
    __device__ __forceinline__ void init(int G_, int c_) { G = G_; c = c_; }
    __device__ __forceinline__ bool next(int i, Unit& u) const { u.kb = 0; u.nk = 0; const int Lx = i * G + c; if (Lx >= 1280) return false;
        if (Lx < 1056) { static_tile(0, 132, 8, 0, Lx, u.pm, u.pn); return true; }
        const int idx = Lx - 1056; u.pm = idx >> 1; u.pn = 8 + (idx & 1); return true; }
};
struct G1Tail {
    static constexpr bool SPLIT = false;
    int G, c;
    __device__ __forceinline__ void init(int G_, int c_) { G = G_; c = c_; }
    __device__ __forceinline__ bool next(int i, Unit& u) const { u.kb = 0; u.nk = 0; const int idx = i * G + ((c + G - 16) % G); if (idx >= 40) return false;
        u.pm = 112 + (idx >> 1); u.pn = 8 + (idx & 1); return true; }
};

struct TailOrder {
    static constexpr bool SPLIT = true;
    int G, c, nm, nkfull;
    __device__ __forceinline__ void init(int K_, int G_, int c_) { G = G_; c = c_; nm = (c_ < 512) ? (512 - c_ + G_ - 1) / G_ : 0; nkfull = K_ / BK; }
    __device__ __forceinline__ bool next(int i, Unit& u) const {
        if (i < nm) { static_tile(i, 128, 4, G, c, u.pm, u.pn); u.kb = 0; u.nk = nkfull; return true; }
        const int t = (i - nm) * G + c; if (t >= 16 * 11) return false;
        const int tile = t / 11, ks = t - tile * 11; u.pm = 128 + (tile >> 2); u.pn = tile & 3; u.kb = ks * 4; u.nk = 4; return true;
    }
};

__device__ __forceinline__ unsigned cvt_pk_bf16(float lo, float hi) { unsigned r; asm volatile("v_cvt_pk_bf16_f32 %0, %1, %2" : "=v"(r) : "v"(lo), "v"(hi)); return r; }

template <class Epi, class Sched>
__device__ __forceinline__ void gemm_phase(PG8_LAS unsigned char* lds, const Gemm g, const Sched& S, const Epi& E) {
    int tid = threadIdx.x; asm volatile("" : "+v"(tid));
    const int wid = __builtin_amdgcn_readfirstlane(tid >> 6), lane = tid & 63, wr = wid >> 2, wc = wid & 3, fr = lane & 15, fq = lane >> 4;
    int K = g.K; asm volatile("" : "+s"(K));
    const int ntfull = K / BK;
    unsigned voffA[2], voffB[2];
#pragma unroll
    for (int i = 0; i < 2; ++i) { int R, C; stage_rc(tid * 16 + i * 8192, R, C); const int Rb = (R & ~31) + perm32(R & 31);
        voffA[i] = (unsigned)(R * g.lda + C) * 2u; voffB[i] = (unsigned)(Rb * K + C) * 2u; }
    const size_t kstep = (size_t)(BK * 2);
    const size_t hstepA = (size_t)HALF * g.lda * 2, hstepB = (size_t)HALF * K * 2;
    const unsigned ldsw = (unsigned)wid * 1024u;
    const int aoff = lds_byte(wr * 64 + fr, fq * 8), boff = lds_byte(wc * 32 + fr, fq * 8);
#define PG8_TA(u) ((const char*)g.A + ((size_t)(u).pm * BM * g.lda + (size_t)(u).pn * g.acs) * 2 + (Sched::SPLIT ? (size_t)(u).kb * (BK * 2) : 0))
#define PG8_TB(u) ((const char*)g.Bt + (size_t)(u).pn * BM * K * 2 + (Sched::SPLIT ? (size_t)(u).kb * (BK * 2) : 0))
#define PG8_SA(b, h) (((b) * 2 + (h)) * HTB)
#define PG8_SB(b, h) ((4 + (b) * 2 + (h)) * HTB)
#define PG8_STAGE(bufoff, gbase, voff) do { _Pragma("unroll") for (int _i = 0; _i < 2; ++_i) \
        __builtin_amdgcn_global_load_lds((const unsigned*)((const char*)(gbase) + (voff)[_i]), (PG8_LAS unsigned*)(lds + (bufoff) + ldsw + _i * 8192), 16, 0, 0); } while (0)
#define PG8_LDA(dst, b, h) do { _Pragma("unroll") for (int m = 0; m < 4; ++m) _Pragma("unroll") for (int k = 0; k < 2; ++k) dst[m][k] = *(const PG8_LAS bf16x8*)(lds + PG8_SA(b, h) + aoff + m * 2048 + k * 1024); } while (0)
#define PG8_LDB(dst, b, h) do { _Pragma("unroll") for (int n = 0; n < 2; ++n) _Pragma("unroll") for (int k = 0; k < 2; ++k) dst[n][k] = *(const PG8_LAS bf16x8*)(lds + PG8_SB(b, h) + boff + n * 2048 + k * 1024); } while (0)
#define PG8_MMA(ai, bj, At, Bt) do { __builtin_amdgcn_s_setprio(1); _Pragma("unroll") for (int m = 0; m < 4; ++m) _Pragma("unroll") for (int n = 0; n < 2; ++n) _Pragma("unroll") for (int k = 0; k < 2; ++k) \
        acc[ai][bj][m][n] = __builtin_amdgcn_mfma_f32_16x16x32_bf16(Bt[n][k], At[m][k], acc[ai][bj][m][n], 0, 0, 0); __builtin_amdgcn_s_setprio(0); } while (0)
#define PG8_WAIT_V(n) asm volatile("s_waitcnt vmcnt(" #n ")" ::: "memory")
#define PG8_WAIT_L(n) asm volatile("s_waitcnt lgkmcnt(" #n ")" ::: "memory")
#define PG8_BAR __builtin_amdgcn_s_barrier()
#define PG8_SCHED __builtin_amdgcn_sched_barrier(0)
    Unit cur, nxt; int ui = 0;
    if (!S.next(0, cur)) return;
    f32x4 acc[2][2][4][2];
    E.init(acc, cur, wr, wc, fr, fq);
    bf16x8 At[4][2], B0[2][2], B1[2][2];
    const char* cA = PG8_TA(cur); const char* cB = PG8_TB(cur);
    PG8_STAGE(PG8_SB(0, 0), cB, voffB); PG8_STAGE(PG8_SB(0, 1), cB + hstepB, voffB); PG8_STAGE(PG8_SA(0, 0), cA, voffA); PG8_STAGE(PG8_SA(0, 1), cA + hstepA, voffA);
    if (wr == 1) PG8_BAR;
    PG8_WAIT_V(2); PG8_BAR;
    PG8_STAGE(PG8_SB(1, 0), cB + kstep, voffB); PG8_STAGE(PG8_SA(1, 0), cA + kstep, voffA); PG8_STAGE(PG8_SB(1, 1), cB + hstepB + kstep, voffB);
    PG8_WAIT_V(6); PG8_BAR;
    for (;;) {
        const bool has_next = S.next(ui + 1, nxt);
        const char* nA = has_next ? PG8_TA(nxt) : cA; const char* nB = has_next ? PG8_TB(nxt) : cB;
        const int nt = Sched::SPLIT ? cur.nk : ntfull;
        for (int t = 0; t < nt; t += 2) {
            const bool last = (t == nt - 2);
            const char* a1 = cA + (size_t)(t + 1) * kstep;
            const char* a2 = last ? nA : cA + (size_t)(t + 2) * kstep; const char* b2 = last ? nB : cB + (size_t)(t + 2) * kstep;
            const char* a3 = a2 + kstep; const char* b3 = b2 + kstep;
            PG8_LDB(B0, 0, 0); PG8_LDB(B1, 0, 1); PG8_SCHED; PG8_LDA(At, 0, 0); PG8_STAGE(PG8_SA(1, 1), a1 + hstepA, voffA);
            PG8_WAIT_V(8); PG8_WAIT_L(0); PG8_BAR; PG8_MMA(0, 0, At, B0); PG8_MMA(0, 1, At, B1); PG8_BAR; PG8_SCHED;
            PG8_LDA(At, 0, 1); PG8_STAGE(PG8_SB(0, 0), b2, voffB); PG8_STAGE(PG8_SB(0, 1), b2 + hstepB, voffB); PG8_STAGE(PG8_SA(0, 0), a2, voffA);
            PG8_WAIT_V(8); PG8_WAIT_L(0); PG8_BAR; PG8_MMA(1, 0, At, B0); PG8_MMA(1, 1, At, B1); PG8_BAR; PG8_SCHED;
            PG8_LDB(B0, 1, 0); PG8_LDB(B1, 1, 1); PG8_SCHED; PG8_LDA(At, 1, 0); PG8_STAGE(PG8_SA(0, 1), a2 + hstepA, voffA);
            PG8_WAIT_V(8); PG8_WAIT_L(0); PG8_BAR; PG8_MMA(0, 0, At, B0); PG8_MMA(0, 1, At, B1); PG8_BAR; PG8_SCHED;
            PG8_LDA(At, 1, 1); PG8_STAGE(PG8_SB(1, 0), b3, voffB); PG8_STAGE(PG8_SB(1, 1), b3 + hstepB, voffB); PG8_STAGE(PG8_SA(1, 0), a3, voffA);
            PG8_WAIT_V(8); PG8_WAIT_L(0); PG8_BAR; PG8_MMA(1, 0, At, B0); PG8_MMA(1, 1, At, B1); PG8_BAR; PG8_SCHED;
        }
        if (wr == 0) PG8_BAR;
        E(acc, cur, wr, wc, fr, fq);
        if (!has_next) break;
        E.init(acc, nxt, wr, wc, fr, fq);
        cur = nxt; cA = nA; cB = nB; ++ui;
        if (wr == 1) PG8_BAR;
    }
    PG8_WAIT_V(0);
    PG8_BAR;
#undef PG8_TA
#undef PG8_TB
#undef PG8_SA
#undef PG8_SB
#undef PG8_STAGE
#undef PG8_LDA
#undef PG8_LDB
#undef PG8_MMA
#undef PG8_WAIT_V
#undef PG8_WAIT_L
#undef PG8_BAR
#undef PG8_SCHED
}
}

using pg8::bf16_t; using pg8::bf16x8; using pg8::f32x4; using pg8::u32x4; using pg8::u32x2; using pg8::Unit; using pg8::cvt_pk_bf16;
typedef float f32x16 __attribute__((ext_vector_type(16)));
#define LAS __attribute__((address_space(3)))

__device__ __forceinline__ float bf2f(bf16_t v) { return __uint_as_float((unsigned)v << 16); }
__device__ __forceinline__ float sigmoidf_(float x) { return 1.f / (1.f + __expf(-x)); }
__device__ __forceinline__ float gelu_tanh(float x) { const float y2 = 1.5957691216f * (x + 0.044715f * x * x * x); return x / (1.f + __expf(-y2)); }
__device__ __forceinline__ bf16x8 pack8(float a0, float a1, float a2, float a3, float a4, float a5, float a6, float a7) {
    u32x4 w; w.x = cvt_pk_bf16(a0, a1); w.y = cvt_pk_bf16(a2, a3); w.z = cvt_pk_bf16(a4, a5); w.w = cvt_pk_bf16(a6, a7); return __builtin_bit_cast(bf16x8, w); }

__device__ __forceinline__ f32x4 bf4lo(u32x4 r) { return (f32x4){__uint_as_float(r.x << 16), __uint_as_float(r.x & 0xffff0000u), __uint_as_float(r.y << 16), __uint_as_float(r.y & 0xffff0000u)}; }
__device__ __forceinline__ f32x4 bf4hi(u32x4 r) { return (f32x4){__uint_as_float(r.z << 16), __uint_as_float(r.z & 0xffff0000u), __uint_as_float(r.w << 16), __uint_as_float(r.w & 0xffff0000u)}; }
__device__ __forceinline__ f32x4 bf4(u32x2 r) { return (f32x4){__uint_as_float(r.x << 16), __uint_as_float(r.x & 0xffff0000u), __uint_as_float(r.y << 16), __uint_as_float(r.y & 0xffff0000u)}; }
__device__ __forceinline__ void acc_zero(f32x4 (&acc)[2][2][4][2]) {
#pragma unroll
    for (int a = 0; a < 2; ++a)
#pragma unroll
        for (int b = 0; b < 2; ++b)
#pragma unroll
            for (int m = 0; m < 4; ++m)
#pragma unroll
                for (int n = 0; n < 2; ++n) acc[a][b][m][n] = (f32x4){0.f, 0.f, 0.f, 0.f};
}
struct EpiG1 {
    bf16_t* QB; bf16_t* GG; bf16_t* U; float* out; bf16_t* KBp; bf16_t* VTp;
    __device__ __forceinline__ void init(f32x4 (&acc)[2][2][4][2], const Unit&, int, int, int, int) const { acc_zero(acc); }
    __device__ __forceinline__ void operator()(const f32x4 (&acc)[2][2][4][2], const Unit& u, int wr, int wc, int fr, int fq) const {
        const int region = u.pn >> 1; const int cb = (u.pn & 1) * 256 + wc * 32 + 8 * fq; const int row0 = u.pm * 256 + wr * 64 + fr;
        const bool samp = u.pm >= 128;
#pragma unroll
        for (int ai = 0; ai < 2; ++ai)
#pragma unroll
            for (int m = 0; m < 4; ++m) { const int row = row0 + ai * 128 + m * 16;
#pragma unroll
                for (int bj = 0; bj < 2; ++bj) { const int col = cb + bj * 128; const f32x4 v0 = acc[ai][bj][m][0], v1 = acc[ai][bj][m][1];
                    if (region == 0) { u32x4 w; const float qs = 0.125f * 1.44269504089f;     w.x = cvt_pk_bf16(v0[0] * qs, v0[1] * qs); w.y = cvt_pk_bf16(v0[2] * qs, v0[3] * qs); w.z = cvt_pk_bf16(v1[0] * qs, v1[1] * qs); w.w = cvt_pk_bf16(v1[2] * qs, v1[3] * qs);
                        *(u32x4*)(QB + (size_t)row * 512 + col) = w; }
                    else if (region == 1 || region == 2) {
                        float* o = out + (region == 1 ? (samp ? OFF_KS : OFF_KP) : (samp ? OFF_VS : OFF_VP)) + (size_t)(samp ? row - MP : row) * 512 + col;
                        *(f32x4*)o = v0; *(f32x4*)(o + 4) = v1;
                        if (!samp) { const unsigned w0 = cvt_pk_bf16(v0[0], v0[1]), w1 = cvt_pk_bf16(v0[2], v0[3]), w2 = cvt_pk_bf16(v1[0], v1[1]), w3 = cvt_pk_bf16(v1[2], v1[3]);
                            const int bh = (row >> 12) * 8 + (col >> 6), pos = row & 4095, d0 = col & 63;
                            if (region == 1) { u32x4 w; w.x = w0; w.y = w1; w.z = w2; w.w = w3; *(u32x4*)(KBp + ((size_t)((bh * 128 + (pos >> 5)) * 4 + (d0 >> 4)) * 512 + (pos & 31) * 16 + (d0 & 15))) = w; }
                            else { bf16_t* vt = VTp + ((size_t)(bh * 1024 + (pos >> 2)) * 64 + d0) * 4 + (pos & 3);
                                vt[0] = (bf16_t)(w0 & 0xffffu); vt[4] = (bf16_t)(w0 >> 16); vt[8] = (bf16_t)(w1 & 0xffffu); vt[12] = (bf16_t)(w1 >> 16);
                                vt[16] = (bf16_t)(w2 & 0xffffu); vt[20] = (bf16_t)(w2 >> 16); vt[24] = (bf16_t)(w3 & 0xffffu); vt[28] = (bf16_t)(w3 >> 16); } } }
                    else if (region == 3) { u32x4 w; w.x = cvt_pk_bf16(v0[0], v0[1]); w.y = cvt_pk_bf16(v0[2], v0[3]); w.z = cvt_pk_bf16(v1[0], v1[1]); w.w = cvt_pk_bf16(v1[2], v1[3]); *(u32x4*)(U + (size_t)row * 512 + col) = w; }
                    else { u32x4 w; w.x = cvt_pk_bf16(gelu_tanh(v0[0]), gelu_tanh(v0[1])); w.y = cvt_pk_bf16(gelu_tanh(v0[2]), gelu_tanh(v0[3])); w.z = cvt_pk_bf16(gelu_tanh(v1[0]), gelu_tanh(v1[1])); w.w = cvt_pk_bf16(gelu_tanh(v1[2]), gelu_tanh(v1[3]));
                        *(u32x4*)(GG + (size_t)row * 512 + col) = w; }
                } asm volatile("" ::: "memory"); }
    }
};
struct EpiGate {
    const float *rgb, *igb, *lam; const bf16_t* UCBp; unsigned* AX;
    __device__ __forceinline__ void init(f32x4 (&acc)[2][2][4][2], const Unit&, int, int, int, int) const { acc_zero(acc); }
    __device__ __forceinline__ void operator()(const f32x4 (&acc)[2][2][4][2], const Unit& u, int wr, int wc, int fr, int fq) const {
        const int row0 = u.pm * 256 + wr * 64 + fr; const int cb = u.pn * 128 + wc * 32 + 8 * fq;
        const f32x4 sp0 = *(const f32x4*)(lam + cb), sp1 = *(const f32x4*)(lam + cb + 4), rb0 = *(const f32x4*)(rgb + cb), rb1 = *(const f32x4*)(rgb + cb + 4), ib0 = *(const f32x4*)(igb + cb), ib1 = *(const f32x4*)(igb + cb + 4);
#pragma unroll
        for (int ai = 0; ai < 2; ++ai) {
            f32x4 ucv[4][2];
#pragma unroll
            for (int m = 0; m < 4; ++m) { const u32x4 raw = *(const u32x4*)(UCBp + (size_t)(row0 + ai * 128 + m * 16) * 512 + cb); ucv[m][0] = bf4lo(raw); ucv[m][1] = bf4hi(raw); }
#pragma unroll
            for (int m = 0; m < 4; ++m)
#pragma unroll
                for (int n = 0; n < 2; ++n) { const size_t off = (size_t)(row0 + ai * 128 + m * 16) * 512 + cb + 4 * n;
                    const f32x4 uv = ucv[m][n], sp = n ? sp1 : sp0, rb = n ? rb1 : rb0, ib = n ? ib1 : ib0; u32x4 pk;
#pragma unroll
                    for (int j = 0; j < 4; ++j) { const float r = sigmoidf_(acc[ai][0][m][n][j] + rb[j]), ig = sigmoidf_(acc[ai][1][m][n][j] + ib[j]);
                        const float la = sp[j] * r; const float ae = __expf(la); const float om = 1.f - ae; pk[j] = cvt_pk_bf16(om, sqrtf(om * (1.f + ae)) * ig * uv[j]); }
                    *(u32x4*)(AX + off) = pk; }
            asm volatile("" ::: "memory"); }
    }
};
template <bool FROMX, bool TAIL = false> struct EpiRes {
    const float* xP; const float* xS; bf16_t* XB; float* ssq; float* part;
    __device__ __forceinline__ void init(f32x4 (&acc)[2][2][4][2], const Unit& u, int wr, int wc, int fr, int fq) const {
        const bool samp = u.pm >= 128;
        if (TAIL && samp) { acc_zero(acc); return; }
        const int cb = u.pn * 256 + wc * 32 + 8 * fq; const int row0 = u.pm * 256 + wr * 64 + fr;
        if (FROMX) { const float* rbase = (samp ? xS : xP) + (size_t)(row0 - (samp ? MP : 0)) * D + cb;
#pragma unroll
            for (int ai = 0; ai < 2; ++ai)
#pragma unroll
                for (int m = 0; m < 4; ++m)
#pragma unroll
                    for (int bj = 0; bj < 2; ++bj) { const float* rp = rbase + (size_t)(ai * 128 + m * 16) * D + bj * 128; acc[ai][bj][m][0] = *(const f32x4*)rp; acc[ai][bj][m][1] = *(const f32x4*)(rp + 4); } }
        else { const bf16_t* rbase = XB + (size_t)row0 * D + cb;
#pragma unroll
            for (int ai = 0; ai < 2; ++ai)
#pragma unroll
                for (int m = 0; m < 4; ++m)
#pragma unroll
                    for (int bj = 0; bj < 2; ++bj) { const u32x4 raw = *(const u32x4*)(rbase + (size_t)(ai * 128 + m * 16) * D + bj * 128); acc[ai][bj][m][0] = bf4lo(raw); acc[ai][bj][m][1] = bf4hi(raw); } }
    }
    __device__ __forceinline__ void operator()(const f32x4 (&acc)[2][2][4][2], const Unit& u, int wr, int wc, int fr, int fq) const {
        const int cb = u.pn * 256 + wc * 32 + 8 * fq; const int row0 = u.pm * 256 + wr * 64 + fr; const bool samp = u.pm >= 128;
        if (TAIL && samp) {
#pragma unroll
            for (int ai = 0; ai < 2; ++ai)
#pragma unroll
                for (int m = 0; m < 4; ++m) { const int row = row0 + ai * 128 + m * 16;
#pragma unroll
                    for (int bj = 0; bj < 2; ++bj) { float* xo = part + ((size_t)(u.kb >> 2) * MS + (row - MP)) * D + cb + bj * 128;
                        *(f32x4*)xo = acc[ai][bj][m][0]; *(f32x4*)(xo + 4) = acc[ai][bj][m][1]; } }
            return;
        }
#pragma unroll
        for (int ai = 0; ai < 2; ++ai)
#pragma unroll
            for (int m = 0; m < 4; ++m) { const int row = row0 + ai * 128 + m * 16; float s = 0.f;
#pragma unroll
                for (int bj = 0; bj < 2; ++bj) { const int col = cb + bj * 128; const f32x4 v0 = acc[ai][bj][m][0], v1 = acc[ai][bj][m][1];
                    u32x4 w; w.x = cvt_pk_bf16(v0[0], v0[1]); w.y = cvt_pk_bf16(v0[2], v0[3]); w.z = cvt_pk_bf16(v1[0], v1[1]); w.w = cvt_pk_bf16(v1[2], v1[3]); *(u32x4*)(XB + (size_t)row * D + col) = w;
                    s += (v0[0] * v0[0] + v0[1] * v0[1]) + (v0[2] * v0[2] + v0[3] * v0[3]) + (v1[0] * v1[0] + v1[1] * v1[1]) + (v1[2] * v1[2] + v1[3] * v1[3]); }
                s += __shfl_xor(s, 16); s += __shfl_xor(s, 32);
                if (fq == 0) atomicAdd(ssq + row, s); }
    }
};
struct EpiSwiglu {
    const float* ssq; bf16_t* H;
    __device__ __forceinline__ void init(f32x4 (&acc)[2][2][4][2], const Unit&, int, int, int, int) const { acc_zero(acc); }
    __device__ __forceinline__ void operator()(const f32x4 (&acc)[2][2][4][2], const Unit& u, int wr, int wc, int fr, int fq) const {
        const int col = u.pn * 128 + wc * 32 + 8 * fq; const int row0 = u.pm * 256 + wr * 64 + fr;
        float rsv[8];
#pragma unroll
        for (int i = 0; i < 8; ++i) rsv[i] = ssq[row0 + (i >> 2) * 128 + (i & 3) * 16];
#pragma unroll
        for (int ai = 0; ai < 2; ++ai)
#pragma unroll
            for (int m = 0; m < 4; ++m) { const int row = row0 + ai * 128 + m * 16; const float rs = rsqrtf(rsv[ai * 4 + m] * (1.f / D) + EPS); float h[8];
#pragma unroll
                for (int j = 0; j < 8; ++j) { const float gv = acc[ai][0][m][j >> 2][j & 3] * rs, uv = acc[ai][1][m][j >> 2][j & 3] * rs; h[j] = gv / (1.f + __expf(-gv)) * uv; }
                u32x4 w; w.x = cvt_pk_bf16(h[0], h[1]); w.y = cvt_pk_bf16(h[2], h[3]); w.z = cvt_pk_bf16(h[4], h[5]); w.w = cvt_pk_bf16(h[6], h[7]);
                *(u32x4*)(H + (size_t)row * FF + col) = w; }
    }
};

struct Args { const float* in[24]; float* out; unsigned char* ws; };
enum { I_XP = 0, I_XS, I_CK, I_CV, I_LH, I_LC, I_SP, I_WIN, I_CW, I_CB, I_RGW, I_RGB, I_IGW, I_IGB, I_LAM, I_WOUT, I_PW, I_PS, I_NM, I_NF, I_FG, I_FU, I_FD, I_NFIN };

__device__ __forceinline__ void transpose_tile(const float* W, int ldw, int srccol0, int k0, const float* gamma, bf16_t* WT, int ldwt, int dstrow0, LAS float* scr, int lane, const float* nscale = nullptr) {
    const float ns = nscale ? nscale[dstrow0 + (lane & 31)] : 1.f;
#pragma unroll
    for (int i = 0; i < 32; ++i) { const int kk = 2 * i + (lane >> 5); float v = W[(size_t)(k0 + kk) * ldw + srccol0 + (lane & 31)]; if (gamma) v *= gamma[k0 + kk]; scr[kk * 33 + (lane & 31)] = v * ns; }
    asm volatile("s_waitcnt lgkmcnt(0)" ::: "memory");
    const int c = lane & 7;
#pragma unroll
    for (int j = 0; j < 4; ++j) { const int n = (lane >> 3) + 8 * j; const LAS float* s = scr + (8 * c) * 33 + n;
        u32x4 o; o.x = cvt_pk_bf16(s[0 * 33], s[1 * 33]); o.y = cvt_pk_bf16(s[2 * 33], s[3 * 33]); o.z = cvt_pk_bf16(s[4 * 33], s[5 * 33]); o.w = cvt_pk_bf16(s[6 * 33], s[7 * 33]);
        *(u32x4*)(WT + (size_t)(dstrow0 + n) * ldwt + k0 + 8 * c) = o; }
    asm volatile("s_waitcnt lgkmcnt(0)" ::: "memory");
}
__device__ __forceinline__ float wave_sum(float v) {
#pragma unroll
    for (int o = 1; o < 64; o <<= 1) v += __shfl_xor(v, o);
    return v;
}
__device__ __forceinline__ int crow(int r, int hi) { return (r & 3) + 8 * (r >> 2) + 4 * hi; }

template <bool PR>
__device__ __forceinline__ void attn_unit(const Args& a, const bf16_t* QB, bf16_t* AO, const bf16_t* KBp, const bf16_t* VTp, int qt, int h, int lane) {
    const int r32 = lane & 31, hi = lane >> 5;
    const float *Kd, *Vd, *Kc, *Vc; int nprev; size_t qrow0;
    if (qt < 1024) { const int b = qt >> 7, tq = qt & 127; qrow0 = (size_t)qt * 32;
        Kc = a.out + OFF_KP + (size_t)b * 4096 * 512 + h * 64; Vc = a.out + OFF_VP + (size_t)b * 4096 * 512 + h * 64;
        Kd = Kc + (size_t)tq * 32 * 512; Vd = Vc + (size_t)tq * 32 * 512; nprev = tq; }
    else { const int bs = qt - 1024; qrow0 = (size_t)MP + (size_t)bs * 32;
        Kd = a.out + OFF_KS + (size_t)bs * 32 * 512 + h * 64; Vd = a.out + OFF_VS + (size_t)bs * 32 * 512 + h * 64;
        Kc = a.in[I_CK] + (size_t)bs * 4096 * 512 + h * 64; Vc = a.in[I_CV] + (size_t)bs * 4096 * 512 + h * 64; nprev = 128; }
    bf16x8 qf[4];
    { const bf16_t* Qp = QB + (qrow0 + r32) * 512 + h * 64 + hi * 8;
#pragma unroll
      for (int kk = 0; kk < 4; ++kk) qf[kk] = *(const bf16x8*)(Qp + kk * 16); }
    f32x16 o0, o1;
#pragma unroll
    for (int r = 0; r < 16; ++r) { o0[r] = 0.f; o1[r] = 0.f; }
    float Cm = 1.f; int Ce = 0;
    constexpr int DP = PR ? 3 : 1;
    f32x4 kr[8]; float vr[32];
    bf16x8 krb[DP][4]; u32x2 vrb[DP][8];
    const bf16_t* Kbb = KBp + (size_t)(((qt >> 7) * 8 + h) * 128) * 2048 + r32 * 16 + hi * 8;
    const bf16_t* Vtb = VTp + ((size_t)(((qt >> 7) * 8 + h) * 1024 + hi) * 64 + r32) * 4;
#define ATT_LOAD(Kt_, Vt_) do { const float* kp_ = (Kt_) + (size_t)r32 * 512 + hi * 8; \
        _Pragma("unroll") for (int kk = 0; kk < 4; ++kk) { kr[2 * kk] = *(const f32x4*)(kp_ + kk * 16); kr[2 * kk + 1] = *(const f32x4*)(kp_ + kk * 16 + 4); } \
        const float* vp_ = (Vt_) + (size_t)(4 * hi) * 512 + r32; \
        _Pragma("unroll") for (int sI = 0; sI < 2; ++sI) _Pragma("unroll") for (int dh = 0; dh < 2; ++dh) _Pragma("unroll") for (int i = 0; i < 8; ++i) \
            vr[(sI * 2 + dh) * 8 + i] = vp_[(size_t)(16 * sI + (i & 3) + 8 * (i >> 2)) * 512 + dh * 32]; } while (0)
#define ATT_LOADB(J_, key0_) do { const bf16_t* kp_ = Kbb + (size_t)((key0_) >> 5) * 2048; \
        _Pragma("unroll") for (int kk = 0; kk < 4; ++kk) krb[J_][kk] = *(const bf16x8*)(kp_ + kk * 512); \
        _Pragma("unroll") for (int sI = 0; sI < 2; ++sI) _Pragma("unroll") for (int dh = 0; dh < 2; ++dh) { const bf16_t* vp_ = Vtb + ((size_t)(((key0_) >> 2) + 4 * sI) * 64 + 32 * dh) * 4; \
            vrb[J_][(sI * 2 + dh) * 2] = *(const u32x2*)vp_; vrb[J_][(sI * 2 + dh) * 2 + 1] = *(const u32x2*)(vp_ + 2 * 64 * 4); } } while (0)
    if (PR) {
#pragma unroll
        for (int j = 0; j < DP; ++j) if (j <= nprev) ATT_LOADB(j, (nprev - j) * 32);
    } else ATT_LOAD(Kd, Vd);
    bool done = false;
    for (int it0 = 0; it0 <= nprev && !done; it0 += DP) {
#pragma unroll
      for (int j = 0; j < DP; ++j) { const int it = it0 + j; if (it > nprev) { done = true; break; }
        bf16x8 kf[4], vb[4];
        if (PR) {
#pragma unroll
            for (int kk = 0; kk < 4; ++kk) kf[kk] = krb[j][kk];
#pragma unroll
            for (int q = 0; q < 4; ++q) { u32x4 w; w.x = vrb[j][2 * q].x; w.y = vrb[j][2 * q].y; w.z = vrb[j][2 * q + 1].x; w.w = vrb[j][2 * q + 1].y; vb[q] = __builtin_bit_cast(bf16x8, w); }
            if (it + DP <= nprev) ATT_LOADB(j, (nprev - it - DP) * 32);
        } else {
#pragma unroll
            for (int kk = 0; kk < 4; ++kk) kf[kk] = pack8(kr[2 * kk][0], kr[2 * kk][1], kr[2 * kk][2], kr[2 * kk][3], kr[2 * kk + 1][0], kr[2 * kk + 1][1], kr[2 * kk + 1][2], kr[2 * kk + 1][3]);
#pragma unroll
            for (int q = 0; q < 4; ++q) vb[q] = pack8(vr[q * 8 + 0], vr[q * 8 + 1], vr[q * 8 + 2], vr[q * 8 + 3], vr[q * 8 + 4], vr[q * 8 + 5], vr[q * 8 + 6], vr[q * 8 + 7]);
            if (it < nprev) { const size_t toff = (size_t)(nprev - it - 1) * 32 * 512; ATT_LOAD(Kc + toff, Vc + toff); }
        }
        f32x16 s;
#pragma unroll
        for (int r = 0; r < 16; ++r) s[r] = 0.f;
#pragma unroll
        for (int kk = 0; kk < 4; ++kk) s = __builtin_amdgcn_mfma_f32_32x32x16_bf16(kf[kk], qf[kk], s, 0, 0, 0);
        float sg[16], om[16];
#pragma unroll
        for (int r = 0; r < 16; ++r) { const float z2 = s[r]; const float e = __builtin_amdgcn_exp2f(-fabsf(z2)); const float rc = __builtin_amdgcn_rcpf(1.f + e); const float t = e * rc;
            const bool pos = z2 >= 0.f; const bool valid = (it != 0) || (crow(r, hi) < r32);
            sg[r] = valid ? (pos ? rc : t) : 0.f; om[r] = valid ? (pos ? t : rc) : 1.f; }
        const float G0 = (om[0] * om[1]) * (om[2] * om[3]), G1 = (om[4] * om[5]) * (om[6] * om[7]), G2 = (om[8] * om[9]) * (om[10] * om[11]), G3 = (om[12] * om[13]) * (om[14] * om[15]);
        const float P0 = __shfl_xor(G0, 32), P1 = __shfl_xor(G1, 32), P2 = __shfl_xor(G2, 32), P3 = __shfl_xor(G3, 32);
        const float t3 = G3 * P3, t2 = G2 * P2, t1 = G1 * P1, t0 = G0 * P0;
        const float Cs = ldexpf(Cm, Ce);
        float base[4];
        base[3] = Cs * (hi ? 1.f : P3); base[2] = Cs * t3 * (hi ? 1.f : P2); base[1] = Cs * (t3 * t2) * (hi ? 1.f : P1); base[0] = Cs * ((t3 * t2) * t1) * (hi ? 1.f : P0);
        float w[16];
#pragma unroll
        for (int g = 0; g < 4; ++g) { float bt = base[g];
#pragma unroll
            for (int rr = 3; rr >= 0; --rr) { const int r = 4 * g + rr; w[r] = sg[r] * bt; bt *= om[r]; } }
        { const float nc = Cm * ((t0 * t1) * (t2 * t3)); Cm = __builtin_amdgcn_frexp_mantf(nc); Ce += __builtin_amdgcn_frexp_expf(nc); }
        const bf16x8 wa0 = pack8(w[0], w[1], w[2], w[3], w[4], w[5], w[6], w[7]), wa1 = pack8(w[8], w[9], w[10], w[11], w[12], w[13], w[14], w[15]);
        o0 = __builtin_amdgcn_mfma_f32_32x32x16_bf16(wa0, vb[0], o0, 0, 0, 0); o0 = __builtin_amdgcn_mfma_f32_32x32x16_bf16(wa1, vb[2], o0, 0, 0, 0);
        o1 = __builtin_amdgcn_mfma_f32_32x32x16_bf16(wa0, vb[1], o1, 0, 0, 0); o1 = __builtin_amdgcn_mfma_f32_32x32x16_bf16(wa1, vb[3], o1, 0, 0, 0);
        if (__all(Cm == 0.f || Ce < -150)) { done = true; break; }
      }
    }
#undef ATT_LOAD
#undef ATT_LOADB
    bf16_t* op = AO + qrow0 * D + h * 64 + r32;
#pragma unroll
    for (int r = 0; r < 16; ++r) { const size_t ro = (size_t)crow(r, hi) * D; op[ro] = (bf16_t)(cvt_pk_bf16(o0[r], 0.f) & 0xffffu); op[ro + 32] = (bf16_t)(cvt_pk_bf16(o1[r], 0.f) & 0xffffu); }
}


constexpr int PR = 8;
template <int W, bool SAMP>
__device__ __forceinline__ void pool_strip(const bf16_t* XRp, bf16_t* XBp, float* pout, const float* ssq2, const LAS float* ldsrs, const float* pbuf, const float* gm,
                                           int row0, int pos0, int seq, int Tseq, int c4) {
    const f32x4 gv = *(const f32x4*)(gm + c4);
    f32x4 xn[PR + W - 1];
#pragma unroll
    for (int j = 0; j < PR + W - 1; ++j) { const int p = pos0 - (W - 1) + j, rr = row0 - (W - 1) + j;
        if (p >= 0) { const float rs = SAMP ? ldsrs[p] : rsqrtf(ssq2[rr] * (1.f / D) + EPS); xn[j] = bf4(*(const u32x2*)(XRp + (size_t)rr * D + c4)) * rs * gv; }
        else if (SAMP) xn[j] = *(const f32x4*)(pbuf + ((size_t)seq * 15 + (15 + p)) * D + c4);
        else xn[j] = (f32x4){0.f, 0.f, 0.f, 0.f}; }
    f32x4 Sw = (f32x4){0.f, 0.f, 0.f, 0.f};
#pragma unroll
    for (int j = 0; j < W - 1; ++j) Sw = Sw + xn[j];
#pragma unroll
    for (int t = 0; t < PR; ++t) { const int pos = pos0 + t; const f32x4 x = xn[t + W - 1]; Sw = Sw + x;
        const float cnt = SAMP ? (float)W : (float)((pos + 1 < W) ? pos + 1 : W); const f32x4 dv = Sw * (1.f / cnt) - x;
        u32x2 wv; wv.x = cvt_pk_bf16(dv[0], dv[1]); wv.y = cvt_pk_bf16(dv[2], dv[3]); *(u32x2*)(XBp + (size_t)(row0 + t) * D + c4) = wv;
        if (pos >= Tseq - 15) *(f32x4*)(pout + ((size_t)seq * 15 + (pos - (Tseq - 15))) * D + c4) = x;
        Sw = Sw - xn[t]; }
}

#define XB_TMO      128
#define XB_XCNT(j)  (256  + 64 * (j))
#define XB_XSUB(j)  (1280 + 64 * (j))
#define XB_XGEN(j)  (2304 + 64 * (j))
#define XB_TOP      3328
#define XB_TOPGEN   3392
#define XCD_BAR_WORDS 3456
#define XB_SPIN_CAP (1u << 18)

__device__ __forceinline__ unsigned xb_ld(unsigned* p)              { return __hip_atomic_load(p, __ATOMIC_RELAXED, __HIP_MEMORY_SCOPE_AGENT); }
__device__ __forceinline__ unsigned xb_add(unsigned* p, unsigned v) { return __hip_atomic_fetch_add(p, v, __ATOMIC_RELAXED, __HIP_MEMORY_SCOPE_AGENT); }
__device__ __forceinline__ unsigned xb_xcc_id() { return (unsigned)__builtin_amdgcn_s_getreg((3 << 11) | 20) & 0xFu; }
#define XB_SPIN(cond, bar) do { unsigned _sp = 0; while (cond) { __builtin_amdgcn_s_sleep(1); \
    if ((++_sp & 255u) == 0u) { if (xb_ld(&(bar)[XB_TMO])) break; if (_sp > XB_SPIN_CAP) { atomicAdd(&(bar)[XB_TMO], 1u); break; } } } } while (0)

struct XcdBarrier {
    unsigned* bar; unsigned x;
    volatile LAS unsigned* st;
};

__device__ __forceinline__ XcdBarrier xcd_barrier_post(unsigned* bar, volatile LAS unsigned* st) {
    XcdBarrier b; b.bar = bar; b.x = xb_xcc_id(); b.st = st;
    if (threadIdx.x == 0) (void)xb_add(&bar[XB_XCNT(b.x)], 1u);
    return b;
}
__device__ __forceinline__ void xcd_barrier_complete(unsigned* bar, unsigned x, unsigned& nloc, unsigned& nx) {
    const unsigned G = gridDim.x * gridDim.y * gridDim.z;
    unsigned sum, cnt, mine, sp = 0u;
    for (;;) {
        sum = 0u; cnt = 0u; mine = 0u;
#pragma unroll
        for (unsigned j = 0; j < 16; ++j) { const unsigned c = xb_ld(&bar[XB_XCNT(j)]); sum += c; cnt += (c > 0u) ? 1u : 0u; mine = (j == x) ? c : mine; }
        if (sum == G) break;
        __builtin_amdgcn_s_sleep(1);
        if ((++sp & 255u) == 0u) { if (xb_ld(&bar[XB_TMO])) break; if (sp > XB_SPIN_CAP) { atomicAdd(&bar[XB_TMO], 1u); break; } }
    }
    nloc = mine > 0u ? mine : 1u; nx = cnt > 0u ? cnt : 1u;
}

__device__ __forceinline__ void xcd_barrier(const XcdBarrier& b) {
    asm volatile("s_waitcnt vmcnt(0)" ::: "memory");
    __syncthreads();
    if (threadIdx.x == 0) {
        unsigned* bar = b.bar;
        __builtin_amdgcn_s_waitcnt(0);
        unsigned nloc = b.st[0], nx = b.st[1];
        if (nloc == 0u) { xcd_barrier_complete(bar, b.x, nloc, nx); b.st[0] = nloc; b.st[1] = nx; }
        const unsigned old = xb_add(&bar[XB_XSUB(b.x)], 1u);
        const unsigned gen = old / nloc;
        if (old + 1u == (gen + 1u) * nloc) {
            __builtin_amdgcn_fence(__ATOMIC_RELEASE, "agent");
            asm volatile("s_waitcnt vmcnt(0)" ::: "memory");
            const unsigned og = xb_add(&bar[XB_TOP], 1u);
            const unsigned tg = og / nx;
            if (og + 1u == (tg + 1u) * nx) xb_add(&bar[XB_TOPGEN], 1u);
            else XB_SPIN(xb_ld(&bar[XB_TOPGEN]) == tg, bar);
            __builtin_amdgcn_fence(__ATOMIC_ACQUIRE, "agent");
            xb_add(&bar[XB_XGEN(b.x)], 1u);
            asm volatile("s_waitcnt vmcnt(0)" ::: "memory");
        } else {
            XB_SPIN(xb_ld(&bar[XB_XGEN(b.x)]) == gen, bar);
            __builtin_amdgcn_fence(__ATOMIC_ACQUIRE, "agent");
            asm volatile("s_waitcnt vmcnt(0)" ::: "memory");
        }
    }
    __syncthreads();
}


#ifndef SKIPMASK
#define SKIPMASK 0
#endif
#define PH(n) if (!((SKIPMASK >> (n)) & 1))
__global__ void __launch_bounds__(512, 2) fwd_kernel(Args a) {
    extern __shared__ __attribute__((aligned(16))) unsigned char lds[];
    cg::grid_group grid = cg::this_grid();
    PG8_LAS unsigned char* L = (PG8_LAS unsigned char*)lds;
    const int tid = threadIdx.x, lane = tid & 63, wave = __builtin_amdgcn_readfirstlane(tid >> 6);
    const int G = gridDim.x, bx = blockIdx.x;
    const int gw = bx * 8 + wave, NGW = G * 8; const int gt = bx * 512 + tid, NGT = G * 512;
    float* const out = a.out;
    volatile LAS unsigned* bst = (volatile LAS unsigned*)(L + 131072 + 64);
    if (tid < 4) bst[tid] = 0u;
    __syncthreads();
    const XcdBarrier xbar = xcd_barrier_post((unsigned*)(a.ws + WS_BAR), bst);
#define ws (a.ws)
#define SSQ ((float*)(ws + WS_SSQ))
#define SUMA ((float*)(ws + WS_SUM))
#define SUMH (SUMA + 512 * 512)
#define SPL ((float*)(ws + WS_SPL))
#define WIN ((bf16_t*)(ws + WS_WIN))
#define WG ((bf16_t*)(ws + WS_WG))
#define WOUT ((bf16_t*)(ws + WS_WOUT))
#define WGU ((bf16_t*)(ws + WS_WGU))
#define WD ((bf16_t*)(ws + WS_WD))
#define WP ((bf16_t*)(ws + WS_WP))
#define XB ((bf16_t*)(ws + WS_XB))
#define QB ((bf16_t*)(ws + WS_QB))
#define GG ((bf16_t*)(ws + WS_GG))
#define UCB ((bf16_t*)(ws + WS_UCB))
#define KB ((bf16_t*)(ws + WS_KB))
#define VT ((bf16_t*)(ws + WS_VT))
#define U ((bf16_t*)(ws + WS_U))
#define AX ((unsigned*)(ws + WS_AA))
#define AO ((bf16_t*)(ws + WS_AO))
#define H ((bf16_t*)(ws + WS_H))
#define PART ((float*)(ws + WS_PART))

    PH(0)
    {
        for (int i = gt; i < 4 * M; i += NGT) SSQ[i] = 0.f;
        if (gt < 512) SPL[gt] = -8.f * log1pf(expf(-a.in[I_LAM][gt]));
        LAS float* scr = (LAS float*)(L + wave * 16384);
        constexpr int IT_WIN = 16 * 80, IT_WOUT = 16 * 32, IT_WGU = 16 * 176, IT_WD = 44 * 32, IT_WP = 4 * 8;
        constexpr int NITEMS = IT_WIN + IT_WOUT + 2 * IT_WGU + 2 * IT_WD + 4 * IT_WP;
        for (int it = gw; it < NITEMS; it += NGW) {
            int r = it;
            if (r >= IT_WIN + IT_WOUT) break;
            if (r < IT_WIN) { const int kb = r / 80, nb = r % 80; transpose_tile(a.in[I_WIN], NIN, nb * 32, kb * 64, a.in[I_NM], WIN, D, nb * 32, scr, lane); continue; } r -= IT_WIN;
            if (r < IT_WOUT) { const int kb = r / 32, nb = r % 32; transpose_tile(a.in[I_WOUT], D, nb * 32, kb * 64, nullptr, WOUT, D, nb * 32, scr, lane); continue; } r -= IT_WOUT;
            if (r < 2 * IT_WGU) { const int l = r / IT_WGU; r -= l * IT_WGU; const int kb = r / 176, nb = r % 176; const int n0 = nb * 32;
                const float* src = ((n0 & 128) ? a.in[I_FU] : a.in[I_FG]) + (size_t)l * D * FF; const int sc0 = (n0 >> 8) * 128 + (n0 & 127);
                transpose_tile(src, FF, sc0, kb * 64, a.in[I_NF] + l * D, WGU + (size_t)l * NGU * D, D, n0, scr, lane); continue; } r -= 2 * IT_WGU;
            if (r < 2 * IT_WD) { const int l = r / IT_WD; r -= l * IT_WD; const int kb = r / 32, nb = r % 32;
                transpose_tile(a.in[I_FD] + (size_t)l * FF * D, D, nb * 32, kb * 64, nullptr, WD + (size_t)l * D * FF, FF, nb * 32, scr, lane); continue; } r -= 2 * IT_WD;
            { const int g = r / IT_WP; r -= g * IT_WP; const int kb = r / 8, nb = r % 8;
                transpose_tile(a.in[I_PW] + (size_t)g * 256 * 256, 256, nb * 32, kb * 64, nullptr, WP, 256, g * 256 + nb * 32, scr, lane, a.in[I_PS]); }
        }
        for (int i = gt; i < 1024 * 128; i += NGT) { const int np = i >> 7, kk = i & 127; const int pn = np >> 8, bj = (np >> 7) & 1, j = np & 127; const int c = 128 * pn + j, cin = 128 * pn + kk;
            float v = 0.f; if ((cin >> 6) == (c >> 6)) v = (bj ? a.in[I_IGW] : a.in[I_RGW])[(size_t)(c >> 6) * 4096 + (cin & 63) * 64 + (c & 63)];
            WG[i] = (bf16_t)(cvt_pk_bf16(v, 0.f) & 0xffffu); }
        for (int m0 = gw; m0 < M; m0 += 2 * NGW) { const int m1 = m0 + NGW; const bool has1 = m1 < M;
            const float* xr0 = (m0 < MP) ? a.in[I_XP] + (size_t)m0 * D : a.in[I_XS] + (size_t)(m0 - MP) * D;
            const float* xr1 = has1 ? ((m1 < MP) ? a.in[I_XP] + (size_t)m1 * D : a.in[I_XS] + (size_t)(m1 - MP) * D) : xr0;
            f32x4 v0[4], v1[4]; float s0 = 0.f, s1 = 0.f;
#pragma unroll
            for (int j = 0; j < 4; ++j) { v0[j] = ((const f32x4*)xr0)[lane + 64 * j]; v1[j] = ((const f32x4*)xr1)[lane + 64 * j]; }
#pragma unroll
            for (int j = 0; j < 4; ++j) { s0 += (v0[j][0] * v0[j][0] + v0[j][1] * v0[j][1]) + (v0[j][2] * v0[j][2] + v0[j][3] * v0[j][3]); s1 += (v1[j][0] * v1[j][0] + v1[j][1] * v1[j][1]) + (v1[j][2] * v1[j][2] + v1[j][3] * v1[j][3]); }
            const float rs0 = rsqrtf(wave_sum(s0) * (1.f / D) + EPS), rs1 = rsqrtf(wave_sum(s1) * (1.f / D) + EPS);
#pragma unroll
            for (int j = 0; j < 4; ++j) { u32x2 w; w.x = cvt_pk_bf16(v0[j][0] * rs0, v0[j][1] * rs0); w.y = cvt_pk_bf16(v0[j][2] * rs0, v0[j][3] * rs0); ((u32x2*)(XB + (size_t)m0 * D))[lane + 64 * j] = w; }
            if (has1) {
#pragma unroll
                for (int j = 0; j < 4; ++j) { u32x2 w; w.x = cvt_pk_bf16(v1[j][0] * rs1, v1[j][1] * rs1); w.y = cvt_pk_bf16(v1[j][2] * rs1, v1[j][3] * rs1); ((u32x2*)(XB + (size_t)m1 * D))[lane + 64 * j] = w; } } }
    }
    xcd_barrier(xbar);
    if (a.out == nullptr) grid.sync();
    pg8::StaticOrder S;
    PH(1)
    { pg8::Gemm g{XB, WIN, M, NIN, D, D, 0}; pg8::G1Order S1; S1.init(G, bx); EpiG1 E{QB, GG, U, out, KB, VT}; pg8::gemm_phase(L, g, S1, E); }
    xcd_barrier(xbar);
    PH(2)
    {
        const float* cw = a.in[I_CW]; const float* cbias = a.in[I_CB];
        for (int idx = gt; idx < (M / 8) * 128; idx += NGT) { const int strip = idx >> 7, c4 = (idx & 127) * 4; const int row0 = strip * 8;
            int pos0, T, seq; const bool samp = row0 >= MP; if (!samp) { pos0 = row0 & 4095; T = 4096; seq = row0 >> 12; } else { pos0 = (row0 - MP) & 31; T = 32; seq = (row0 - MP) >> 5; }
            f32x4 uu[11];
#pragma unroll
            for (int j = 0; j < 11; ++j) { const int p = pos0 - 3 + j;
                if (p >= 0) uu[j] = bf4(*(const u32x2*)(U + (size_t)(row0 - 3 + j) * 512 + c4));
                else if (samp) uu[j] = *(const f32x4*)(a.in[I_LC] + ((size_t)seq * 3 + (3 + p)) * 512 + c4);
                else uu[j] = (f32x4){0.f, 0.f, 0.f, 0.f}; }
            const f32x4 cb4 = *(const f32x4*)(cbias + c4), w0 = *(const f32x4*)(cw + c4), w1 = *(const f32x4*)(cw + 512 + c4), w2 = *(const f32x4*)(cw + 1024 + c4), w3 = *(const f32x4*)(cw + 1536 + c4);
#pragma unroll
            for (int t = 0; t < 8; ++t) { const f32x4 accv = cb4 + uu[t] * w0 + uu[t + 1] * w1 + uu[t + 2] * w2 + uu[t + 3] * w3;
                u32x2 w; w.x = cvt_pk_bf16(accv[0], accv[1]); w.y = cvt_pk_bf16(accv[2], accv[3]); *(u32x2*)(UCB + (size_t)(row0 + t) * 512 + c4) = w;
                if (pos0 + t >= T - 3) *(f32x4*)(out + (samp ? OFF_CS : OFF_CP) + ((size_t)seq * 3 + (pos0 + t - (T - 3))) * 512 + c4) = uu[t + 3]; } }
    }
    xcd_barrier(xbar);
    PH(3)
    { pg8::Gemm g{UCB, WG, M, 1024, 128, 512, 128}; S.init(M, 1024, G, bx); EpiGate E{a.in[I_RGB], a.in[I_IGB], SPL, UCB, AX}; pg8::gemm_phase(L, g, S, E); }
    PH(4)
    for (int i = 0; ; ++i) { pg8::Unit tu; if (!S.next(i, tu)) break; if (tu.pm >= 128) continue;
        const int chunk = 4 * tu.pm + (wave >> 1), c = (2 * tu.pn + (wave & 1)) * 64 + lane; const size_t base = (size_t)chunk * 64 * 512 + c;
        float hl = 0.f, ap = 1.f;
#pragma unroll 32
        for (int t = 0; t < 64; ++t) { const unsigned pk = AX[base + (size_t)t * 512]; const float av = 1.f - __uint_as_float(pk << 16), xv = __uint_as_float(pk & 0xffff0000u); hl = av * hl + xv; ap *= av; }
        SUMA[chunk * 512 + c] = ap; SUMH[chunk * 512 + c] = hl; }
    PH(3)
    { pg8::Gemm g{XB, WIN, M, NIN, D, D, 0}; pg8::G1Tail S2; S2.init(G, bx); EpiG1 E{QB, GG, U, out, KB, VT}; pg8::gemm_phase(L, g, S2, E); }
    PH(14) { unsigned* actr = (unsigned*)(ws + WS_BAR) + 3584;
        unsigned u = (unsigned)gw;
        while (u < 1056u * 8u) {
            unsigned nx = 0; if (lane == 0) nx = atomicAdd(actr, 1u) + (unsigned)NGW;
            if (u < 256u) { const int uu = (int)(8192u + u); attn_unit<false>(a, QB, AO, KB, VT, uu >> 3, uu & 7, lane); } else { const int uu = (int)(u - 256u); attn_unit<true>(a, QB, AO, KB, VT, uu >> 3, uu & 7, lane); }
            u = (unsigned)__builtin_amdgcn_readfirstlane((int)nx); } }
    xcd_barrier(xbar);
    PH(5)
    for (int u = gw; u < 512 * 8 + 32 * 8; u += NGW) {
        const bool samp = u >= 4096; int row0, nt, c; float hcur; bool lastc; float* hout;
        if (!samp) { const int chunk = u >> 3; c = (u & 7) * 64 + lane; const int b = chunk >> 6, ci = chunk & 63; row0 = chunk * 64; nt = 64; hcur = 0.f;
            for (int j0 = 0; j0 < ci; j0 += 8) { float sa[8], sh[8];
#pragma unroll
                for (int k = 0; k < 8; ++k) { const bool ok = (j0 + k) < ci; const int jj = ok ? (j0 + k) : j0; sa[k] = SUMA[(b * 64 + jj) * 512 + c]; sh[k] = SUMH[(b * 64 + jj) * 512 + c]; if (!ok) { sa[k] = 1.f; sh[k] = 0.f; } }
#pragma unroll
                for (int k = 0; k < 8; ++k) hcur = sa[k] * hcur + sh[k]; }
            lastc = (ci == 63); hout = out + OFF_HP + b * 512 + c; }
        else { const int v = u - 4096; const int bs = v >> 3; c = (v & 7) * 64 + lane; row0 = MP + bs * 32; nt = 32; hcur = a.in[I_LH][bs * 512 + c]; lastc = true; hout = out + OFF_HS + bs * 512 + c; }
        const size_t base = (size_t)row0 * 512 + c;
        for (int t0 = 0; t0 < nt; t0 += 32) { unsigned pk[32]; bf16_t gg[32];
#pragma unroll
            for (int k = 0; k < 32; ++k) { pk[k] = AX[base + (size_t)(t0 + k) * 512]; gg[k] = GG[base + (size_t)(t0 + k) * 512]; }
#pragma unroll
            for (int k = 0; k < 32; ++k) { const float av = 1.f - __uint_as_float(pk[k] << 16), xv = __uint_as_float(pk[k] & 0xffff0000u); hcur = av * hcur + xv;
                AO[(size_t)(row0 + t0 + k) * D + 512 + c] = (bf16_t)(cvt_pk_bf16(hcur * bf2f(gg[k]), 0.f) & 0xffffu); } }
        if (lastc) *hout = hcur; }
    xcd_barrier(xbar);
    PH(6)
    { pg8::Gemm g{AO, WOUT, M, D, D, D, 0}; S.init(M, D, G, bx); EpiRes<true> E{a.in[I_XP], a.in[I_XS], XB, SSQ, nullptr}; pg8::gemm_phase(L, g, S, E); }
    PH(6)
    { const int rem = (M / 256 * (D / 256)) % G; const int b0 = rem; const int nblk = G - b0;
      if (bx >= b0) { LAS float* scr = (LAS float*)(L + wave * 16384); const int dw = (bx - b0) * 8 + wave, NDW = nblk * 8;
        constexpr int IT_WGU = 16 * 176, IT_WD = 44 * 32, IT_WP = 4 * 8;
        for (int it = dw; it < IT_WGU + IT_WD + 4 * IT_WP; it += NDW) {
            int r = it;
            if (r < IT_WGU) { const int kb = r / 176, nb = r % 176; const int n0 = nb * 32;
                const float* src = (n0 & 128) ? a.in[I_FU] : a.in[I_FG]; const int sc0 = (n0 >> 8) * 128 + (n0 & 127);
                transpose_tile(src, FF, sc0, kb * 64, a.in[I_NF], WGU, D, n0, scr, lane); continue; } r -= IT_WGU;
            if (r < IT_WD) { const int kb = r / 32, nb = r % 32; transpose_tile(a.in[I_FD], D, nb * 32, kb * 64, nullptr, WD, FF, nb * 32, scr, lane); continue; } r -= IT_WD;
            { const int g = r / IT_WP; r -= g * IT_WP; const int kb = r / 8, nb = r % 8;
                transpose_tile(a.in[I_PW] + (size_t)g * 256 * 256, 256, nb * 32, kb * 64, nullptr, WP, 256, g * 256 + nb * 32, scr, lane, a.in[I_PS]); }
        } } }
    xcd_barrier(xbar);
    PH(7)
    { pg8::Gemm g{XB, WGU, M, NGU, D, D, 0}; S.init(M, NGU, G, bx); EpiSwiglu E{SSQ, H}; pg8::gemm_phase(L, g, S, E); }
    PH(7)
    { const int rem = (M / 256 * (NGU / 256)) % G; const int b0 = rem; const int nblk = G - b0;
      if (bx >= b0) { LAS float* scr = (LAS float*)(L + wave * 16384); const int dw = (bx - b0) * 8 + wave, NDW = nblk * 8;
        constexpr int IT_WGU = 16 * 176, IT_WD = 44 * 32;
        for (int it = dw; it < IT_WGU + IT_WD; it += NDW) {
            int r = it;
            if (r < IT_WGU) { const int kb = r / 176, nb = r % 176; const int n0 = nb * 32;
                const float* src = ((n0 & 128) ? a.in[I_FU] : a.in[I_FG]) + (size_t)D * FF; const int sc0 = (n0 >> 8) * 128 + (n0 & 127);
                transpose_tile(src, FF, sc0, kb * 64, a.in[I_NF] + D, WGU + (size_t)NGU * D, D, n0, scr, lane); continue; } r -= IT_WGU;
            { const int kb = r / 32, nb = r % 32; transpose_tile(a.in[I_FD] + (size_t)FF * D, D, nb * 32, kb * 64, nullptr, WD + (size_t)D * FF, FF, nb * 32, scr, lane); }
        } } }
    xcd_barrier(xbar);
    PH(8)
    { pg8::Gemm g{H, WD, M, D, FF, FF, 0}; pg8::TailOrder ST; ST.init(FF, G, bx); EpiRes<false, true> E{nullptr, nullptr, XB, SSQ + M, PART}; pg8::gemm_phase(L, g, ST, E); }
    xcd_barrier(xbar);
    PH(9)
    {
        const float* ssq2 = SSQ + M; const float* gm = a.in[I_NM] + D; const float* pbuf = a.in[I_SP]; const LAS float* ldsrs = (const LAS float*)L;
        for (int idx = gt; idx < (MP / PR) * 256; idx += NGT) { const int strip = idx >> 8, c4 = (idx & 255) * 4; const int row0 = strip * PR, pos0 = row0 & 4095, seq = row0 >> 12;
            switch (c4 >> 8) {
                case 0: pool_strip<2, false>(XB, AO, out + OFF_PP, ssq2, ldsrs, pbuf, gm, row0, pos0, seq, 4096, c4); break;
                case 1: pool_strip<4, false>(XB, AO, out + OFF_PP, ssq2, ldsrs, pbuf, gm, row0, pos0, seq, 4096, c4); break;
                case 2: pool_strip<8, false>(XB, AO, out + OFF_PP, ssq2, ldsrs, pbuf, gm, row0, pos0, seq, 4096, c4); break;
                default: pool_strip<16, false>(XB, AO, out + OFF_PP, ssq2, ldsrs, pbuf, gm, row0, pos0, seq, 4096, c4); break; } }
        for (int sidx = bx; sidx < 32; sidx += G) {
            __syncthreads();
#pragma unroll
            for (int j = 0; j < 4; ++j) { const int r = wave * 4 + j; u32x2* xr = (u32x2*)(XB + (size_t)(MP + sidx * 32 + r) * D); const f32x4* pr = (const f32x4*)(PART + (size_t)(sidx * 32 + r) * D); float sq = 0.f;
#pragma unroll
                for (int q = 0; q < 4; ++q) { f32x4 v = bf4(xr[lane + 64 * q]);
#pragma unroll
                    for (int ks = 0; ks < 11; ++ks) v = v + pr[(size_t)ks * (MS * D / 4) + lane + 64 * q];
                    u32x2 wv; wv.x = cvt_pk_bf16(v[0], v[1]); wv.y = cvt_pk_bf16(v[2], v[3]); xr[lane + 64 * q] = wv; sq += (v[0] * v[0] + v[1] * v[1]) + (v[2] * v[2] + v[3] * v[3]); }
                sq = wave_sum(sq); if (lane == 0) ((LAS float*)L)[r] = rsqrtf(sq * (1.f / D) + EPS); }
            asm volatile("s_waitcnt vmcnt(0)" ::: "memory"); __threadfence_block(); __syncthreads();
            const int c4 = (tid & 255) * 4, half = tid >> 8;
            for (int sub = 0; sub < 16 / PR; ++sub) { const int pos0 = half * 16 + sub * PR, row0 = MP + sidx * 32 + pos0;
            switch (c4 >> 8) {
                case 0: pool_strip<2, true>(XB, AO, out + OFF_PS, ssq2, ldsrs, pbuf, gm, row0, pos0, sidx, 32, c4); break;
                case 1: pool_strip<4, true>(XB, AO, out + OFF_PS, ssq2, ldsrs, pbuf, gm, row0, pos0, sidx, 32, c4); break;
                case 2: pool_strip<8, true>(XB, AO, out + OFF_PS, ssq2, ldsrs, pbuf, gm, row0, pos0, sidx, 32, c4); break;
                default: pool_strip<16, true>(XB, AO, out + OFF_PS, ssq2, ldsrs, pbuf, gm, row0, pos0, sidx, 32, c4); break; } } }
    }
    xcd_barrier(xbar);
    PH(10)
    { pg8::Gemm g{AO  , WP, M, D, 256, D, 256}; S.init(M, D, G, bx); EpiRes<false> E{nullptr, nullptr, XB, SSQ + 2 * M, nullptr}; pg8::gemm_phase(L, g, S, E); }
    xcd_barrier(xbar);
    PH(11)
    { pg8::Gemm g{XB, WGU + (size_t)NGU * D, M, NGU, D, D, 0}; S.init(M, NGU, G, bx); EpiSwiglu E{SSQ + 2 * M, H}; pg8::gemm_phase(L, g, S, E); }
    xcd_barrier(xbar);
    PH(12)
    { pg8::Gemm g{H, WD + (size_t)D * FF, M, D, FF, FF, 0}; pg8::TailOrder ST; ST.init(FF, G, bx); EpiRes<false, true> E{nullptr, nullptr, XB, SSQ + 3 * M, PART}; pg8::gemm_phase(L, g, ST, E); }
    xcd_barrier(xbar);
    PH(13)
    { const float* ssq4 = SSQ + 3 * M; const f32x4* gf = (const f32x4*)a.in[I_NFIN];
      for (int m0 = gw; m0 < M; m0 += 2 * NGW) {
          const int m1 = (m0 + NGW < M) ? m0 + NGW : m0; const bool has1 = m0 + NGW < M;
          const u32x2* p0 = (const u32x2*)(XB + (size_t)m0 * D); const u32x2* p1 = (const u32x2*)(XB + (size_t)m1 * D); u32x2 r0[4], r1[4];
#pragma unroll
          for (int q = 0; q < 4; ++q) { r0[q] = p0[lane + 64 * q]; r1[q] = p1[lane + 64 * q]; }
#pragma unroll
          for (int rr = 0; rr < 2; ++rr) { if (rr == 1 && !has1) break; const int m = rr ? m1 : m0; f32x4 v[4]; float sq = 0.f;
#pragma unroll
              for (int q = 0; q < 4; ++q) v[q] = bf4(rr ? r1[q] : r0[q]);
              if (m >= MP) { const f32x4* pr = (const f32x4*)(PART + (size_t)(m - MP) * D);
#pragma unroll
                  for (int ks = 0; ks < 11; ++ks)
#pragma unroll
                      for (int q = 0; q < 4; ++q) v[q] = v[q] + pr[(size_t)ks * (MS * D / 4) + lane + 64 * q]; }
#pragma unroll
              for (int q = 0; q < 4; ++q) sq += (v[q][0] * v[q][0] + v[q][1] * v[q][1]) + (v[q][2] * v[q][2] + v[q][3] * v[q][3]);
              const float ss = (m >= MP) ? wave_sum(sq) : ssq4[m]; const float rs = rsqrtf(ss * (1.f / D) + EPS);
              f32x4* yo = (f32x4*)(out + OFF_Y + (size_t)m * D);
#pragma unroll
              for (int q = 0; q < 4; ++q) yo[lane + 64 * q] = v[q] * rs * gf[lane + 64 * q]; } } }
}

#undef ws
#undef SSQ
#undef SUMA
#undef SUMH
#undef KB
#undef VT
#undef PART
#undef SPL
#undef WIN
#undef WG
#undef WOUT
#undef WGU
#undef WD
#undef WP
#undef XB
#undef QB
#undef GG
#undef UCB
#undef U
#undef AX
#undef AO
#undef H
extern "C" void kernel_launch(void* const* d_in, const int* in_sizes, int n_in, void* d_out, int out_size, void* d_ws, size_t ws_size, hipStream_t stream) {
    static int grid = 0;
    if (grid == 0) {
        if (n_in != 24 || out_size != (int)OUT_TOTAL || ws_size < WS_END) { fprintf(stderr, "kernel_launch: unexpected shapes (n_in %d out %d ws %zu)\n", n_in, out_size, ws_size); grid = -1; return; }
        int dev = 0, cus = 0, per_cu = 0;
        hipGetDevice(&dev); hipDeviceGetAttribute(&cus, hipDeviceAttributeMultiprocessorCount, dev);
        hipFuncSetAttribute((const void*)fwd_kernel, hipFuncAttributeMaxDynamicSharedMemorySize, LDS_BYTES);
        hipOccupancyMaxActiveBlocksPerMultiprocessor(&per_cu, (const void*)fwd_kernel, 512, LDS_BYTES);
        if (per_cu < 1) { fprintf(stderr, "kernel_launch: occupancy query says %d blocks/CU\n", per_cu); per_cu = 1; }
        (void)hipGetLastError();
        grid = cus * per_cu;
    }
    if (grid < 0) return;
    (void)hipMemsetAsync((char*)d_ws + WS_BAR, 0, 16384, stream);
    Args a{};
    for (int i = 0; i < 24; ++i) a.in[i] = (const float*)d_in[i];
    a.out = (float*)d_out; a.ws = (unsigned char*)d_ws;
    void* params[] = {&a};
    hipError_t e = hipLaunchCooperativeKernel((const void*)fwd_kernel, dim3(grid), dim3(512), params, LDS_BYTES, stream);
    if (e != hipSuccess) fprintf(stderr, "cooperative launch failed: %s (grid %d)\n", hipGetErrorString(e), grid);
}
```

```cpp
#include <hip/hip_runtime.h>
#include <hip/hip_cooperative_groups.h>
#include <cstdio>
#include <cstdint>
namespace cg = cooperative_groups;

constexpr int MP = 32768;
constexpr int MS = 1024;
constexpr int M = MP + MS;
constexpr int D = 1024, NIN = 2560, FF = 2816, NGU = 2 * FF;
constexpr float EPS = 1e-6f;
constexpr size_t OFF_Y = 0, OFF_KP = 34603008, OFF_VP = 51380224, OFF_HP = 68157440, OFF_CP = 68161536, OFF_PP = 68173824,
                 OFF_KS = 68296704, OFF_VS = 68820992, OFF_HS = 69345280, OFF_CS = 69361664, OFF_PS = 69410816, OUT_TOTAL = 69902336;
constexpr size_t MiB = 1u << 20;
constexpr size_t WS_SSQ = 0, WS_SUM = 1 * MiB, WS_SPL = 3 * MiB, WS_BAR = 3 * MiB + 512 * 1024, WS_WIN = 4 * MiB, WS_WG = 9 * MiB, WS_WOUT = 10 * MiB, WS_WGU = 12 * MiB, WS_WD = 34 * MiB, WS_WP = 45 * MiB,
                 WS_XB = 48 * MiB, WS_QB = 114 * MiB, WS_GG = 147 * MiB, WS_UCB = 180 * MiB, WS_U = 213 * MiB, WS_UC = 279 * MiB, WS_KB = 279 * MiB  , WS_VT = 312 * MiB  , WS_AA = 345 * MiB, WS_XIN = 411 * MiB,
                 WS_AO = 477 * MiB, WS_H = 213 * MiB  , WS_PART = 543 * MiB  , WS_END = 587 * MiB;
static_assert(WS_H + (size_t)M * FF * 2 <= WS_AO, "H overlay");
constexpr int LDS_BYTES = 147456;

namespace pg8 {
#define PG8_LAS __attribute__((address_space(3)))
typedef unsigned short bf16_t;
typedef short bf16x8 __attribute__((ext_vector_type(8)));
typedef float f32x4 __attribute__((ext_vector_type(4)));
typedef unsigned u32x4 __attribute__((ext_vector_type(4)));
typedef unsigned u32x2 __attribute__((ext_vector_type(2)));
constexpr int BM = 256, BK = 64, HALF = 128, HTB = HALF * BK * 2, STAGE_BYTES = 8 * HTB, NXCD = 8, WGM = 8;

__host__ __device__ __forceinline__ int lds_byte(int r, int c) { const int st = (r >> 4) * 2 + (c >> 5), rr = r & 15, cc = c & 31, ob = rr * 64 + cc * 2; return st * 1024 + (ob ^ (((ob >> 9) & 1) << 5)); }
__host__ __device__ __forceinline__ void stage_rc(int b, int& R, int& C) { const int st = b / 1024, sb = b % 1024, swz = sb ^ (((sb >> 9) & 1) << 5); R = (st >> 1) * 16 + swz / 64; C = (st & 1) * 32 + (swz % 64) / 2; }
__host__ __device__ __forceinline__ int perm32(int rho) { const int n = rho >> 4, i = rho & 15; return 8 * (i >> 2) + 4 * n + (i & 3); }

struct Unit { int pm, pn, kb, nk; };
struct Gemm { const bf16_t* A; const bf16_t* Bt; int M, N, K, lda, acs; };

__device__ __forceinline__ bool static_tile(int i, int nM, int nN, int G, int c, int& pm, int& pn) {
    const int nwg = nM * nN; const long Lx = (long)i * G + c; if (Lx >= nwg) return false;
    int wgid = (int)Lx; { const int q = nwg / NXCD, r = nwg % NXCD, xcd = wgid % NXCD, off = wgid / NXCD; wgid = (xcd < r ? xcd * (q + 1) : r * (q + 1) + (xcd - r) * q) + off; }
    const int nig = WGM * nN, gid = wgid / nig, fm = gid * WGM, gsz = (nM - fm) < WGM ? (nM - fm) : WGM;
    pm = fm + ((wgid % nig) % gsz); pn = (wgid % nig) / gsz; return true;
}
struct StaticOrder {
    static constexpr bool SPLIT = false;
    int nM, nN, G, c;
    __device__ __forceinline__ void init(int M_, int N_, int G_, int c_) { nM = M_ / BM; nN = N_ / BM; G = G_; c = c_; }
    __device__ __forceinline__ bool next(int i, Unit& u) const { u.kb = 0; u.nk = 0; return static_tile(i, nM, nN, G, c, u.pm, u.pn); }
};

struct G1Order {
    static constexpr bool SPLIT = false;
    int G, c;
    __device__ __forceinline__ void init(int G_, int c_) { G = G_; c = c_; }
    __device__ __forceinline__ bool next(int i, Unit& u) const { u.kb = 0; u.nk = 0; const int Lx = i * G + c; if (Lx >= 1280) return false;
        if (Lx < 1056) { static_tile(0, 132, 8, 0, Lx, u.pm, u.pn); return true; }
        const int idx = Lx - 1056; u.pm = idx >> 1; u.pn = 8 + (idx & 1); return true; }
};
struct G1Tail {
    static constexpr bool SPLIT = false;
    int G, c;
    __device__ __forceinline__ void init(int G_, int c_) { G = G_; c = c_; }
    __device__ __forceinline__ bool next(int i, Unit& u) const { u.kb = 0; u.nk = 0; const int idx = i * G + ((c + G - 16) % G); if (idx >= 40) return false;
        u.pm = 112 + (idx >> 1); u.pn = 8 + (idx & 1); return true; }
};

struct TailOrder {
    static constexpr bool SPLIT = true;
    int G, c, nm, nkfull;
    __device__ __forceinline__ void init(int K_, int G_, int c_) { G = G_; c = c_; nm = (c_ < 512) ? (512 - c_ + G_ - 1) / G_ : 0; nkfull = K_ / BK; }
    __device__ __forceinline__ bool next(int i, Unit& u) const {
        if (i < nm) { static_tile(i, 128, 4, G, c, u.pm, u.pn); u.kb = 0; u.nk = nkfull; return true; }
        const int t = (i - nm) * G + c; if (t >= 16 * 11) return false;
        const int tile = t / 11, ks = t - tile * 11; u.pm = 128 + (tile >> 2); u.pn = tile & 3; u.kb = ks * 4; u.nk = 4; return true;
    }
};

__device__ __forceinline__ unsigned cvt_pk_bf16(float lo, float hi) { unsigned r; asm volatile("v_cvt_pk_bf16_f32 %0, %1, %2" : "=v"(r) : "v"(lo), "v"(hi)); return r; }

template <class Epi, class Sched>
__device__ __forceinline__ void gemm_phase(PG8_LAS unsigned char* lds, const Gemm g, const Sched& S, const Epi& E) {
    int tid = threadIdx.x; asm volatile("" : "+v"(tid));
    const int wid = __builtin_amdgcn_readfirstlane(tid >> 6), lane = tid & 63, wr = wid >> 2, wc = wid & 3, fr = lane & 15, fq = lane >> 4;
    int K = g.K; asm volatile("" : "+s"(K));
    const int ntfull = K / BK;
    unsigned voffA[2], voffB[2];
#pragma unroll
    for (int i = 0; i < 2; ++i) { int R, C; stage_rc(tid * 16 + i * 8192, R, C); const int Rb = (R & ~31) + perm32(R & 31);
        voffA[i] = (unsigned)(R * g.lda + C) * 2u; voffB[i] = (unsigned)(Rb * K + C) * 2u; }
    const size_t kstep = (size_t)(BK * 2);
    const size_t hstepA = (size_t)HALF * g.lda * 2, hstepB = (size_t)HALF * K * 2;
    const unsigned ldsw = (unsigned)wid * 1024u;
    const int aoff = lds_byte(wr * 64 + fr, fq * 8), boff = lds_byte(wc * 32 + fr, fq * 8);
#define PG8_TA(u) ((const char*)g.A + ((size_t)(u).pm * BM * g.lda + (size_t)(u).pn * g.acs) * 2 + (Sched::SPLIT ? (size_t)(u).kb * (BK * 2) : 0))
#define PG8_TB(u) ((const char*)g.Bt + (size_t)(u).pn * BM * K * 2 + (Sched::SPLIT ? (size_t)(u).kb * (BK * 2) : 0))
#define PG8_SA(b, h) (((b) * 2 + (h)) * HTB)
#define PG8_SB(b, h) ((4 + (b) * 2 + (h)) * HTB)
#define PG8_STAGE(bufoff, gbase, voff) do { _Pragma("unroll") for (int _i = 0; _i < 2; ++_i) \
        __builtin_amdgcn_global_load_lds((const unsigned*)((const char*)(gbase) + (voff)[_i]), (PG8_LAS unsigned*)(lds + (bufoff) + ldsw + _i * 8192), 16, 0, 0); } while (0)
#define PG8_LDA(dst, b, h) do { _Pragma("unroll") for (int m = 0; m < 4; ++m) _Pragma("unroll") for (int k = 0; k < 2; ++k) dst[m][k] = *(const PG8_LAS bf16x8*)(lds + PG8_SA(b, h) + aoff + m * 2048 + k * 1024); } while (0)
#define PG8_LDB(dst, b, h) do { _Pragma("unroll") for (int n = 0; n < 2; ++n) _Pragma("unroll") for (int k = 0; k < 2; ++k) dst[n][k] = *(const PG8_LAS bf16x8*)(lds + PG8_SB(b, h) + boff + n * 2048 + k * 1024); } while (0)
#define PG8_MMA(ai, bj, At, Bt) do { __builtin_amdgcn_s_setprio(1); _Pragma("unroll") for (int m = 0; m < 4; ++m) _Pragma("unroll") for (int n = 0; n < 2; ++n) _Pragma("unroll") for (int k = 0; k < 2; ++k) \
        acc[ai][bj][m][n] = __builtin_amdgcn_mfma_f32_16x16x32_bf16(Bt[n][k], At[m][k], acc[ai][bj][m][n], 0, 0, 0); __builtin_amdgcn_s_setprio(0); } while (0)
#define PG8_WAIT_V(n) asm volatile("s_waitcnt vmcnt(" #n ")" ::: "memory")
#define PG8_WAIT_L(n) asm volatile("s_waitcnt lgkmcnt(" #n ")" ::: "memory")
#define PG8_BAR __builtin_amdgcn_s_barrier()
#define PG8_SCHED __builtin_amdgcn_sched_barrier(0)
    Unit cur, nxt; int ui = 0;
    if (!S.next(0, cur)) return;
    f32x4 acc[2][2][4][2];
    E.init(acc, cur, wr, wc, fr, fq);
    bf16x8 At[4][2], B0[2][2], B1[2][2];
    const char* cA = PG8_TA(cur); const char* cB = PG8_TB(cur);
    PG8_STAGE(PG8_SB(0, 0), cB, voffB); PG8_STAGE(PG8_SB(0, 1), cB + hstepB, voffB); PG8_STAGE(PG8_SA(0, 0), cA, voffA); PG8_STAGE(PG8_SA(0, 1), cA + hstepA, voffA);
    if (wr == 1) PG8_BAR;
    PG8_WAIT_V(2); PG8_BAR;
    PG8_STAGE(PG8_SB(1, 0), cB + kstep, voffB); PG8_STAGE(PG8_SA(1, 0), cA + kstep, voffA); PG8_STAGE(PG8_SB(1, 1), cB + hstepB + kstep, voffB);
    PG8_WAIT_V(6); PG8_BAR;
    for (;;) {
        const bool has_next = S.next(ui + 1, nxt);
        const char* nA = has_next ? PG8_TA(nxt) : cA; const char* nB = has_next ? PG8_TB(nxt) : cB;
        const int nt = Sched::SPLIT ? cur.nk : ntfull;
        for (int t = 0; t < nt; t += 2) {
            const bool last = (t == nt - 2);
            const char* a1 = cA + (size_t)(t + 1) * kstep;
            const char* a2 = last ? nA : cA + (size_t)(t + 2) * kstep; const char* b2 = last ? nB : cB + (size_t)(t + 2) * kstep;
            const char* a3 = a2 + kstep; const char* b3 = b2 + kstep;
            PG8_LDB(B0, 0, 0); PG8_LDB(B1, 0, 1); PG8_SCHED; PG8_LDA(At, 0, 0); PG8_STAGE(PG8_SA(1, 1), a1 + hstepA, voffA);
            PG8_WAIT_V(8); PG8_WAIT_L(0); PG8_BAR; PG8_MMA(0, 0, At, B0); PG8_MMA(0, 1, At, B1); PG8_BAR; PG8_SCHED;
            PG8_LDA(At, 0, 1); PG8_STAGE(PG8_SB(0, 0), b2, voffB); PG8_STAGE(PG8_SB(0, 1), b2 + hstepB, voffB); PG8_STAGE(PG8_SA(0, 0), a2, voffA);
            PG8_WAIT_V(8); PG8_WAIT_L(0); PG8_BAR; PG8_MMA(1, 0, At, B0); PG8_MMA(1, 1, At, B1); PG8_BAR; PG8_SCHED;
            PG8_LDB(B0, 1, 0); PG8_LDB(B1, 1, 1); PG8_SCHED; PG8_LDA(At, 1, 0); PG8_STAGE(PG8_SA(0, 1), a2 + hstepA, voffA);
            PG8_WAIT_V(8); PG8_WAIT_L(0); PG8_BAR; PG8_MMA(0, 0, At, B0); PG8_MMA(0, 1, At, B1); PG8_BAR; PG8_SCHED;
            PG8_LDA(At, 1, 1); PG8_STAGE(PG8_SB(1, 0), b3, voffB); PG8_STAGE(PG8_SB(1, 1), b3 + hstepB, voffB); PG8_STAGE(PG8_SA(1, 0), a3, voffA);
            PG8_WAIT_V(8); PG8_WAIT_L(0); PG8_BAR; PG8_MMA(1, 0, At, B0); PG8_MMA(1, 1, At, B1); PG8_BAR; PG8_SCHED;
        }
        if (wr == 0) PG8_BAR;
        E(acc, cur, wr, wc, fr, fq);
        if (!has_next) break;
        E.init(acc, nxt, wr, wc, fr, fq);
        cur = nxt; cA = nA; cB = nB; ++ui;
        if (wr == 1) PG8_BAR;
    }
    PG8_WAIT_V(0);
    PG8_BAR;
#undef PG8_TA
#undef PG8_TB
#undef PG8_SA
#undef PG8_SB
#undef PG8_STAGE
#undef PG8_LDA
#undef PG8_LDB
#undef PG8_MMA
#undef PG8_WAIT_V
#undef PG8_WAIT_L
#undef PG8_BAR
#undef PG8_SCHED
}
}

using pg8::bf16_t; using pg8::bf16x8; using pg8::f32x4; using pg8::u32x4; using pg8::u32x2; using pg8::Unit; using pg8::cvt_pk_bf16;
typedef float f32x16 __attribute__((ext_vector_type(16)));
#define LAS __attribute__((address_space(3)))

__device__ __forceinline__ float bf2f(bf16_t v) { return __uint_as_float((unsigned)v << 16); }
__device__ __forceinline__ float sigmoidf_(float x) { return 1.f / (1.f + __expf(-x)); }
__device__ __forceinline__ float gelu_tanh(float x) { const float y2 = 1.5957691216f * (x + 0.044715f * x * x * x); return x / (1.f + __expf(-y2)); }
__device__ __forceinline__ bf16x8 pack8(float a0, float a1, float a2, float a3, float a4, float a5, float a6, float a7) {
    u32x4 w; w.x = cvt_pk_bf16(a0, a1); w.y = cvt_pk_bf16(a2, a3); w.z = cvt_pk_bf16(a4, a5); w.w = cvt_pk_bf16(a6, a7); return __builtin_bit_cast(bf16x8, w); }

__device__ __forceinline__ f32x4 bf4lo(u32x4 r) { return (f32x4){__uint_as_float(r.x << 16), __uint_as_float(r.x & 0xffff0000u), __uint_as_float(r.y << 16), __uint_as_float(r.y & 0xffff0000u)}; }
__device__ __forceinline__ f32x4 bf4hi(u32x4 r) { return (f32x4){__uint_as_float(r.z << 16), __uint_as_float(r.z & 0xffff0000u), __uint_as_float(r.w << 16), __uint_as_float(r.w & 0xffff0000u)}; }
__device__ __forceinline__ f32x4 bf4(u32x2 r) { return (f32x4){__uint_as_float(r.x << 16), __uint_as_float(r.x & 0xffff0000u), __uint_as_float(r.y << 16), __uint_as_float(r.y & 0xffff0000u)}; }
__device__ __forceinline__ void acc_zero(f32x4 (&acc)[2][2][4][2]) {
#pragma unroll
    for (int a = 0; a < 2; ++a)
#pragma unroll
        for (int b = 0; b < 2; ++b)
#pragma unroll
            for (int m = 0; m < 4; ++m)
#pragma unroll
                for (int n = 0; n < 2; ++n) acc[a][b][m][n] = (f32x4){0.f, 0.f, 0.f, 0.f};
}
struct EpiG1 {
    bf16_t* QB; bf16_t* GG; bf16_t* U; float* out; bf16_t* KBp; bf16_t* VTp;
    __device__ __forceinline__ void init(f32x4 (&acc)[2][2][4][2], const Unit&, int, int, int, int) const { acc_zero(acc); }
    __device__ __forceinline__ void operator()(const f32x4 (&acc)[2][2][4][2], const Unit& u, int wr, int wc, int fr, int fq) const {
        const int region = u.pn >> 1; const int cb = (u.pn & 1) * 256 + wc * 32 + 8 * fq; const int row0 = u.pm * 256 + wr * 64 + fr;
        const bool samp = u.pm >= 128;
#pragma unroll
        for (int ai = 0; ai < 2; ++ai)
#pragma unroll
            for (int m = 0; m < 4; ++m) { const int row = row0 + ai * 128 + m * 16;
#pragma unroll
                for (int bj = 0; bj < 2; ++bj) { const int col = cb + bj * 128; const f32x4 v0 = acc[ai][bj][m][0], v1 = acc[ai][bj][m][1];
                    if (region == 0) { u32x4 w; const float qs = 0.125f * 1.44269504089f;     w.x = cvt_pk_bf16(v0[0] * qs, v0[1] * qs); w.y = cvt_pk_bf16(v0[2] * qs, v0[3] * qs); w.z = cvt_pk_bf16(v1[0] * qs, v1[1] * qs); w.w = cvt_pk_bf16(v1[2] * qs, v1[3] * qs);
                        *(u32x4*)(QB + (size_t)row * 512 + col) = w; }
                    else if (region == 1 || region == 2) {
                        float* o = out + (region == 1 ? (samp ? OFF_KS : OFF_KP) : (samp ? OFF_VS : OFF_VP)) + (size_t)(samp ? row - MP : row) * 512 + col;
                        *(f32x4*)o = v0; *(f32x4*)(o + 4) = v1;
                        if (!samp) { const unsigned w0 = cvt_pk_bf16(v0[0], v0[1]), w1 = cvt_pk_bf16(v0[2], v0[3]), w2 = cvt_pk_bf16(v1[0], v1[1]), w3 = cvt_pk_bf16(v1[2], v1[3]);
                            const int bh = (row >> 12) * 8 + (col >> 6), pos = row & 4095, d0 = col & 63;
                            if (region == 1) { u32x4 w; w.x = w0; w.y = w1; w.z = w2; w.w = w3; *(u32x4*)(KBp + ((size_t)((bh * 128 + (pos >> 5)) * 4 + (d0 >> 4)) * 512 + (pos & 31) * 16 + (d0 & 15))) = w; }
                            else { bf16_t* vt = VTp + ((size_t)(bh * 1024 + (pos >> 2)) * 64 + d0) * 4 + (pos & 3);
                                vt[0] = (bf16_t)(w0 & 0xffffu); vt[4] = (bf16_t)(w0 >> 16); vt[8] = (bf16_t)(w1 & 0xffffu); vt[12] = (bf16_t)(w1 >> 16);
                                vt[16] = (bf16_t)(w2 & 0xffffu); vt[20] = (bf16_t)(w2 >> 16); vt[24] = (bf16_t)(w3 & 0xffffu); vt[28] = (bf16_t)(w3 >> 16); } } }
                    else if (region == 3) { u32x4 w; w.x = cvt_pk_bf16(v0[0], v0[1]); w.y = cvt_pk_bf16(v0[2], v0[3]); w.z = cvt_pk_bf16(v1[0], v1[1]); w.w = cvt_pk_bf16(v1[2], v1[3]); *(u32x4*)(U + (size_t)row * 512 + col) = w; }
                    else { u32x4 w; w.x = cvt_pk_bf16(gelu_tanh(v0[0]), gelu_tanh(v0[1])); w.y = cvt_pk_bf16(gelu_tanh(v0[2]), gelu_tanh(v0[3])); w.z = cvt_pk_bf16(gelu_tanh(v1[0]), gelu_tanh(v1[1])); w.w = cvt_pk_bf16(gelu_tanh(v1[2]), gelu_tanh(v1[3]));
                        *(u32x4*)(GG + (size_t)row * 512 + col) = w; }
                } asm volatile("" ::: "memory"); }
    }
};
struct EpiGate {
    const float *rgb, *igb, *lam; const bf16_t* UCBp; unsigned* AX;
    __device__ __forceinline__ void init(f32x4 (&acc)[2][2][4][2], const Unit&, int, int, int, int) const { acc_zero(acc); }
    __device__ __forceinline__ void operator()(const f32x4 (&acc)[2][2][4][2], const Unit& u, int wr, int wc, int fr, int fq) const {
        const int row0 = u.pm * 256 + wr * 64 + fr; const int cb = u.pn * 128 + wc * 32 + 8 * fq;
        const f32x4 sp0 = *(const f32x4*)(lam + cb), sp1 = *(const f32x4*)(lam + cb + 4), rb0 = *(const f32x4*)(rgb + cb), rb1 = *(const f32x4*)(rgb + cb + 4), ib0 = *(const f32x4*)(igb + cb), ib1 = *(const f32x4*)(igb + cb + 4);
#pragma unroll
        for (int ai = 0; ai < 2; ++ai) {
            f32x4 ucv[4][2];
#pragma unroll
            for (int m = 0; m < 4; ++m) { const u32x4 raw = *(const u32x4*)(UCBp + (size_t)(row0 + ai * 128 + m * 16) * 512 + cb); ucv[m][0] = bf4lo(raw); ucv[m][1] = bf4hi(raw); }
#pragma unroll
            for (int m = 0; m < 4; ++m)
#pragma unroll
                for (int n = 0; n < 2; ++n) { const size_t off = (size_t)(row0 + ai * 128 + m * 16) * 512 + cb + 4 * n;
                    const f32x4 uv = ucv[m][n], sp = n ? sp1 : sp0, rb = n ? rb1 : rb0, ib = n ? ib1 : ib0; u32x4 pk;
#pragma unroll
                    for (int j = 0; j < 4; ++j) { const float r = sigmoidf_(acc[ai][0][m][n][j] + rb[j]), ig = sigmoidf_(acc[ai][1][m][n][j] + ib[j]);
                        const float la = sp[j] * r; const float ae = __expf(la); const float om = 1.f - ae; pk[j] = cvt_pk_bf16(om, sqrtf(om * (1.f + ae)) * ig * uv[j]); }
                    *(u32x4*)(AX + off) = pk; }
            asm volatile("" ::: "memory"); }
    }
};
template <bool FROMX, bool TAIL = false> struct EpiRes {
    const float* xP; const float* xS; bf16_t* XB; float* ssq; float* part;
    __device__ __forceinline__ void init(f32x4 (&acc)[2][2][4][2], const Unit& u, int wr, int wc, int fr, int fq) const {
        const bool samp = u.pm >= 128;
        if (TAIL && samp) { acc_zero(acc); return; }
        const int cb = u.pn * 256 + wc * 32 + 8 * fq; const int row0 = u.pm * 256 + wr * 64 + fr;
        if (FROMX) { const float* rbase = (samp ? xS : xP) + (size_t)(row0 - (samp ? MP : 0)) * D + cb;
#pragma unroll
            for (int ai = 0; ai < 2; ++ai)
#pragma unroll
                for (int m = 0; m < 4; ++m)
#pragma unroll
                    for (int bj = 0; bj < 2; ++bj) { const float* rp = rbase + (size_t)(ai * 128 + m * 16) * D + bj * 128; acc[ai][bj][m][0] = *(const f32x4*)rp; acc[ai][bj][m][1] = *(const f32x4*)(rp + 4); } }
        else { const bf16_t* rbase = XB + (size_t)row0 * D + cb;
#pragma unroll
            for (int ai = 0; ai < 2; ++ai)
#pragma unroll
                for (int m = 0; m < 4; ++m)
#pragma unroll
                    for (int bj = 0; bj < 2; ++bj) { const u32x4 raw = *(const u32x4*)(rbase + (size_t)(ai * 128 + m * 16) * D + bj * 128); acc[ai][bj][m][0] = bf4lo(raw); acc[ai][bj][m][1] = bf4hi(raw); } }
    }
    __device__ __forceinline__ void operator()(const f32x4 (&acc)[2][2][4][2], const Unit& u, int wr, int wc, int fr, int fq) const {
        const int cb = u.pn * 256 + wc * 32 + 8 * fq; const int row0 = u.pm * 256 + wr * 64 + fr; const bool samp = u.pm >= 128;
        if (TAIL && samp) {
#pragma unroll
            for (int ai = 0; ai < 2; ++ai)
#pragma unroll
                for (int m = 0; m < 4; ++m) { const int row = row0 + ai * 128 + m * 16;
#pragma unroll
                    for (int bj = 0; bj < 2; ++bj) { float* xo = part + ((size_t)(u.kb >> 2) * MS + (row - MP)) * D + cb + bj * 128;
                        *(f32x4*)xo = acc[ai][bj][m][0]; *(f32x4*)(xo + 4) = acc[ai][bj][m][1]; } }
            return;
        }
#pragma unroll
        for (int ai = 0; ai < 2; ++ai)
#pragma unroll
            for (int m = 0; m < 4; ++m) { const int row = row0 + ai * 128 + m * 16; float s = 0.f;
#pragma unroll
                for (int bj = 0; bj < 2; ++bj) { const int col = cb + bj * 128; const f32x4 v0 = acc[ai][bj][m][0], v1 = acc[ai][bj][m][1];
                    u32x4 w; w.x = cvt_pk_bf16(v0[0], v0[1]); w.y = cvt_pk_bf16(v0[2], v0[3]); w.z = cvt_pk_bf16(v1[0], v1[1]); w.w = cvt_pk_bf16(v1[2], v1[3]); *(u32x4*)(XB + (size_t)row * D + col) = w;
                    s += (v0[0] * v0[0] + v0[1] * v0[1]) + (v0[2] * v0[2] + v0[3] * v0[3]) + (v1[0] * v1[0] + v1[1] * v1[1]) + (v1[2] * v1[2] + v1[3] * v1[3]); }
                s += __shfl_xor(s, 16); s += __shfl_xor(s, 32);
                if (fq == 0) atomicAdd(ssq + row, s); }
    }
};
struct EpiSwiglu {
    const float* ssq; bf16_t* H;
    __device__ __forceinline__ void init(f32x4 (&acc)[2][2][4][2], const Unit&, int, int, int, int) const { acc_zero(acc); }
    __device__ __forceinline__ void operator()(const f32x4 (&acc)[2][2][4][2], const Unit& u, int wr, int wc, int fr, int fq) const {
        const int col = u.pn * 128 + wc * 32 + 8 * fq; const int row0 = u.pm * 256 + wr * 64 + fr;
        float rsv[8];
#pragma unroll
        for (int i = 0; i < 8; ++i) rsv[i] = ssq[row0 + (i >> 2) * 128 + (i & 3) * 16];
#pragma unroll
        for (int ai = 0; ai < 2; ++ai)
#pragma unroll
            for (int m = 0; m < 4; ++m) { const int row = row0 + ai * 128 + m * 16; const float rs = rsqrtf(rsv[ai * 4 + m] * (1.f / D) + EPS); float h[8];
#pragma unroll
                for (int j = 0; j < 8; ++j) { const float gv = acc[ai][0][m][j >> 2][j & 3] * rs, uv = acc[ai][1][m][j >> 2][j & 3] * rs; h[j] = gv / (1.f + __expf(-gv)) * uv; }
                u32x4 w; w.x = cvt_pk_bf16(h[0], h[1]); w.y = cvt_pk_bf16(h[2], h[3]); w.z = cvt_pk_bf16(h[4], h[5]); w.w = cvt_pk_bf16(h[6], h[7]);
                *(u32x4*)(H + (size_t)row * FF + col) = w; }
    }
};

struct Args { const float* in[24]; float* out; unsigned char* ws; };
enum { I_XP = 0, I_XS, I_CK, I_CV, I_LH, I_LC, I_SP, I_WIN, I_CW, I_CB, I_RGW, I_RGB, I_IGW, I_IGB, I_LAM, I_WOUT, I_PW, I_PS, I_NM, I_NF, I_FG, I_FU, I_FD, I_NFIN };

__device__ __forceinline__ void transpose_tile(const float* W, int ldw, int srccol0, int k0, const float* gamma, bf16_t* WT, int ldwt, int dstrow0, LAS float* scr, int lane, const float* nscale = nullptr) {
    const float ns = nscale ? nscale[dstrow0 + (lane & 31)] : 1.f;
#pragma unroll
    for (int i = 0; i < 32; ++i) { const int kk = 2 * i + (lane >> 5); float v = W[(size_t)(k0 + kk) * ldw + srccol0 + (lane & 31)]; if (gamma) v *= gamma[k0 + kk]; scr[kk * 33 + (lane & 31)] = v * ns; }
    asm volatile("s_waitcnt lgkmcnt(0)" ::: "memory");
    const int c = lane & 7;
#pragma unroll
    for (int j = 0; j < 4; ++j) { const int n = (lane >> 3) + 8 * j; const LAS float* s = scr + (8 * c) * 33 + n;
        u32x4 o; o.x = cvt_pk_bf16(s[0 * 33], s[1 * 33]); o.y = cvt_pk_bf16(s[2 * 33], s[3 * 33]); o.z = cvt_pk_bf16(s[4 * 33], s[5 * 33]); o.w = cvt_pk_bf16(s[6 * 33], s[7 * 33]);
        *(u32x4*)(WT + (size_t)(dstrow0 + n) * ldwt + k0 + 8 * c) = o; }
    asm volatile("s_waitcnt lgkmcnt(0)" ::: "memory");
}
__device__ __forceinline__ float wave_sum(float v) {
#pragma unroll
    for (int o = 1; o < 64; o <<= 1) v += __shfl_xor(v, o);
    return v;
}
__device__ __forceinline__ int crow(int r, int hi) { return (r & 3) + 8 * (r >> 2) + 4 * hi; }

template <bool PR>
__device__ __forceinline__ void attn_unit(const Args& a, const bf16_t* QB, bf16_t* AO, const bf16_t* KBp, const bf16_t* VTp, int qt, int h, int lane) {
    const int r32 = lane & 31, hi = lane >> 5;
    const float *Kd, *Vd, *Kc, *Vc; int nprev; size_t qrow0;
    if (qt < 1024) { const int b = qt >> 7, tq = qt & 127; qrow0 = (size_t)qt * 32;
        Kc = a.out + OFF_KP + (size_t)b * 4096 * 512 + h * 64; Vc = a.out + OFF_VP + (size_t)b * 4096 * 512 + h * 64;
        Kd = Kc + (size_t)tq * 32 * 512; Vd = Vc + (size_t)tq * 32 * 512; nprev = tq; }
    else { const int bs = qt - 1024; qrow0 = (size_t)MP + (size_t)bs * 32;
        Kd = a.out + OFF_KS + (size_t)bs * 32 * 512 + h * 64; Vd = a.out + OFF_VS + (size_t)bs * 32 * 512 + h * 64;
        Kc = a.in[I_CK] + (size_t)bs * 4096 * 512 + h * 64; Vc = a.in[I_CV] + (size_t)bs * 4096 * 512 + h * 64; nprev = 128; }
    bf16x8 qf[4];
    { const bf16_t* Qp = QB + (qrow0 + r32) * 512 + h * 64 + hi * 8;
#pragma unroll
      for (int kk = 0; kk < 4; ++kk) qf[kk] = *(const bf16x8*)(Qp + kk * 16); }
    f32x16 o0, o1;
#pragma unroll
    for (int r = 0; r < 16; ++r) { o0[r] = 0.f; o1[r] = 0.f; }
    float Cm = 1.f; int Ce = 0;
    constexpr int DP = PR ? 3 : 1;
    f32x4 kr[8]; float vr[32];
    bf16x8 krb[DP][4]; u32x2 vrb[DP][8];
    const bf16_t* Kbb = KBp + (size_t)(((qt >> 7) * 8 + h) * 128) * 2048 + r32 * 16 + hi * 8;
    const bf16_t* Vtb = VTp + ((size_t)(((qt >> 7) * 8 + h) * 1024 + hi) * 64 + r32) * 4;
#define ATT_LOAD(Kt_, Vt_) do { const float* kp_ = (Kt_) + (size_t)r32 * 512 + hi * 8; \
        _Pragma("unroll") for (int kk = 0; kk < 4; ++kk) { kr[2 * kk] = *(const f32x4*)(kp_ + kk * 16); kr[2 * kk + 1] = *(const f32x4*)(kp_ + kk * 16 + 4); } \
        const float* vp_ = (Vt_) + (size_t)(4 * hi) * 512 + r32; \
        _Pragma("unroll") for (int sI = 0; sI < 2; ++sI) _Pragma("unroll") for (int dh = 0; dh < 2; ++dh) _Pragma("unroll") for (int i = 0; i < 8; ++i) \
            vr[(sI * 2 + dh) * 8 + i] = vp_[(size_t)(16 * sI + (i & 3) + 8 * (i >> 2)) * 512 + dh * 32]; } while (0)
#define ATT_LOADB(J_, key0_) do { const bf16_t* kp_ = Kbb + (size_t)((key0_) >> 5) * 2048; \
        _Pragma("unroll") for (int kk = 0; kk < 4; ++kk) krb[J_][kk] = *(const bf16x8*)(kp_ + kk * 512); \
        _Pragma("unroll") for (int sI = 0; sI < 2; ++sI) _Pragma("unroll") for (int dh = 0; dh < 2; ++dh) { const bf16_t* vp_ = Vtb + ((size_t)(((key0_) >> 2) + 4 * sI) * 64 + 32 * dh) * 4; \
            vrb[J_][(sI * 2 + dh) * 2] = *(const u32x2*)vp_; vrb[J_][(sI * 2 + dh) * 2 + 1] = *(const u32x2*)(vp_ + 2 * 64 * 4); } } while (0)
    if (PR) {
#pragma unroll
        for (int j = 0; j < DP; ++j) if (j <= nprev) ATT_LOADB(j, (nprev - j) * 32);
    } else ATT_LOAD(Kd, Vd);
    bool done = false;
    for (int it0 = 0; it0 <= nprev && !done; it0 += DP) {
#pragma unroll
      for (int j = 0; j < DP; ++j) { const int it = it0 + j; if (it > nprev) { done = true; break; }
        bf16x8 kf[4], vb[4];
        if (PR) {
#pragma unroll
            for (int kk = 0; kk < 4; ++kk) kf[kk] = krb[j][kk];
#pragma unroll
            for (int q = 0; q < 4; ++q) { u32x4 w; w.x = vrb[j][2 * q].x; w.y = vrb[j][2 * q].y; w.z = vrb[j][2 * q + 1].x; w.w = vrb[j][2 * q + 1].y; vb[q] = __builtin_bit_cast(bf16x8, w); }
            if (it + DP <= nprev) ATT_LOADB(j, (nprev - it - DP) * 32);
        } else {
#pragma unroll
            for (int kk = 0; kk < 4; ++kk) kf[kk] = pack8(kr[2 * kk][0], kr[2 * kk][1], kr[2 * kk][2], kr[2 * kk][3], kr[2 * kk + 1][0], kr[2 * kk + 1][1], kr[2 * kk + 1][2], kr[2 * kk + 1][3]);
#pragma unroll
            for (int q = 0; q < 4; ++q) vb[q] = pack8(vr[q * 8 + 0], vr[q * 8 + 1], vr[q * 8 + 2], vr[q * 8 + 3], vr[q * 8 + 4], vr[q * 8 + 5], vr[q * 8 + 6], vr[q * 8 + 7]);
            if (it < nprev) { const size_t toff = (size_t)(nprev - it - 1) * 32 * 512; ATT_LOAD(Kc + toff, Vc + toff); }
        }
        f32x16 s;
#pragma unroll
        for (int r = 0; r < 16; ++r) s[r] = 0.f;
#pragma unroll
        for (int kk = 0; kk < 4; ++kk) s = __builtin_amdgcn_mfma_f32_32x32x16_bf16(kf[kk], qf[kk], s, 0, 0, 0);
        float sg[16], om[16];
#pragma unroll
        for (int r = 0; r < 16; ++r) { const float z2 = s[r]; const float e = __builtin_amdgcn_exp2f(-fabsf(z2)); const float rc = __builtin_amdgcn_rcpf(1.f + e); const float t = e * rc;
            const bool pos = z2 >= 0.f; const bool valid = (it != 0) || (crow(r, hi) < r32);
            sg[r] = valid ? (pos ? rc : t) : 0.f; om[r] = valid ? (pos ? t : rc) : 1.f; }
        const float G0 = (om[0] * om[1]) * (om[2] * om[3]), G1 = (om[4] * om[5]) * (om[6] * om[7]), G2 = (om[8] * om[9]) * (om[10] * om[11]), G3 = (om[12] * om[13]) * (om[14] * om[15]);
        const float P0 = __shfl_xor(G0, 32), P1 = __shfl_xor(G1, 32), P2 = __shfl_xor(G2, 32), P3 = __shfl_xor(G3, 32);
        const float t3 = G3 * P3, t2 = G2 * P2, t1 = G1 * P1, t0 = G0 * P0;
        const float Cs = ldexpf(Cm, Ce);
        float base[4];
        base[3] = Cs * (hi ? 1.f : P3); base[2] = Cs * t3 * (hi ? 1.f : P2); base[1] = Cs * (t3 * t2) * (hi ? 1.f : P1); base[0] = Cs * ((t3 * t2) * t1) * (hi ? 1.f : P0);
        float w[16];
#pragma unroll
        for (int g = 0; g < 4; ++g) { float bt = base[g];
#pragma unroll
            for (int rr = 3; rr >= 0; --rr) { const int r = 4 * g + rr; w[r] = sg[r] * bt; bt *= om[r]; } }
        { const float nc = Cm * ((t0 * t1) * (t2 * t3)); Cm = __builtin_amdgcn_frexp_mantf(nc); Ce += __builtin_amdgcn_frexp_expf(nc); }
        const bf16x8 wa0 = pack8(w[0], w[1], w[2], w[3], w[4], w[5], w[6], w[7]), wa1 = pack8(w[8], w[9], w[10], w[11], w[12], w[13], w[14], w[15]);
        o0 = __builtin_amdgcn_mfma_f32_32x32x16_bf16(wa0, vb[0], o0, 0, 0, 0); o0 = __builtin_amdgcn_mfma_f32_32x32x16_bf16(wa1, vb[2], o0, 0, 0, 0);
        o1 = __builtin_amdgcn_mfma_f32_32x32x16_bf16(wa0, vb[1], o1, 0, 0, 0); o1 = __builtin_amdgcn_mfma_f32_32x32x16_bf16(wa1, vb[3], o1, 0, 0, 0);
        if (__all(Cm == 0.f || Ce < -150)) { done = true; break; }
      }
    }
#undef ATT_LOAD
#undef ATT_LOADB
    bf16_t* op = AO + qrow0 * D + h * 64 + r32;
#pragma unroll
    for (int r = 0; r < 16; ++r) { const size_t ro = (size_t)crow(r, hi) * D; op[ro] = (bf16_t)(cvt_pk_bf16(o0[r], 0.f) & 0xffffu); op[ro + 32] = (bf16_t)(cvt_pk_bf16(o1[r], 0.f) & 0xffffu); }
}


constexpr int PR = 8;
template <int W, bool SAMP>
__device__ __forceinline__ void pool_strip(const bf16_t* XRp, bf16_t* XBp, float* pout, const float* ssq2, const LAS float* ldsrs, const float* pbuf, const float* gm,
                                           int row0, int pos0, int seq, int Tseq, int c4) {
    const f32x4 gv = *(const f32x4*)(gm + c4);
    f32x4 xn[PR + W - 1];
#pragma unroll
    for (int j = 0; j < PR + W - 1; ++j) { const int p = pos0 - (W - 1) + j, rr = row0 - (W - 1) + j;
        if (p >= 0) { const float rs = SAMP ? ldsrs[p] : rsqrtf(ssq2[rr] * (1.f / D) + EPS); xn[j] = bf4(*(const u32x2*)(XRp + (size_t)rr * D + c4)) * rs * gv; }
        else if (SAMP) xn[j] = *(const f32x4*)(pbuf + ((size_t)seq * 15 + (15 + p)) * D + c4);
        else xn[j] = (f32x4){0.f, 0.f, 0.f, 0.f}; }
    f32x4 Sw = (f32x4){0.f, 0.f, 0.f, 0.f};
#pragma unroll
    for (int j = 0; j < W - 1; ++j) Sw = Sw + xn[j];
#pragma unroll
    for (int t = 0; t < PR; ++t) { const int pos = pos0 + t; const f32x4 x = xn[t + W - 1]; Sw = Sw + x;
        const float cnt = SAMP ? (float)W : (float)((pos + 1 < W) ? pos + 1 : W); const f32x4 dv = Sw * (1.f / cnt) - x;
        u32x2 wv; wv.x = cvt_pk_bf16(dv[0], dv[1]); wv.y = cvt_pk_bf16(dv[2], dv[3]); *(u32x2*)(XBp + (size_t)(row0 + t) * D + c4) = wv;
        if (pos >= Tseq - 15) *(f32x4*)(pout + ((size_t)seq * 15 + (pos - (Tseq - 15))) * D + c4) = x;
        Sw = Sw - xn[t]; }
}

#define XB_TMO      128
#define XB_XCNT(j)  (256  + 64 * (j))
#define XB_XSUB(j)  (1280 + 64 * (j))
#define XB_XGEN(j)  (2304 + 64 * (j))
#define XB_TOP      3328
#define XB_TOPGEN   3392
#define XCD_BAR_WORDS 3456
#define XB_SPIN_CAP (1u << 18)

__device__ __forceinline__ unsigned xb_ld(unsigned* p)              { return __hip_atomic_load(p, __ATOMIC_RELAXED, __HIP_MEMORY_SCOPE_AGENT); }
__device__ __forceinline__ unsigned xb_add(unsigned* p, unsigned v) { return __hip_atomic_fetch_add(p, v, __ATOMIC_RELAXED, __HIP_MEMORY_SCOPE_AGENT); }
__device__ __forceinline__ unsigned xb_xcc_id() { return (unsigned)__builtin_amdgcn_s_getreg((3 << 11) | 20) & 0xFu; }
#define XB_SPIN(cond, bar) do { unsigned _sp = 0; while (cond) { __builtin_amdgcn_s_sleep(1); \
    if ((++_sp & 255u) == 0u) { if (xb_ld(&(bar)[XB_TMO])) break; if (_sp > XB_SPIN_CAP) { atomicAdd(&(bar)[XB_TMO], 1u); break; } } } } while (0)

struct XcdBarrier {
    unsigned* bar; unsigned x;
    volatile LAS unsigned* st;
};

__device__ __forceinline__ XcdBarrier xcd_barrier_post(unsigned* bar, volatile LAS unsigned* st) {
    XcdBarrier b; b.bar = bar; b.x = xb_xcc_id(); b.st = st;
    if (threadIdx.x == 0) (void)xb_add(&bar[XB_XCNT(b.x)], 1u);
    return b;
}
__device__ __forceinline__ void xcd_barrier_complete(unsigned* bar, unsigned x, unsigned& nloc, unsigned& nx) {
    const unsigned G = gridDim.x * gridDim.y * gridDim.z;
    unsigned sum, cnt, mine, sp = 0u;
    for (;;) {
        sum = 0u; cnt = 0u; mine = 0u;
#pragma unroll
        for (unsigned j = 0; j < 16; ++j) { const unsigned c = xb_ld(&bar[XB_XCNT(j)]); sum += c; cnt += (c > 0u) ? 1u : 0u; mine = (j == x) ? c : mine; }
        if (sum == G) break;
        __builtin_amdgcn_s_sleep(1);
        if ((++sp & 255u) == 0u) { if (xb_ld(&bar[XB_TMO])) break; if (sp > XB_SPIN_CAP) { atomicAdd(&bar[XB_TMO], 1u); break; } }
    }
    nloc = mine > 0u ? mine : 1u; nx = cnt > 0u ? cnt : 1u;
}

__device__ __forceinline__ void xcd_barrier(const XcdBarrier& b) {
    asm volatile("s_waitcnt vmcnt(0)" ::: "memory");
    __syncthreads();
    if (threadIdx.x == 0) {
        unsigned* bar = b.bar;
        __builtin_amdgcn_s_waitcnt(0);
        unsigned nloc = b.st[0], nx = b.st[1];
        if (nloc == 0u) { xcd_barrier_complete(bar, b.x, nloc, nx); b.st[0] = nloc; b.st[1] = nx; }
        const unsigned old = xb_add(&bar[XB_XSUB(b.x)], 1u);
        const unsigned gen = old / nloc;
        if (old + 1u == (gen + 1u) * nloc) {
            __builtin_amdgcn_fence(__ATOMIC_RELEASE, "agent");
            asm volatile("s_waitcnt vmcnt(0)" ::: "memory");
            const unsigned og = xb_add(&bar[XB_TOP], 1u);
            const unsigned tg = og / nx;
            if (og + 1u == (tg + 1u) * nx) xb_add(&bar[XB_TOPGEN], 1u);
            else XB_SPIN(xb_ld(&bar[XB_TOPGEN]) == tg, bar);
            __builtin_amdgcn_fence(__ATOMIC_ACQUIRE, "agent");
            xb_add(&bar[XB_XGEN(b.x)], 1u);
            asm volatile("s_waitcnt vmcnt(0)" ::: "memory");
        } else {
            XB_SPIN(xb_ld(&bar[XB_XGEN(b.x)]) == gen, bar);
            __builtin_amdgcn_fence(__ATOMIC_ACQUIRE, "agent");
            asm volatile("s_waitcnt vmcnt(0)" ::: "memory");
        }
    }
    __syncthreads();
}


#ifndef SKIPMASK
#define SKIPMASK 0
#endif
#define PH(n) if (!((SKIPMASK >> (n)) & 1))
__global__ void __launch_bounds__(512, 2) fwd_kernel(Args a) {
    extern __shared__ __attribute__((aligned(16))) unsigned char lds[];
    cg::grid_group grid = cg::this_grid();
    PG8_LAS unsigned char* L = (PG8_LAS unsigned char*)lds;
    const int tid = threadIdx.x, lane = tid & 63, wave = __builtin_amdgcn_readfirstlane(tid >> 6);
    const int G = gridDim.x, bx = blockIdx.x;
    const int gw = bx * 8 + wave, NGW = G * 8; const int gt = bx * 512 + tid, NGT = G * 512;
    float* const out = a.out;
    volatile LAS unsigned* bst = (volatile LAS unsigned*)(L + 131072 + 64);
    if (tid < 4) bst[tid] = 0u;
    __syncthreads();
    const XcdBarrier xbar = xcd_barrier_post((unsigned*)(a.ws + WS_BAR), bst);
#define ws (a.ws)
#define SSQ ((float*)(ws + WS_SSQ))
#define SUMA ((float*)(ws + WS_SUM))
#define SUMH (SUMA + 512 * 512)
#define SPL ((float*)(ws + WS_SPL))
#define WIN ((bf16_t*)(ws + WS_WIN))
#define WG ((bf16_t*)(ws + WS_WG))
#define WOUT ((bf16_t*)(ws + WS_WOUT))
#define WGU ((bf16_t*)(ws + WS_WGU))
#define WD ((bf16_t*)(ws + WS_WD))
#define WP ((bf16_t*)(ws + WS_WP))
#define XB ((bf16_t*)(ws + WS_XB))
#define QB ((bf16_t*)(ws + WS_QB))
#define GG ((bf16_t*)(ws + WS_GG))
#define UCB ((bf16_t*)(ws + WS_UCB))
#define KB ((bf16_t*)(ws + WS_KB))
#define VT ((bf16_t*)(ws + WS_VT))
#define U ((bf16_t*)(ws + WS_U))
#define AX ((unsigned*)(ws + WS_AA))
#define AO ((bf16_t*)(ws + WS_AO))
#define H ((bf16_t*)(ws + WS_H))
#define PART ((float*)(ws + WS_PART))

    PH(0)
    {
        for (int i = gt; i < 4 * M; i += NGT) SSQ[i] = 0.f;
        if (gt < 512) SPL[gt] = -8.f * log1pf(expf(-a.in[I_LAM][gt]));
        LAS float* scr = (LAS float*)(L + wave * 16384);
        constexpr int IT_WIN = 16 * 80, IT_WOUT = 16 * 32, IT_WGU = 16 * 176, IT_WD = 44 * 32, IT_WP = 4 * 8;
        constexpr int NITEMS = IT_WIN + IT_WOUT + 2 * IT_WGU + 2 * IT_WD + 4 * IT_WP;
        for (int it = gw; it < NITEMS; it += NGW) {
            int r = it;
            if (r >= IT_WIN + IT_WOUT) break;
            if (r < IT_WIN) { const int kb = r / 80, nb = r % 80; transpose_tile(a.in[I_WIN], NIN, nb * 32, kb * 64, a.in[I_NM], WIN, D, nb * 32, scr, lane); continue; } r -= IT_WIN;
            if (r < IT_WOUT) { const int kb = r / 32, nb = r % 32; transpose_tile(a.in[I_WOUT], D, nb * 32, kb * 64, nullptr, WOUT, D, nb * 32, scr, lane); continue; } r -= IT_WOUT;
            if (r < 2 * IT_WGU) { const int l = r / IT_WGU; r -= l * IT_WGU; const int kb = r / 176, nb = r % 176; const int n0 = nb * 32;
                const float* src = ((n0 & 128) ? a.in[I_FU] : a.in[I_FG]) + (size_t)l * D * FF; const int sc0 = (n0 >> 8) * 128 + (n0 & 127);
                transpose_tile(src, FF, sc0, kb * 64, a.in[I_NF] + l * D, WGU + (size_t)l * NGU * D, D, n0, scr, lane); continue; } r -= 2 * IT_WGU;
            if (r < 2 * IT_WD) { const int l = r / IT_WD; r -= l * IT_WD; const int kb = r / 32, nb = r % 32;
                transpose_tile(a.in[I_FD] + (size_t)l * FF * D, D, nb * 32, kb * 64, nullptr, WD + (size_t)l * D * FF, FF, nb * 32, scr, lane); continue; } r -= 2 * IT_WD;
            { const int g = r / IT_WP; r -= g * IT_WP; const int kb = r / 8, nb = r % 8;
                transpose_tile(a.in[I_PW] + (size_t)g * 256 * 256, 256, nb * 32, kb * 64, nullptr, WP, 256, g * 256 + nb * 32, scr, lane, a.in[I_PS]); }
        }
        for (int i = gt; i < 1024 * 128; i += NGT) { const int np = i >> 7, kk = i & 127; const int pn = np >> 8, bj = (np >> 7) & 1, j = np & 127; const int c = 128 * pn + j, cin = 128 * pn + kk;
            float v = 0.f; if ((cin >> 6) == (c >> 6)) v = (bj ? a.in[I_IGW] : a.in[I_RGW])[(size_t)(c >> 6) * 4096 + (cin & 63) * 64 + (c & 63)];
            WG[i] = (bf16_t)(cvt_pk_bf16(v, 0.f) & 0xffffu); }
        for (int m0 = gw; m0 < M; m0 += 2 * NGW) { const int m1 = m0 + NGW; const bool has1 = m1 < M;
            const float* xr0 = (m0 < MP) ? a.in[I_XP] + (size_t)m0 * D : a.in[I_XS] + (size_t)(m0 - MP) * D;
            const float* xr1 = has1 ? ((m1 < MP) ? a.in[I_XP] + (size_t)m1 * D : a.in[I_XS] + (size_t)(m1 - MP) * D) : xr0;
            f32x4 v0[4], v1[4]; float s0 = 0.f, s1 = 0.f;
#pragma unroll
            for (int j = 0; j < 4; ++j) { v0[j] = ((const f32x4*)xr0)[lane + 64 * j]; v1[j] = ((const f32x4*)xr1)[lane + 64 * j]; }
#pragma unroll
            for (int j = 0; j < 4; ++j) { s0 += (v0[j][0] * v0[j][0] + v0[j][1] * v0[j][1]) + (v0[j][2] * v0[j][2] + v0[j][3] * v0[j][3]); s1 += (v1[j][0] * v1[j][0] + v1[j][1] * v1[j][1]) + (v1[j][2] * v1[j][2] + v1[j][3] * v1[j][3]); }
            const float rs0 = rsqrtf(wave_sum(s0) * (1.f / D) + EPS), rs1 = rsqrtf(wave_sum(s1) * (1.f / D) + EPS);
#pragma unroll
            for (int j = 0; j < 4; ++j) { u32x2 w; w.x = cvt_pk_bf16(v0[j][0] * rs0, v0[j][1] * rs0); w.y = cvt_pk_bf16(v0[j][2] * rs0, v0[j][3] * rs0); ((u32x2*)(XB + (size_t)m0 * D))[lane + 64 * j] = w; }
            if (has1) {
#pragma unroll
                for (int j = 0; j < 4; ++j) { u32x2 w; w.x = cvt_pk_bf16(v1[j][0] * rs1, v1[j][1] * rs1); w.y = cvt_pk_bf16(v1[j][2] * rs1, v1[j][3] * rs1); ((u32x2*)(XB + (size_t)m1 * D))[lane + 64 * j] = w; } } }
    }
    xcd_barrier(xbar);
    if (a.out == nullptr) grid.sync();
    pg8::StaticOrder S;
    PH(1)
    { pg8::Gemm g{XB, WIN, M, NIN, D, D, 0}; pg8::G1Order S1; S1.init(G, bx); EpiG1 E{QB, GG, U, out, KB, VT}; pg8::gemm_phase(L, g, S1, E); }
    xcd_barrier(xbar);
    PH(2)
    { const float* cw = a.in[I_CW]; const float* cbias = a.in[I_CB]; S.init(M, 1024, G, bx);
      for (int i = 0; ; ++i) { pg8::Unit tu; if (!S.next(i, tu)) break;
        for (int item = tid; item < 32 * 32; item += 512) { const int c4 = tu.pn * 128 + (item & 31) * 4; const int row0 = tu.pm * 256 + (item >> 5) * 8;
            int pos0, T, seq; const bool samp = row0 >= MP; if (!samp) { pos0 = row0 & 4095; T = 4096; seq = row0 >> 12; } else { pos0 = (row0 - MP) & 31; T = 32; seq = (row0 - MP) >> 5; }
            f32x4 uu[11];
#pragma unroll
            for (int j = 0; j < 11; ++j) { const int p = pos0 - 3 + j;
                if (p >= 0) uu[j] = bf4(*(const u32x2*)(U + (size_t)(row0 - 3 + j) * 512 + c4));
                else if (samp) uu[j] = *(const f32x4*)(a.in[I_LC] + ((size_t)seq * 3 + (3 + p)) * 512 + c4);
                else uu[j] = (f32x4){0.f, 0.f, 0.f, 0.f}; }
            const f32x4 cb4 = *(const f32x4*)(cbias + c4), w0 = *(const f32x4*)(cw + c4), w1 = *(const f32x4*)(cw + 512 + c4), w2 = *(const f32x4*)(cw + 1024 + c4), w3 = *(const f32x4*)(cw + 1536 + c4);
#pragma unroll
            for (int t = 0; t < 8; ++t) { const f32x4 accv = cb4 + uu[t] * w0 + uu[t + 1] * w1 + uu[t + 2] * w2 + uu[t + 3] * w3;
                u32x2 w; w.x = cvt_pk_bf16(accv[0], accv[1]); w.y = cvt_pk_bf16(accv[2], accv[3]); *(u32x2*)(UCB + (size_t)(row0 + t) * 512 + c4) = w;
                if (pos0 + t >= T - 3) *(f32x4*)(out + (samp ? OFF_CS : OFF_CP) + ((size_t)seq * 3 + (pos0 + t - (T - 3))) * 512 + c4) = uu[t + 3]; } } }
      asm volatile("s_waitcnt vmcnt(0)" ::: "memory"); __syncthreads(); }
    PH(3)
    { pg8::Gemm g{UCB, WG, M, 1024, 128, 512, 128}; S.init(M, 1024, G, bx); EpiGate E{a.in[I_RGB], a.in[I_IGB], SPL, UCB, AX}; pg8::gemm_phase(L, g, S, E); }
    PH(4)
    for (int i = 0; ; ++i) { pg8::Unit tu; if (!S.next(i, tu)) break; if (tu.pm >= 128) continue;
        const int chunk = 4 * tu.pm + (wave >> 1), c = (2 * tu.pn + (wave & 1)) * 64 + lane; const size_t base = (size_t)chunk * 64 * 512 + c;
        float hl = 0.f, ap = 1.f;
#pragma unroll 32
        for (int t = 0; t < 64; ++t) { const unsigned pk = AX[base + (size_t)t * 512]; const float av = 1.f - __uint_as_float(pk << 16), xv = __uint_as_float(pk & 0xffff0000u); hl = av * hl + xv; ap *= av; }
        SUMA[chunk * 512 + c] = ap; SUMH[chunk * 512 + c] = hl; }
    PH(3)
    { pg8::Gemm g{XB, WIN, M, NIN, D, D, 0}; pg8::G1Tail S2; S2.init(G, bx); EpiG1 E{QB, GG, U, out, KB, VT}; pg8::gemm_phase(L, g, S2, E); }
    PH(14) { unsigned* actr = (unsigned*)(ws + WS_BAR) + 3584;
        unsigned u = (unsigned)gw;
        while (u < 1056u * 8u) {
            unsigned nx = 0; if (lane == 0) nx = atomicAdd(actr, 1u) + (unsigned)NGW;
            if (u < 256u) { const int uu = (int)(8192u + u); attn_unit<false>(a, QB, AO, KB, VT, uu >> 3, uu & 7, lane); } else { const int uu = (int)(u - 256u); attn_unit<true>(a, QB, AO, KB, VT, uu >> 3, uu & 7, lane); }
            u = (unsigned)__builtin_amdgcn_readfirstlane((int)nx); } }
    xcd_barrier(xbar);
    PH(5)
    for (int u = gw; u < 512 * 8 + 32 * 8; u += NGW) {
        const bool samp = u >= 4096; int row0, nt, c; float hcur; bool lastc; float* hout;
        if (!samp) { const int chunk = u >> 3; c = (u & 7) * 64 + lane; const int b = chunk >> 6, ci = chunk & 63; row0 = chunk * 64; nt = 64; hcur = 0.f;
            for (int j0 = 0; j0 < ci; j0 += 8) { float sa[8], sh[8];
#pragma unroll
                for (int k = 0; k < 8; ++k) { const bool ok = (j0 + k) < ci; const int jj = ok ? (j0 + k) : j0; sa[k] = SUMA[(b * 64 + jj) * 512 + c]; sh[k] = SUMH[(b * 64 + jj) * 512 + c]; if (!ok) { sa[k] = 1.f; sh[k] = 0.f; } }
#pragma unroll
                for (int k = 0; k < 8; ++k) hcur = sa[k] * hcur + sh[k]; }
            lastc = (ci == 63); hout = out + OFF_HP + b * 512 + c; }
        else { const int v = u - 4096; const int bs = v >> 3; c = (v & 7) * 64 + lane; row0 = MP + bs * 32; nt = 32; hcur = a.in[I_LH][bs * 512 + c]; lastc = true; hout = out + OFF_HS + bs * 512 + c; }
        const size_t base = (size_t)row0 * 512 + c;
        for (int t0 = 0; t0 < nt; t0 += 32) { unsigned pk[32]; bf16_t gg[32];
#pragma unroll
            for (int k = 0; k < 32; ++k) { pk[k] = AX[base + (size_t)(t0 + k) * 512]; gg[k] = GG[base + (size_t)(t0 + k) * 512]; }
#pragma unroll
            for (int k = 0; k < 32; ++k) { const float av = 1.f - __uint_as_float(pk[k] << 16), xv = __uint_as_float(pk[k] & 0xffff0000u); hcur = av * hcur + xv;
                AO[(size_t)(row0 + t0 + k) * D + 512 + c] = (bf16_t)(cvt_pk_bf16(hcur * bf2f(gg[k]), 0.f) & 0xffffu); } }
        if (lastc) *hout = hcur; }
    xcd_barrier(xbar);
    PH(6)
    { pg8::Gemm g{AO, WOUT, M, D, D, D, 0}; S.init(M, D, G, bx); EpiRes<true> E{a.in[I_XP], a.in[I_XS], XB, SSQ, nullptr}; pg8::gemm_phase(L, g, S, E); }
    PH(6)
    { const int rem = (M / 256 * (D / 256)) % G; const int b0 = rem; const int nblk = G - b0;
      if (bx >= b0) { LAS float* scr = (LAS float*)(L + wave * 16384); const int dw = (bx - b0) * 8 + wave, NDW = nblk * 8;
        constexpr int IT_WGU = 16 * 176, IT_WD = 44 * 32, IT_WP = 4 * 8;
        for (int it = dw; it < IT_WGU + IT_WD + 4 * IT_WP; it += NDW) {
            int r = it;
            if (r < IT_WGU) { const int kb = r / 176, nb = r % 176; const int n0 = nb * 32;
                const float* src = (n0 & 128) ? a.in[I_FU] : a.in[I_FG]; const int sc0 = (n0 >> 8) * 128 + (n0 & 127);
                transpose_tile(src, FF, sc0, kb * 64, a.in[I_NF], WGU, D, n0, scr, lane); continue; } r -= IT_WGU;
            if (r < IT_WD) { const int kb = r / 32, nb = r % 32; transpose_tile(a.in[I_FD], D, nb * 32, kb * 64, nullptr, WD, FF, nb * 32, scr, lane); continue; } r -= IT_WD;
            { const int g = r / IT_WP; r -= g * IT_WP; const int kb = r / 8, nb = r % 8;
                transpose_tile(a.in[I_PW] + (size_t)g * 256 * 256, 256, nb * 32, kb * 64, nullptr, WP, 256, g * 256 + nb * 32, scr, lane, a.in[I_PS]); }
        } } }
    xcd_barrier(xbar);
    PH(7)
    { pg8::Gemm g{XB, WGU, M, NGU, D, D, 0}; S.init(M, NGU, G, bx); EpiSwiglu E{SSQ, H}; pg8::gemm_phase(L, g, S, E); }
    PH(7)
    { const int rem = (M / 256 * (NGU / 256)) % G; const int b0 = rem; const int nblk = G - b0;
      if (bx >= b0) { LAS float* scr = (LAS float*)(L + wave * 16384); const int dw = (bx - b0) * 8 + wave, NDW = nblk * 8;
        constexpr int IT_WGU = 16 * 176, IT_WD = 44 * 32;
        for (int it = dw; it < IT_WGU + IT_WD; it += NDW) {
            int r = it;
            if (r < IT_WGU) { const int kb = r / 176, nb = r % 176; const int n0 = nb * 32;
                const float* src = ((n0 & 128) ? a.in[I_FU] : a.in[I_FG]) + (size_t)D * FF; const int sc0 = (n0 >> 8) * 128 + (n0 & 127);
                transpose_tile(src, FF, sc0, kb * 64, a.in[I_NF] + D, WGU + (size_t)NGU * D, D, n0, scr, lane); continue; } r -= IT_WGU;
            { const int kb = r / 32, nb = r % 32; transpose_tile(a.in[I_FD] + (size_t)FF * D, D, nb * 32, kb * 64, nullptr, WD + (size_t)D * FF, FF, nb * 32, scr, lane); }
        } } }
    xcd_barrier(xbar);
    PH(8)
    { pg8::Gemm g{H, WD, M, D, FF, FF, 0}; pg8::TailOrder ST; ST.init(FF, G, bx); EpiRes<false, true> E{nullptr, nullptr, XB, SSQ + M, PART}; pg8::gemm_phase(L, g, ST, E); }
    xcd_barrier(xbar);
    PH(9)
    {
        const float* ssq2 = SSQ + M; const float* gm = a.in[I_NM] + D; const float* pbuf = a.in[I_SP]; const LAS float* ldsrs = (const LAS float*)L;
        for (int idx = gt; idx < (MP / PR) * 256; idx += NGT) { const int strip = idx >> 8, c4 = (idx & 255) * 4; const int row0 = strip * PR, pos0 = row0 & 4095, seq = row0 >> 12;
            switch (c4 >> 8) {
                case 0: pool_strip<2, false>(XB, AO, out + OFF_PP, ssq2, ldsrs, pbuf, gm, row0, pos0, seq, 4096, c4); break;
                case 1: pool_strip<4, false>(XB, AO, out + OFF_PP, ssq2, ldsrs, pbuf, gm, row0, pos0, seq, 4096, c4); break;
                case 2: pool_strip<8, false>(XB, AO, out + OFF_PP, ssq2, ldsrs, pbuf, gm, row0, pos0, seq, 4096, c4); break;
                default: pool_strip<16, false>(XB, AO, out + OFF_PP, ssq2, ldsrs, pbuf, gm, row0, pos0, seq, 4096, c4); break; } }
        for (int sidx = bx; sidx < 32; sidx += G) {
            __syncthreads();
#pragma unroll
            for (int j = 0; j < 4; ++j) { const int r = wave * 4 + j; u32x2* xr = (u32x2*)(XB + (size_t)(MP + sidx * 32 + r) * D); const f32x4* pr = (const f32x4*)(PART + (size_t)(sidx * 32 + r) * D); float sq = 0.f;
#pragma unroll
                for (int q = 0; q < 4; ++q) { f32x4 v = bf4(xr[lane + 64 * q]);
#pragma unroll
                    for (int ks = 0; ks < 11; ++ks) v = v + pr[(size_t)ks * (MS * D / 4) + lane + 64 * q];
                    u32x2 wv; wv.x = cvt_pk_bf16(v[0], v[1]); wv.y = cvt_pk_bf16(v[2], v[3]); xr[lane + 64 * q] = wv; sq += (v[0] * v[0] + v[1] * v[1]) + (v[2] * v[2] + v[3] * v[3]); }
                sq = wave_sum(sq); if (lane == 0) ((LAS float*)L)[r] = rsqrtf(sq * (1.f / D) + EPS); }
            asm volatile("s_waitcnt vmcnt(0)" ::: "memory"); __threadfence_block(); __syncthreads();
            const int c4 = (tid & 255) * 4, half = tid >> 8;
            for (int sub = 0; sub < 16 / PR; ++sub) { const int pos0 = half * 16 + sub * PR, row0 = MP + sidx * 32 + pos0;
            switch (c4 >> 8) {
                case 0: pool_strip<2, true>(XB, AO, out + OFF_PS, ssq2, ldsrs, pbuf, gm, row0, pos0, sidx, 32, c4); break;
                case 1: pool_strip<4, true>(XB, AO, out + OFF_PS, ssq2, ldsrs, pbuf, gm, row0, pos0, sidx, 32, c4); break;
                case 2: pool_strip<8, true>(XB, AO, out + OFF_PS, ssq2, ldsrs, pbuf, gm, row0, pos0, sidx, 32, c4); break;
                default: pool_strip<16, true>(XB, AO, out + OFF_PS, ssq2, ldsrs, pbuf, gm, row0, pos0, sidx, 32, c4); break; } } }
    }
    xcd_barrier(xbar);
    PH(10)
    { pg8::Gemm g{AO  , WP, M, D, 256, D, 256}; S.init(M, D, G, bx); EpiRes<false> E{nullptr, nullptr, XB, SSQ + 2 * M, nullptr}; pg8::gemm_phase(L, g, S, E); }
    xcd_barrier(xbar);
    PH(11)
    { pg8::Gemm g{XB, WGU + (size_t)NGU * D, M, NGU, D, D, 0}; S.init(M, NGU, G, bx); EpiSwiglu E{SSQ + 2 * M, H}; pg8::gemm_phase(L, g, S, E); }
    xcd_barrier(xbar);
    PH(12)
    { pg8::Gemm g{H, WD + (size_t)D * FF, M, D, FF, FF, 0}; pg8::TailOrder ST; ST.init(FF, G, bx); EpiRes<false, true> E{nullptr, nullptr, XB, SSQ + 3 * M, PART}; pg8::gemm_phase(L, g, ST, E); }
    xcd_barrier(xbar);
    PH(13)
    { const float* ssq4 = SSQ + 3 * M; const f32x4* gf = (const f32x4*)a.in[I_NFIN];
      for (int m0 = gw; m0 < M; m0 += 2 * NGW) {
          const int m1 = (m0 + NGW < M) ? m0 + NGW : m0; const bool has1 = m0 + NGW < M;
          const u32x2* p0 = (const u32x2*)(XB + (size_t)m0 * D); const u32x2* p1 = (const u32x2*)(XB + (size_t)m1 * D); u32x2 r0[4], r1[4];
#pragma unroll
          for (int q = 0; q < 4; ++q) { r0[q] = p0[lane + 64 * q]; r1[q] = p1[lane + 64 * q]; }
#pragma unroll
          for (int rr = 0; rr < 2; ++rr) { if (rr == 1 && !has1) break; const int m = rr ? m1 : m0; f32x4 v[4]; float sq = 0.f;
#pragma unroll
              for (int q = 0; q < 4; ++q) v[q] = bf4(rr ? r1[q] : r0[q]);
              if (m >= MP) { const f32x4* pr = (const f32x4*)(PART + (size_t)(m - MP) * D);
#pragma unroll
                  for (int ks = 0; ks < 11; ++ks)
#pragma unroll
                      for (int q = 0; q < 4; ++q) v[q] = v[q] + pr[(size_t)ks * (MS * D / 4) + lane + 64 * q]; }
#pragma unroll
              for (int q = 0; q < 4; ++q) sq += (v[q][0] * v[q][0] + v[q][1] * v[q][1]) + (v[q][2] * v[q][2] + v[q][3] * v[q][3]);
              const float ss = (m >= MP) ? wave_sum(sq) : ssq4[m]; const float rs = rsqrtf(ss * (1.f / D) + EPS);
              f32x4* yo = (f32x4*)(out + OFF_Y + (size_t)m * D);
#pragma unroll
              for (int q = 0; q < 4; ++q) yo[lane + 64 * q] = v[q] * rs * gf[lane + 64 * q]; } } }
}

#undef ws
#undef SSQ
#undef SUMA
#undef SUMH
#undef KB
#undef VT
#undef PART
#undef SPL
#undef WIN
#undef WG
#undef WOUT
#undef WGU
#undef WD
#undef WP
#undef XB
#undef QB
#undef GG
#undef UCB
#undef U
#undef AX
#undef AO
#undef H
extern "C" void kernel_launch(void* const* d_in, const int* in_sizes, int n_in, void* d_out, int out_size, void* d_ws, size_t ws_size, hipStream_t stream) {
    static int grid = 0;
    if (grid == 0) {
        if (n_in != 24 || out_size != (int)OUT_TOTAL || ws_size < WS_END) { fprintf(stderr, "kernel_launch: unexpected shapes (n_in %d out %d ws %zu)\n", n_in, out_size, ws_size); grid = -1; return; }
        int dev = 0, cus = 0, per_cu = 0;
        hipGetDevice(&dev); hipDeviceGetAttribute(&cus, hipDeviceAttributeMultiprocessorCount, dev);
        hipFuncSetAttribute((const void*)fwd_kernel, hipFuncAttributeMaxDynamicSharedMemorySize, LDS_BYTES);
        hipOccupancyMaxActiveBlocksPerMultiprocessor(&per_cu, (const void*)fwd_kernel, 512, LDS_BYTES);
        if (per_cu < 1) { fprintf(stderr, "kernel_launch: occupancy query says %d blocks/CU\n", per_cu); per_cu = 1; }
        (void)hipGetLastError();
        grid = cus * per_cu;
    }
    if (grid < 0) return;
    (void)hipMemsetAsync((char*)d_ws + WS_BAR, 0, 16384, stream);
    Args a{};
    for (int i = 0; i < 24; ++i) a.in[i] = (const float*)d_in[i];
    a.out = (float*)d_out; a.ws = (unsigned char*)d_ws;
    void* params[] = {&a};
    hipError_t e = hipLaunchCooperativeKernel((const void*)fwd_kernel, dim3(grid), dim3(512), params, LDS_BYTES, stream);
    if (e != hipSuccess) fprintf(stderr, "cooperative launch failed: %s (grid %d)\n", hipGetErrorString(e), grid);
}
```

```cpp
#include <hip/hip_runtime.h>
#include <hip/hip_cooperative_groups.h>
#include <cstdio>
#include <cstdint>
namespace cg = cooperative_groups;

constexpr int MP = 32768;
constexpr int MS = 1024;
constexpr int M = MP + MS;
constexpr int D = 1024, NIN = 2560, FF = 2816, NGU = 2 * FF;
constexpr float EPS = 1e-6f;
constexpr size_t OFF_Y = 0, OFF_KP = 34603008, OFF_VP = 51380224, OFF_HP = 68157440, OFF_CP = 68161536, OFF_PP = 68173824,
                 OFF_KS = 68296704, OFF_VS = 68820992, OFF_HS = 69345280, OFF_CS = 69361664, OFF_PS = 69410816, OUT_TOTAL = 69902336;
constexpr size_t MiB = 1u << 20;
constexpr size_t WS_SSQ = 0, WS_SUM = 1 * MiB, WS_SPL = 3 * MiB, WS_BAR = 3 * MiB + 512 * 1024, WS_WIN = 4 * MiB, WS_WG = 9 * MiB, WS_WOUT = 10 * MiB, WS_WGU = 12 * MiB, WS_WD = 34 * MiB, WS_WP = 45 * MiB,
                 WS_XB = 48 * MiB, WS_QB = 114 * MiB, WS_GG = 147 * MiB, WS_UCB = 180 * MiB, WS_U = 213 * MiB, WS_UC = 279 * MiB, WS_KB = 279 * MiB  , WS_VT = 312 * MiB  , WS_AA = 345 * MiB, WS_XIN = 411 * MiB,
                 WS_AO = 477 * MiB, WS_H = 213 * MiB  , WS_PART = 543 * MiB  , WS_END = 587 * MiB;
static_assert(WS_H + (size_t)M * FF * 2 <= WS_AO, "H overlay");
constexpr int LDS_BYTES = 147456;

namespace pg8 {
#define PG8_LAS __attribute__((address_space(3)))
typedef unsigned short bf16_t;
typedef short bf16x8 __attribute__((ext_vector_type(8)));
typedef float f32x4 __attribute__((ext_vector_type(4)));
typedef unsigned u32x4 __attribute__((ext_vector_type(4)));
typedef unsigned u32x2 __attribute__((ext_vector_type(2)));
constexpr int BM = 256, BK = 64, HALF = 128, HTB = HALF * BK * 2, STAGE_BYTES = 8 * HTB, NXCD = 8, WGM = 8;

__host__ __device__ __forceinline__ int lds_byte(int r, int c) { const int st = (r >> 4) * 2 + (c >> 5), rr = r & 15, cc = c & 31, ob = rr * 64 + cc * 2; return st * 1024 + (ob ^ (((ob >> 9) & 1) << 5)); }
__host__ __device__ __forceinline__ void stage_rc(int b, int& R, int& C) { const int st = b / 1024, sb = b % 1024, swz = sb ^ (((sb >> 9) & 1) << 5); R = (st >> 1) * 16 + swz / 64; C = (st & 1) * 32 + (swz % 64) / 2; }
__host__ __device__ __forceinline__ int perm32(int rho) { const int n = rho >> 4, i = rho & 15; return 8 * (i >> 2) + 4 * n + (i & 3); }

struct Unit { int pm, pn, kb, nk; };
struct Gemm { const bf16_t* A; const bf16_t* Bt; int M, N, K, lda, acs; };

__device__ __forceinline__ bool static_tile(int i, int nM, int nN, int G, int c, int& pm, int& pn) {
    const int nwg = nM * nN; const long Lx = (long)i * G + c; if (Lx >= nwg) return false;
    int wgid = (int)Lx; { const int q = nwg / NXCD, r = nwg % NXCD, xcd = wgid % NXCD, off = wgid / NXCD; wgid = (xcd < r ? xcd * (q + 1) : r * (q + 1) + (xcd - r) * q) + off; }
    const int nig = WGM * nN, gid = wgid / nig, fm = gid * WGM, gsz = (nM - fm) < WGM ? (nM - fm) : WGM;
    pm = fm + ((wgid % nig) % gsz); pn = (wgid % nig) / gsz; return true;
}
struct StaticOrder {
    static constexpr bool SPLIT = false;
    int nM, nN, G, c;
    __device__ __forceinline__ void init(int M_, int N_, int G_, int c_) { nM = M_ / BM; nN = N_ / BM; G = G_; c = c_; }
    __device__ __forceinline__ bool next(int i, Unit& u) const { u.kb = 0; u.nk = 0; return static_tile(i, nM, nN, G, c, u.pm, u.pn); }
};

struct G1Order {
    static constexpr bool SPLIT = false;
    int G, c;
    __device__ __forceinline__ void init(int G_, int c_) { G = G_; c = c_; }
    __device__ __forceinline__ bool next(int i, Unit& u) const { u.kb = 0; u.nk = 0; const int Lx = i * G + c; if (Lx >= 1280) return false;
        if (Lx < 1056) { static_tile(0, 132, 8, 0, Lx, u.pm, u.pn); return true; }
        const int idx = Lx - 1056; u.pm = idx >> 1; u.pn = 8 + (idx & 1); return true; }
};
struct G1Tail {
    static constexpr bool SPLIT = false;
    int G, c;
    __device__ __forceinline__ void init(int G_, int c_) { G = G_; c = c_; }
    __device__ __forceinline__ bool next(int i, Unit& u) const { u.kb = 0; u.nk = 0; const int idx = i * G + ((c + G - 16) % G); if (idx >= 40) return false;
        u.pm = 112 + (idx >> 1); u.pn = 8 + (idx & 1); return true; }
};

struct TailOrder {
    static constexpr bool SPLIT = true;
    int G, c, nm, nkfull;
    __device__ __forceinline__ void init(int K_, int G_, int c_) { G = G_; c = c_; nm = (c_ < 512) ? (512 - c_ + G_ - 1) / G_ : 0; nkfull = K_ / BK; }
    __device__ __forceinline__ bool next(int i, Unit& u) const {
        if (i < nm) { static_tile(i, 128, 4, G, c, u.pm, u.pn); u.kb = 0; u.nk = nkfull; return true; }
        const int t = (i - nm) * G + c; if (t >= 16 * 11) return false;
        const int tile = t / 11, ks = t - tile * 11; u.pm = 128 + (tile >> 2); u.pn = tile & 3; u.kb = ks * 4; u.nk = 4; return true;
    }
};

__device__ __forceinline__ unsigned cvt_pk_bf16(float lo, float hi) { unsigned r; asm volatile("v_cvt_pk_bf16_f32 %0, %1, %2" : "=v"(r) : "v"(lo), "v"(hi)); return r; }

template <class Epi, class Sched>
__device__ __forceinline__ void gemm_phase(PG8_LAS unsigned char* lds, const Gemm g, const Sched& S, const Epi& E) {
    int tid = threadIdx.x; asm volatile("" : "+v"(tid));
    const int wid = __builtin_amdgcn_readfirstlane(tid >> 6), lane = tid & 63, wr = wid >> 2, wc = wid & 3, fr = lane & 15, fq = lane >> 4;
    int K = g.K; asm volatile("" : "+s"(K));
    const int ntfull = K / BK;
    unsigned voffA[2], voffB[2];
#pragma unroll
    for (int i = 0; i < 2; ++i) { int R, C; stage_rc(tid * 16 + i * 8192, R, C); const int Rb = (R & ~31) + perm32(R & 31);
        voffA[i] = (unsigned)(R * g.lda + C) * 2u; voffB[i] = (unsigned)(Rb * K + C) * 2u; }
    const size_t kstep = (size_t)(BK * 2);
    const size_t hstepA = (size_t)HALF * g.lda * 2, hstepB = (size_t)HALF * K * 2;
    const unsigned ldsw = (unsigned)wid * 1024u;
    const int aoff = lds_byte(wr * 64 + fr, fq * 8), boff = lds_byte(wc * 32 + fr, fq * 8);
#define PG8_TA(u) ((const char*)g.A + ((size_t)(u).pm * BM * g.lda + (size_t)(u).pn * g.acs) * 2 + (Sched::SPLIT ? (size_t)(u).kb * (BK * 2) : 0))
#define PG8_TB(u) ((const char*)g.Bt + (size_t)(u).pn * BM * K * 2 + (Sched::SPLIT ? (size_t)(u).kb * (BK * 2) : 0))
#define PG8_SA(b, h) (((b) * 2 + (h)) * HTB)
#define PG8_SB(b, h) ((4 + (b) * 2 + (h)) * HTB)
#define PG8_STAGE(bufoff, gbase, voff) do { _Pragma("unroll") for (int _i = 0; _i < 2; ++_i) \
        __builtin_amdgcn_global_load_lds((const unsigned*)((const char*)(gbase) + (voff)[_i]), (PG8_LAS unsigned*)(lds + (bufoff) + ldsw + _i * 8192), 16, 0, 0); } while (0)
#define PG8_LDA(dst, b, h) do { _Pragma("unroll") for (int m = 0; m < 4; ++m) _Pragma("unroll") for (int k = 0; k < 2; ++k) dst[m][k] = *(const PG8_LAS bf16x8*)(lds + PG8_SA(b, h) + aoff + m * 2048 + k * 1024); } while (0)
#define PG8_LDB(dst, b, h) do { _Pragma("unroll") for (int n = 0; n < 2; ++n) _Pragma("unroll") for (int k = 0; k < 2; ++k) dst[n][k] = *(const PG8_LAS bf16x8*)(lds + PG8_SB(b, h) + boff + n * 2048 + k * 1024); } while (0)
#define PG8_MMA(ai, bj, At, Bt) do { __builtin_amdgcn_s_setprio(1); _Pragma("unroll") for (int m = 0; m < 4; ++m) _Pragma("unroll") for (int n = 0; n < 2; ++n) _Pragma("unroll") for (int k = 0; k < 2; ++k) \
        acc[ai][bj][m][n] = __builtin_amdgcn_mfma_f32_16x16x32_bf16(Bt[n][k], At[m][k], acc[ai][bj][m][n], 0, 0, 0); __builtin_amdgcn_s_setprio(0); } while (0)
#define PG8_WAIT_V(n) asm volatile("s_waitcnt vmcnt(" #n ")" ::: "memory")
#define PG8_WAIT_L(n) asm volatile("s_waitcnt lgkmcnt(" #n ")" ::: "memory")
#define PG8_BAR __builtin_amdgcn_s_barrier()
#define PG8_SCHED __builtin_amdgcn_sched_barrier(0)
    Unit cur, nxt; int ui = 0;
    if (!S.next(0, cur)) return;
    f32x4 acc[2][2][4][2];
    E.init(acc, cur, wr, wc, fr, fq);
    bf16x8 At[4][2], B0[2][2], B1[2][2];
    const char* cA = PG8_TA(cur); const char* cB = PG8_TB(cur);
    PG8_STAGE(PG8_SB(0, 0), cB, voffB); PG8_STAGE(PG8_SB(0, 1), cB + hstepB, voffB); PG8_STAGE(PG8_SA(0, 0), cA, voffA); PG8_STAGE(PG8_SA(0, 1), cA + hstepA, voffA);
    if (wr == 1) PG8_BAR;
    PG8_WAIT_V(2); PG8_BAR;
    PG8_STAGE(PG8_SB(1, 0), cB + kstep, voffB); PG8_STAGE(PG8_SA(1, 0), cA + kstep, voffA); PG8_STAGE(PG8_SB(1, 1), cB + hstepB + kstep, voffB);
    PG8_WAIT_V(6); PG8_BAR;
    for (;;) {
        const bool has_next = S.next(ui + 1, nxt);
        const char* nA = has_next ? PG8_TA(nxt) : cA; const char* nB = has_next ? PG8_TB(nxt) : cB;
        const int nt = Sched::SPLIT ? cur.nk : ntfull;
        for (int t = 0; t < nt; t += 2) {
            const bool last = (t == nt - 2);
            const char* a1 = cA + (size_t)(t + 1) * kstep;
            const char* a2 = last ? nA : cA + (size_t)(t + 2) * kstep; const char* b2 = last ? nB : cB + (size_t)(t + 2) * kstep;
            const char* a3 = a2 + kstep; const char* b3 = b2 + kstep;
            PG8_LDB(B0, 0, 0); PG8_LDB(B1, 0, 1); PG8_SCHED; PG8_LDA(At, 0, 0); PG8_STAGE(PG8_SA(1, 1), a1 + hstepA, voffA);
            PG8_WAIT_V(8); PG8_WAIT_L(0); PG8_BAR; PG8_MMA(0, 0, At, B0); PG8_MMA(0, 1, At, B1); PG8_BAR; PG8_SCHED;
            PG8_LDA(At, 0, 1); PG8_STAGE(PG8_SB(0, 0), b2, voffB); PG8_STAGE(PG8_SB(0, 1), b2 + hstepB, voffB); PG8_STAGE(PG8_SA(0, 0), a2, voffA);
            PG8_WAIT_V(8); PG8_WAIT_L(0); PG8_BAR; PG8_MMA(1, 0, At, B0); PG8_MMA(1, 1, At, B1); PG8_BAR; PG8_SCHED;
            PG8_LDB(B0, 1, 0); PG8_LDB(B1, 1, 1); PG8_SCHED; PG8_LDA(At, 1, 0); PG8_STAGE(PG8_SA(0, 1), a2 + hstepA, voffA);
            PG8_WAIT_V(8); PG8_WAIT_L(0); PG8_BAR; PG8_MMA(0, 0, At, B0); PG8_MMA(0, 1, At, B1); PG8_BAR; PG8_SCHED;
            PG8_LDA(At, 1, 1); PG8_STAGE(PG8_SB(1, 0), b3, voffB); PG8_STAGE(PG8_SB(1, 1), b3 + hstepB, voffB); PG8_STAGE(PG8_SA(1, 0), a3, voffA);
            PG8_WAIT_V(8); PG8_WAIT_L(0); PG8_BAR; PG8_MMA(1, 0, At, B0); PG8_MMA(1, 1, At, B1); PG8_BAR; PG8_SCHED;
        }
        if (wr == 0) PG8_BAR;
        E(acc, cur, wr, wc, fr, fq);
        if (!has_next) break;
        E.init(acc, nxt, wr, wc, fr, fq);
        cur = nxt; cA = nA; cB = nB; ++ui;
        if (wr == 1) PG8_BAR;
    }
    PG8_WAIT_V(0);
    PG8_BAR;
#undef PG8_TA
#undef PG8_TB
#undef PG8_SA
#undef PG8_SB
#undef PG8_STAGE
#undef PG8_LDA
#undef PG8_LDB
#undef PG8_MMA
#undef PG8_WAIT_V
#undef PG8_WAIT_L
#undef PG8_BAR
#undef PG8_SCHED
}
}

using pg8::bf16_t; using pg8::bf16x8; using pg8::f32x4; using pg8::u32x4; using pg8::u32x2; using pg8::Unit; using pg8::cvt_pk_bf16;
typedef float f32x16 __attribute__((ext_vector_type(16)));
#define LAS __attribute__((address_space(3)))

__device__ __forceinline__ float bf2f(bf16_t v) { return __uint_as_float((unsigned)v << 16); }
__device__ __forceinline__ float sigmoidf_(float x) { return 1.f / (1.f + __expf(-x)); }
__device__ __forceinline__ float gelu_tanh(float x) { const float y2 = 1.5957691216f * (x + 0.044715f * x * x * x); return x / (1.f + __expf(-y2)); }
__device__ __forceinline__ bf16x8 pack8(float a0, float a1, float a2, float a3, float a4, float a5, float a6, float a7) {
    u32x4 w; w.x = cvt_pk_bf16(a0, a1); w.y = cvt_pk_bf16(a2, a3); w.z = cvt_pk_bf16(a4, a5); w.w = cvt_pk_bf16(a6, a7); return __builtin_bit_cast(bf16x8, w); }

__device__ __forceinline__ f32x4 bf4lo(u32x4 r) { return (f32x4){__uint_as_float(r.x << 16), __uint_as_float(r.x & 0xffff0000u), __uint_as_float(r.y << 16), __uint_as_float(r.y & 0xffff0000u)}; }
__device__ __forceinline__ f32x4 bf4hi(u32x4 r) { return (f32x4){__uint_as_float(r.z << 16), __uint_as_float(r.z & 0xffff0000u), __uint_as_float(r.w << 16), __uint_as_float(r.w & 0xffff0000u)}; }
__device__ __forceinline__ f32x4 bf4(u32x2 r) { return (f32x4){__uint_as_float(r.x << 16), __uint_as_float(r.x & 0xffff0000u), __uint_as_float(r.y << 16), __uint_as_float(r.y & 0xffff0000u)}; }
__device__ __forceinline__ void acc_zero(f32x4 (&acc)[2][2][4][2]) {
#pragma unroll
    for (int a = 0; a < 2; ++a)
#pragma unroll
        for (int b = 0; b < 2; ++b)
#pragma unroll
            for (int m = 0; m < 4; ++m)
#pragma unroll
                for (int n = 0; n < 2; ++n) acc[a][b][m][n] = (f32x4){0.f, 0.f, 0.f, 0.f};
}
struct EpiG1 {
    bf16_t* QB; bf16_t* GG; bf16_t* U; float* out; bf16_t* KBp; bf16_t* VTp;
    __device__ __forceinline__ void init(f32x4 (&acc)[2][2][4][2], const Unit&, int, int, int, int) const { acc_zero(acc); }
    __device__ __forceinline__ void operator()(const f32x4 (&acc)[2][2][4][2], const Unit& u, int wr, int wc, int fr, int fq) const {
        const int region = u.pn >> 1; const int cb = (u.pn & 1) * 256 + wc * 32 + 8 * fq; const int row0 = u.pm * 256 + wr * 64 + fr;
        const bool samp = u.pm >= 128;
#pragma unroll
        for (int ai = 0; ai < 2; ++ai)
#pragma unroll
            for (int m = 0; m < 4; ++m) { const int row = row0 + ai * 128 + m * 16;
#pragma unroll
                for (int bj = 0; bj < 2; ++bj) { const int col = cb + bj * 128; const f32x4 v0 = acc[ai][bj][m][0], v1 = acc[ai][bj][m][1];
                    if (region == 0) { u32x4 w; const float qs = 0.125f * 1.44269504089f;     w.x = cvt_pk_bf16(v0[0] * qs, v0[1] * qs); w.y = cvt_pk_bf16(v0[2] * qs, v0[3] * qs); w.z = cvt_pk_bf16(v1[0] * qs, v1[1] * qs); w.w = cvt_pk_bf16(v1[2] * qs, v1[3] * qs);
                        *(u32x4*)(QB + (size_t)row * 512 + col) = w; }
                    else if (region == 1 || region == 2) {
                        float* o = out + (region == 1 ? (samp ? OFF_KS : OFF_KP) : (samp ? OFF_VS : OFF_VP)) + (size_t)(samp ? row - MP : row) * 512 + col;
                        if (samp) { *(f32x4*)o = v0; *(f32x4*)(o + 4) = v1; } else { __builtin_nontemporal_store(v0, (f32x4*)o); __builtin_nontemporal_store(v1, (f32x4*)(o + 4)); }
                        if (!samp) { const unsigned w0 = cvt_pk_bf16(v0[0], v0[1]), w1 = cvt_pk_bf16(v0[2], v0[3]), w2 = cvt_pk_bf16(v1[0], v1[1]), w3 = cvt_pk_bf16(v1[2], v1[3]);
                            const int bh = (row >> 12) * 8 + (col >> 6), pos = row & 4095, d0 = col & 63;
                            if (region == 1) { u32x4 w; w.x = w0; w.y = w1; w.z = w2; w.w = w3; *(u32x4*)(KBp + ((size_t)((bh * 128 + (pos >> 5)) * 4 + (d0 >> 4)) * 512 + (pos & 31) * 16 + (d0 & 15))) = w; }
                            else { bf16_t* vt = VTp + ((size_t)(bh * 1024 + (pos >> 2)) * 64 + d0) * 4 + (pos & 3);
                                vt[0] = (bf16_t)(w0 & 0xffffu); vt[4] = (bf16_t)(w0 >> 16); vt[8] = (bf16_t)(w1 & 0xffffu); vt[12] = (bf16_t)(w1 >> 16);
                                vt[16] = (bf16_t)(w2 & 0xffffu); vt[20] = (bf16_t)(w2 >> 16); vt[24] = (bf16_t)(w3 & 0xffffu); vt[28] = (bf16_t)(w3 >> 16); } } }
                    else if (region == 3) { u32x4 w; w.x = cvt_pk_bf16(v0[0], v0[1]); w.y = cvt_pk_bf16(v0[2], v0[3]); w.z = cvt_pk_bf16(v1[0], v1[1]); w.w = cvt_pk_bf16(v1[2], v1[3]); *(u32x4*)(U + (size_t)row * 512 + col) = w; }
                    else { u32x4 w; w.x = cvt_pk_bf16(gelu_tanh(v0[0]), gelu_tanh(v0[1])); w.y = cvt_pk_bf16(gelu_tanh(v0[2]), gelu_tanh(v0[3])); w.z = cvt_pk_bf16(gelu_tanh(v1[0]), gelu_tanh(v1[1])); w.w = cvt_pk_bf16(gelu_tanh(v1[2]), gelu_tanh(v1[3]));
                        *(u32x4*)(GG + (size_t)row * 512 + col) = w; }
                } asm volatile("" ::: "memory"); }
    }
};
struct EpiGate {
    const float *rgb, *igb, *lam; const bf16_t* UCBp; unsigned* AX;
    __device__ __forceinline__ void init(f32x4 (&acc)[2][2][4][2], const Unit&, int, int, int, int) const { acc_zero(acc); }
    __device__ __forceinline__ void operator()(const f32x4 (&acc)[2][2][4][2], const Unit& u, int wr, int wc, int fr, int fq) const {
        const int row0 = u.pm * 256 + wr * 64 + fr; const int cb = u.pn * 128 + wc * 32 + 8 * fq;
        const f32x4 sp0 = *(const f32x4*)(lam + cb), sp1 = *(const f32x4*)(lam + cb + 4), rb0 = *(const f32x4*)(rgb + cb), rb1 = *(const f32x4*)(rgb + cb + 4), ib0 = *(const f32x4*)(igb + cb), ib1 = *(const f32x4*)(igb + cb + 4);
#pragma unroll
        for (int ai = 0; ai < 2; ++ai) {
            f32x4 ucv[4][2];
#pragma unroll
            for (int m = 0; m < 4; ++m) { const u32x4 raw = *(const u32x4*)(UCBp + (size_t)(row0 + ai * 128 + m * 16) * 512 + cb); ucv[m][0] = bf4lo(raw); ucv[m][1] = bf4hi(raw); }
#pragma unroll
            for (int m = 0; m < 4; ++m)
#pragma unroll
                for (int n = 0; n < 2; ++n) { const size_t off = (size_t)(row0 + ai * 128 + m * 16) * 512 + cb + 4 * n;
                    const f32x4 uv = ucv[m][n], sp = n ? sp1 : sp0, rb = n ? rb1 : rb0, ib = n ? ib1 : ib0; u32x4 pk;
#pragma unroll
                    for (int j = 0; j < 4; ++j) { const float r = sigmoidf_(acc[ai][0][m][n][j] + rb[j]), ig = sigmoidf_(acc[ai][1][m][n][j] + ib[j]);
                        const float la = sp[j] * r; const float ae = __expf(la); const float om = 1.f - ae; pk[j] = cvt_pk_bf16(om, sqrtf(om * (1.f + ae)) * ig * uv[j]); }
                    *(u32x4*)(AX + off) = pk; }
            asm volatile("" ::: "memory"); }
    }
};
template <bool FROMX, bool TAIL = false> struct EpiRes {
    const float* xP; const float* xS; bf16_t* XB; float* ssq; float* part;
    __device__ __forceinline__ void init(f32x4 (&acc)[2][2][4][2], const Unit& u, int wr, int wc, int fr, int fq) const {
        const bool samp = u.pm >= 128;
        if (TAIL && samp) { acc_zero(acc); return; }
        const int cb = u.pn * 256 + wc * 32 + 8 * fq; const int row0 = u.pm * 256 + wr * 64 + fr;
        if (FROMX) { const float* rbase = (samp ? xS : xP) + (size_t)(row0 - (samp ? MP : 0)) * D + cb;
#pragma unroll
            for (int ai = 0; ai < 2; ++ai)
#pragma unroll
                for (int m = 0; m < 4; ++m)
#pragma unroll
                    for (int bj = 0; bj < 2; ++bj) { const float* rp = rbase + (size_t)(ai * 128 + m * 16) * D + bj * 128; acc[ai][bj][m][0] = *(const f32x4*)rp; acc[ai][bj][m][1] = *(const f32x4*)(rp + 4); } }
        else { const bf16_t* rbase = XB + (size_t)row0 * D + cb;
#pragma unroll
            for (int ai = 0; ai < 2; ++ai)
#pragma unroll
                for (int m = 0; m < 4; ++m)
#pragma unroll
                    for (int bj = 0; bj < 2; ++bj) { const u32x4 raw = *(const u32x4*)(rbase + (size_t)(ai * 128 + m * 16) * D + bj * 128); acc[ai][bj][m][0] = bf4lo(raw); acc[ai][bj][m][1] = bf4hi(raw); } }
    }
    __device__ __forceinline__ void operator()(const f32x4 (&acc)[2][2][4][2], const Unit& u, int wr, int wc, int fr, int fq) const {
        const int cb = u.pn * 256 + wc * 32 + 8 * fq; const int row0 = u.pm * 256 + wr * 64 + fr; const bool samp = u.pm >= 128;
        if (TAIL && samp) {
#pragma unroll
            for (int ai = 0; ai < 2; ++ai)
#pragma unroll
                for (int m = 0; m < 4; ++m) { const int row = row0 + ai * 128 + m * 16;
#pragma unroll
                    for (int bj = 0; bj < 2; ++bj) { float* xo = part + ((size_t)(u.kb >> 2) * MS + (row - MP)) * D + cb + bj * 128;
                        *(f32x4*)xo = acc[ai][bj][m][0]; *(f32x4*)(xo + 4) = acc[ai][bj][m][1]; } }
            return;
        }
#pragma unroll
        for (int ai = 0; ai < 2; ++ai)
#pragma unroll
            for (int m = 0; m < 4; ++m) { const int row = row0 + ai * 128 + m * 16; float s = 0.f;
#pragma unroll
                for (int bj = 0; bj < 2; ++bj) { const int col = cb + bj * 128; const f32x4 v0 = acc[ai][bj][m][0], v1 = acc[ai][bj][m][1];
                    u32x4 w; w.x = cvt_pk_bf16(v0[0], v0[1]); w.y = cvt_pk_bf16(v0[2], v0[3]); w.z = cvt_pk_bf16(v1[0], v1[1]); w.w = cvt_pk_bf16(v1[2], v1[3]); *(u32x4*)(XB + (size_t)row * D + col) = w;
                    s += (v0[0] * v0[0] + v0[1] * v0[1]) + (v0[2] * v0[2] + v0[3] * v0[3]) + (v1[0] * v1[0] + v1[1] * v1[1]) + (v1[2] * v1[2] + v1[3] * v1[3]); }
                s += __shfl_xor(s, 16); s += __shfl_xor(s, 32);
                if (fq == 0) atomicAdd(ssq + row, s); }
    }
};
struct EpiSwiglu {
    const float* ssq; bf16_t* H;
    __device__ __forceinline__ void init(f32x4 (&acc)[2][2][4][2], const Unit&, int, int, int, int) const { acc_zero(acc); }
    __device__ __forceinline__ void operator()(const f32x4 (&acc)[2][2][4][2], const Unit& u, int wr, int wc, int fr, int fq) const {
        const int col = u.pn * 128 + wc * 32 + 8 * fq; const int row0 = u.pm * 256 + wr * 64 + fr;
        float rsv[8];
#pragma unroll
        for (int i = 0; i < 8; ++i) rsv[i] = ssq[row0 + (i >> 2) * 128 + (i & 3) * 16];
#pragma unroll
        for (int ai = 0; ai < 2; ++ai)
#pragma unroll
            for (int m = 0; m < 4; ++m) { const int row = row0 + ai * 128 + m * 16; const float rs = rsqrtf(rsv[ai * 4 + m] * (1.f / D) + EPS); float h[8];
#pragma unroll
                for (int j = 0; j < 8; ++j) { const float gv = acc[ai][0][m][j >> 2][j & 3] * rs, uv = acc[ai][1][m][j >> 2][j & 3] * rs; h[j] = gv / (1.f + __expf(-gv)) * uv; }
                u32x4 w; w.x = cvt_pk_bf16(h[0], h[1]); w.y = cvt_pk_bf16(h[2], h[3]); w.z = cvt_pk_bf16(h[4], h[5]); w.w = cvt_pk_bf16(h[6], h[7]);
                *(u32x4*)(H + (size_t)row * FF + col) = w; }
    }
};

struct Args { const float* in[24]; float* out; unsigned char* ws; };
enum { I_XP = 0, I_XS, I_CK, I_CV, I_LH, I_LC, I_SP, I_WIN, I_CW, I_CB, I_RGW, I_RGB, I_IGW, I_IGB, I_LAM, I_WOUT, I_PW, I_PS, I_NM, I_NF, I_FG, I_FU, I_FD, I_NFIN };

__device__ __forceinline__ void transpose_tile(const float* W, int ldw, int srccol0, int k0, const float* gamma, bf16_t* WT, int ldwt, int dstrow0, LAS float* scr, int lane, const float* nscale = nullptr) {
    const float ns = nscale ? nscale[dstrow0 + (lane & 31)] : 1.f;
#pragma unroll
    for (int i = 0; i < 32; ++i) { const int kk = 2 * i + (lane >> 5); float v = W[(size_t)(k0 + kk) * ldw + srccol0 + (lane & 31)]; if (gamma) v *= gamma[k0 + kk]; scr[kk * 33 + (lane & 31)] = v * ns; }
    asm volatile("s_waitcnt lgkmcnt(0)" ::: "memory");
    const int c = lane & 7;
#pragma unroll
    for (int j = 0; j < 4; ++j) { const int n = (lane >> 3) + 8 * j; const LAS float* s = scr + (8 * c) * 33 + n;
        u32x4 o; o.x = cvt_pk_bf16(s[0 * 33], s[1 * 33]); o.y = cvt_pk_bf16(s[2 * 33], s[3 * 33]); o.z = cvt_pk_bf16(s[4 * 33], s[5 * 33]); o.w = cvt_pk_bf16(s[6 * 33], s[7 * 33]);
        *(u32x4*)(WT + (size_t)(dstrow0 + n) * ldwt + k0 + 8 * c) = o; }
    asm volatile("s_waitcnt lgkmcnt(0)" ::: "memory");
}
__device__ __forceinline__ float wave_sum(float v) {
#pragma unroll
    for (int o = 1; o < 64; o <<= 1) v += __shfl_xor(v, o);
    return v;
}
__device__ __forceinline__ int crow(int r, int hi) { return (r & 3) + 8 * (r >> 2) + 4 * hi; }

template <bool PR>
__device__ __forceinline__ void attn_unit(const Args& a, const bf16_t* QB, bf16_t* AO, const bf16_t* KBp, const bf16_t* VTp, int qt, int h, int lane) {
    const int r32 = lane & 31, hi = lane >> 5;
    const float *Kd, *Vd, *Kc, *Vc; int nprev; size_t qrow0;
    if (qt < 1024) { const int b = qt >> 7, tq = qt & 127; qrow0 = (size_t)qt * 32;
        Kc = a.out + OFF_KP + (size_t)b * 4096 * 512 + h * 64; Vc = a.out + OFF_VP + (size_t)b * 4096 * 512 + h * 64;
        Kd = Kc + (size_t)tq * 32 * 512; Vd = Vc + (size_t)tq * 32 * 512; nprev = tq; }
    else { const int bs = qt - 1024; qrow0 = (size_t)MP + (size_t)bs * 32;
        Kd = a.out + OFF_KS + (size_t)bs * 32 * 512 + h * 64; Vd = a.out + OFF_VS + (size_t)bs * 32 * 512 + h * 64;
        Kc = a.in[I_CK] + (size_t)bs * 4096 * 512 + h * 64; Vc = a.in[I_CV] + (size_t)bs * 4096 * 512 + h * 64; nprev = 128; }
    bf16x8 qf[4];
    { const bf16_t* Qp = QB + (qrow0 + r32) * 512 + h * 64 + hi * 8;
#pragma unroll
      for (int kk = 0; kk < 4; ++kk) qf[kk] = *(const bf16x8*)(Qp + kk * 16); }
    f32x16 o0, o1;
#pragma unroll
    for (int r = 0; r < 16; ++r) { o0[r] = 0.f; o1[r] = 0.f; }
    float Cm = 1.f; int Ce = 0;
    constexpr int DP = PR ? 3 : 1;
    f32x4 kr[8]; float vr[32];
    bf16x8 krb[DP][4]; u32x2 vrb[DP][8];
    const bf16_t* Kbb = KBp + (size_t)(((qt >> 7) * 8 + h) * 128) * 2048 + r32 * 16 + hi * 8;
    const bf16_t* Vtb = VTp + ((size_t)(((qt >> 7) * 8 + h) * 1024 + hi) * 64 + r32) * 4;
#define ATT_LOAD(Kt_, Vt_) do { const float* kp_ = (Kt_) + (size_t)r32 * 512 + hi * 8; \
        _Pragma("unroll") for (int kk = 0; kk < 4; ++kk) { kr[2 * kk] = *(const f32x4*)(kp_ + kk * 16); kr[2 * kk + 1] = *(const f32x4*)(kp_ + kk * 16 + 4); } \
        const float* vp_ = (Vt_) + (size_t)(4 * hi) * 512 + r32; \
        _Pragma("unroll") for (int sI = 0; sI < 2; ++sI) _Pragma("unroll") for (int dh = 0; dh < 2; ++dh) _Pragma("unroll") for (int i = 0; i < 8; ++i) \
            vr[(sI * 2 + dh) * 8 + i] = vp_[(size_t)(16 * sI + (i & 3) + 8 * (i >> 2)) * 512 + dh * 32]; } while (0)
#define ATT_LOADB(J_, key0_) do { const bf16_t* kp_ = Kbb + (size_t)((key0_) >> 5) * 2048; \
        _Pragma("unroll") for (int kk = 0; kk < 4; ++kk) krb[J_][kk] = *(const bf16x8*)(kp_ + kk * 512); \
        _Pragma("unroll") for (int sI = 0; sI < 2; ++sI) _Pragma("unroll") for (int dh = 0; dh < 2; ++dh) { const bf16_t* vp_ = Vtb + ((size_t)(((key0_) >> 2) + 4 * sI) * 64 + 32 * dh) * 4; \
            vrb[J_][(sI * 2 + dh) * 2] = *(const u32x2*)vp_; vrb[J_][(sI * 2 + dh) * 2 + 1] = *(const u32x2*)(vp_ + 2 * 64 * 4); } } while (0)
    if (PR) {
#pragma unroll
        for (int j = 0; j < DP; ++j) if (j <= nprev) ATT_LOADB(j, (nprev - j) * 32);
    } else ATT_LOAD(Kd, Vd);
    bool done = false;
    for (int it0 = 0; it0 <= nprev && !done; it0 += DP) {
#pragma unroll
      for (int j = 0; j < DP; ++j) { const int it = it0 + j; if (it > nprev) { done = true; break; }
        bf16x8 kf[4], vb[4];
        if (PR) {
#pragma unroll
            for (int kk = 0; kk < 4; ++kk) kf[kk] = krb[j][kk];
#pragma unroll
            for (int q = 0; q < 4; ++q) { u32x4 w; w.x = vrb[j][2 * q].x; w.y = vrb[j][2 * q].y; w.z = vrb[j][2 * q + 1].x; w.w = vrb[j][2 * q + 1].y; vb[q] = __builtin_bit_cast(bf16x8, w); }
            if (it + DP <= nprev) ATT_LOADB(j, (nprev - it - DP) * 32);
        } else {
#pragma unroll
            for (int kk = 0; kk < 4; ++kk) kf[kk] = pack8(kr[2 * kk][0], kr[2 * kk][1], kr[2 * kk][2], kr[2 * kk][3], kr[2 * kk + 1][0], kr[2 * kk + 1][1], kr[2 * kk + 1][2], kr[2 * kk + 1][3]);
#pragma unroll
            for (int q = 0; q < 4; ++q) vb[q] = pack8(vr[q * 8 + 0], vr[q * 8 + 1], vr[q * 8 + 2], vr[q * 8 + 3], vr[q * 8 + 4], vr[q * 8 + 5], vr[q * 8 + 6], vr[q * 8 + 7]);
            if (it < nprev) { const size_t toff = (size_t)(nprev - it - 1) * 32 * 512; ATT_LOAD(Kc + toff, Vc + toff); }
        }
        f32x16 s;
#pragma unroll
        for (int r = 0; r < 16; ++r) s[r] = 0.f;
#pragma unroll
        for (int kk = 0; kk < 4; ++kk) s = __builtin_amdgcn_mfma_f32_32x32x16_bf16(kf[kk], qf[kk], s, 0, 0, 0);
        float sg[16], om[16];
#pragma unroll
        for (int r = 0; r < 16; ++r) { const float z2 = s[r]; const float e = __builtin_amdgcn_exp2f(-fabsf(z2)); const float rc = __builtin_amdgcn_rcpf(1.f + e); const float t = e * rc;
            const bool pos = z2 >= 0.f; const bool valid = (it != 0) || (crow(r, hi) < r32);
            sg[r] = valid ? (pos ? rc : t) : 0.f; om[r] = valid ? (pos ? t : rc) : 1.f; }
        const float G0 = (om[0] * om[1]) * (om[2] * om[3]), G1 = (om[4] * om[5]) * (om[6] * om[7]), G2 = (om[8] * om[9]) * (om[10] * om[11]), G3 = (om[12] * om[13]) * (om[14] * om[15]);
        const float P0 = __shfl_xor(G0, 32), P1 = __shfl_xor(G1, 32), P2 = __shfl_xor(G2, 32), P3 = __shfl_xor(G3, 32);
        const float t3 = G3 * P3, t2 = G2 * P2, t1 = G1 * P1, t0 = G0 * P0;
        const float Cs = ldexpf(Cm, Ce);
        float base[4];
        base[3] = Cs * (hi ? 1.f : P3); base[2] = Cs * t3 * (hi ? 1.f : P2); base[1] = Cs * (t3 * t2) * (hi ? 1.f : P1); base[0] = Cs * ((t3 * t2) * t1) * (hi ? 1.f : P0);
        float w[16];
#pragma unroll
        for (int g = 0; g < 4; ++g) { float bt = base[g];
#pragma unroll
            for (int rr = 3; rr >= 0; --rr) { const int r = 4 * g + rr; w[r] = sg[r] * bt; bt *= om[r]; } }
        { const float nc = Cm * ((t0 * t1) * (t2 * t3)); Cm = __builtin_amdgcn_frexp_mantf(nc); Ce += __builtin_amdgcn_frexp_expf(nc); }
        const bf16x8 wa0 = pack8(w[0], w[1], w[2], w[3], w[4], w[5], w[6], w[7]), wa1 = pack8(w[8], w[9], w[10], w[11], w[12], w[13], w[14], w[15]);
        o0 = __builtin_amdgcn_mfma_f32_32x32x16_bf16(wa0, vb[0], o0, 0, 0, 0); o0 = __builtin_amdgcn_mfma_f32_32x32x16_bf16(wa1, vb[2], o0, 0, 0, 0);
        o1 = __builtin_amdgcn_mfma_f32_32x32x16_bf16(wa0, vb[1], o1, 0, 0, 0); o1 = __builtin_amdgcn_mfma_f32_32x32x16_bf16(wa1, vb[3], o1, 0, 0, 0);
        if (__all(Cm == 0.f || Ce < -150)) { done = true; break; }
      }
    }
#undef ATT_LOAD
#undef ATT_LOADB
    bf16_t* op = AO + qrow0 * D + h * 64 + r32;
#pragma unroll
    for (int r = 0; r < 16; ++r) { const size_t ro = (size_t)crow(r, hi) * D; op[ro] = (bf16_t)(cvt_pk_bf16(o0[r], 0.f) & 0xffffu); op[ro + 32] = (bf16_t)(cvt_pk_bf16(o1[r], 0.f) & 0xffffu); }
}


constexpr int PR = 8;
template <int W, bool SAMP>
__device__ __forceinline__ void pool_strip(const bf16_t* XRp, bf16_t* XBp, float* pout, const float* ssq2, const LAS float* ldsrs, const float* pbuf, const float* gm,
                                           int row0, int pos0, int seq, int Tseq, int c4) {
    const f32x4 gv = *(const f32x4*)(gm + c4);
    f32x4 xn[PR + W - 1];
#pragma unroll
    for (int j = 0; j < PR + W - 1; ++j) { const int p = pos0 - (W - 1) + j, rr = row0 - (W - 1) + j;
        if (p >= 0) { const float rs = SAMP ? ldsrs[p] : rsqrtf(ssq2[rr] * (1.f / D) + EPS); xn[j] = bf4(*(const u32x2*)(XRp + (size_t)rr * D + c4)) * rs * gv; }
        else if (SAMP) xn[j] = *(const f32x4*)(pbuf + ((size_t)seq * 15 + (15 + p)) * D + c4);
        else xn[j] = (f32x4){0.f, 0.f, 0.f, 0.f}; }
    f32x4 Sw = (f32x4){0.f, 0.f, 0.f, 0.f};
#pragma unroll
    for (int j = 0; j < W - 1; ++j) Sw = Sw + xn[j];
#pragma unroll
    for (int t = 0; t < PR; ++t) { const int pos = pos0 + t; const f32x4 x = xn[t + W - 1]; Sw = Sw + x;
        const float cnt = SAMP ? (float)W : (float)((pos + 1 < W) ? pos + 1 : W); const f32x4 dv = Sw * (1.f / cnt) - x;
        u32x2 wv; wv.x = cvt_pk_bf16(dv[0], dv[1]); wv.y = cvt_pk_bf16(dv[2], dv[3]); *(u32x2*)(XBp + (size_t)(row0 + t) * D + c4) = wv;
        if (pos >= Tseq - 15) *(f32x4*)(pout + ((size_t)seq * 15 + (pos - (Tseq - 15))) * D + c4) = x;
        Sw = Sw - xn[t]; }
}

#define XB_TMO      128
#define XB_XCNT(j)  (256  + 64 * (j))
#define XB_XSUB(j)  (1280 + 64 * (j))
#define XB_XGEN(j)  (2304 + 64 * (j))
#define XB_TOP      3328
#define XB_TOPGEN   3392
#define XCD_BAR_WORDS 3456
#define XB_SPIN_CAP (1u << 18)

__device__ __forceinline__ unsigned xb_ld(unsigned* p)              { return __hip_atomic_load(p, __ATOMIC_RELAXED, __HIP_MEMORY_SCOPE_AGENT); }
__device__ __forceinline__ unsigned xb_add(unsigned* p, unsigned v) { return __hip_atomic_fetch_add(p, v, __ATOMIC_RELAXED, __HIP_MEMORY_SCOPE_AGENT); }
__device__ __forceinline__ unsigned xb_xcc_id() { return (unsigned)__builtin_amdgcn_s_getreg((3 << 11) | 20) & 0xFu; }
#define XB_SPIN(cond, bar) do { unsigned _sp = 0; while (cond) { __builtin_amdgcn_s_sleep(1); \
    if ((++_sp & 255u) == 0u) { if (xb_ld(&(bar)[XB_TMO])) break; if (_sp > XB_SPIN_CAP) { atomicAdd(&(bar)[XB_TMO], 1u); break; } } } } while (0)

struct XcdBarrier {
    unsigned* bar; unsigned x;
    volatile LAS unsigned* st;
};

__device__ __forceinline__ XcdBarrier xcd_barrier_post(unsigned* bar, volatile LAS unsigned* st) {
    XcdBarrier b; b.bar = bar; b.x = xb_xcc_id(); b.st = st;
    if (threadIdx.x == 0) (void)xb_add(&bar[XB_XCNT(b.x)], 1u);
    return b;
}
__device__ __forceinline__ void xcd_barrier_complete(unsigned* bar, unsigned x, unsigned& nloc, unsigned& nx) {
    const unsigned G = gridDim.x * gridDim.y * gridDim.z;
    unsigned sum, cnt, mine, sp = 0u;
    for (;;) {
        sum = 0u; cnt = 0u; mine = 0u;
#pragma unroll
        for (unsigned j = 0; j < 16; ++j) { const unsigned c = xb_ld(&bar[XB_XCNT(j)]); sum += c; cnt += (c > 0u) ? 1u : 0u; mine = (j == x) ? c : mine; }
        if (sum == G) break;
        __builtin_amdgcn_s_sleep(1);
        if ((++sp & 255u) == 0u) { if (xb_ld(&bar[XB_TMO])) break; if (sp > XB_SPIN_CAP) { atomicAdd(&bar[XB_TMO], 1u); break; } }
    }
    nloc = mine > 0u ? mine : 1u; nx = cnt > 0u ? cnt : 1u;
}

__device__ __forceinline__ void xcd_barrier(const XcdBarrier& b) {
    asm volatile("s_waitcnt vmcnt(0)" ::: "memory");
    __syncthreads();
    if (threadIdx.x == 0) {
        unsigned* bar = b.bar;
        __builtin_amdgcn_s_waitcnt(0);
        unsigned nloc = b.st[0], nx = b.st[1];
        if (nloc == 0u) { xcd_barrier_complete(bar, b.x, nloc, nx); b.st[0] = nloc; b.st[1] = nx; }
        const unsigned old = xb_add(&bar[XB_XSUB(b.x)], 1u);
        const unsigned gen = old / nloc;
        if (old + 1u == (gen + 1u) * nloc) {
            __builtin_amdgcn_fence(__ATOMIC_RELEASE, "agent");
            asm volatile("s_waitcnt vmcnt(0)" ::: "memory");
            const unsigned og = xb_add(&bar[XB_TOP], 1u);
            const unsigned tg = og / nx;
            if (og + 1u == (tg + 1u) * nx) xb_add(&bar[XB_TOPGEN], 1u);
            else XB_SPIN(xb_ld(&bar[XB_TOPGEN]) == tg, bar);
            __builtin_amdgcn_fence(__ATOMIC_ACQUIRE, "agent");
            xb_add(&bar[XB_XGEN(b.x)], 1u);
            asm volatile("s_waitcnt vmcnt(0)" ::: "memory");
        } else {
            XB_SPIN(xb_ld(&bar[XB_XGEN(b.x)]) == gen, bar);
            __builtin_amdgcn_fence(__ATOMIC_ACQUIRE, "agent");
            asm volatile("s_waitcnt vmcnt(0)" ::: "memory");
        }
    }
    __syncthreads();
}


#ifndef SKIPMASK
#define SKIPMASK 0
#endif
#define PH(n) if (!((SKIPMASK >> (n)) & 1))
__global__ void __launch_bounds__(512, 2) fwd_kernel(Args a) {
    extern __shared__ __attribute__((aligned(16))) unsigned char lds[];
    cg::grid_group grid = cg::this_grid();
    PG8_LAS unsigned char* L = (PG8_LAS unsigned char*)lds;
    const int tid = threadIdx.x, lane = tid & 63, wave = __builtin_amdgcn_readfirstlane(tid >> 6);
    const int G = gridDim.x, bx = blockIdx.x;
    const int gw = bx * 8 + wave, NGW = G * 8; const int gt = bx * 512 + tid, NGT = G * 512;
    float* const out = a.out;
    volatile LAS unsigned* bst = (volatile LAS unsigned*)(L + 131072 + 64);
    if (tid < 4) bst[tid] = 0u;
    __syncthreads();
    const XcdBarrier xbar = xcd_barrier_post((unsigned*)(a.ws + WS_BAR), bst);
#define ws (a.ws)
#define SSQ ((float*)(ws + WS_SSQ))
#define SUMA ((float*)(ws + WS_SUM))
#define SUMH (SUMA + 512 * 512)
#define SPL ((float*)(ws + WS_SPL))
#define WIN ((bf16_t*)(ws + WS_WIN))
#define WG ((bf16_t*)(ws + WS_WG))
#define WOUT ((bf16_t*)(ws + WS_WOUT))
#define WGU ((bf16_t*)(ws + WS_WGU))
#define WD ((bf16_t*)(ws + WS_WD))
#define WP ((bf16_t*)(ws + WS_WP))
#define XB ((bf16_t*)(ws + WS_XB))
#define QB ((bf16_t*)(ws + WS_QB))
#define GG ((bf16_t*)(ws + WS_GG))
#define UCB ((bf16_t*)(ws + WS_UCB))
#define KB ((bf16_t*)(ws + WS_KB))
#define VT ((bf16_t*)(ws + WS_VT))
#define U ((bf16_t*)(ws + WS_U))
#define AX ((unsigned*)(ws + WS_AA))
#define AO ((bf16_t*)(ws + WS_AO))
#define H ((bf16_t*)(ws + WS_H))
#define PART ((float*)(ws + WS_PART))

    PH(0)
    {
        for (int i = gt; i < 4 * M; i += NGT) SSQ[i] = 0.f;
        if (gt < 512) SPL[gt] = -8.f * log1pf(expf(-a.in[I_LAM][gt]));
        LAS float* scr = (LAS float*)(L + wave * 16384);
        constexpr int IT_WIN = 16 * 80, IT_WOUT = 16 * 32, IT_WGU = 16 * 176, IT_WD = 44 * 32, IT_WP = 4 * 8;
        constexpr int NITEMS = IT_WIN + IT_WOUT + 2 * IT_WGU + 2 * IT_WD + 4 * IT_WP;
        for (int it = gw; it < NITEMS; it += NGW) {
            int r = it;
            if (r >= IT_WIN + IT_WOUT) break;
            if (r < IT_WIN) { const int kb = r / 80, nb = r % 80; transpose_tile(a.in[I_WIN], NIN, nb * 32, kb * 64, a.in[I_NM], WIN, D, nb * 32, scr, lane); continue; } r -= IT_WIN;
            if (r < IT_WOUT) { const int kb = r / 32, nb = r % 32; transpose_tile(a.in[I_WOUT], D, nb * 32, kb * 64, nullptr, WOUT, D, nb * 32, scr, lane); continue; } r -= IT_WOUT;
            if (r < 2 * IT_WGU) { const int l = r / IT_WGU; r -= l * IT_WGU; const int kb = r / 176, nb = r % 176; const int n0 = nb * 32;
                const float* src = ((n0 & 128) ? a.in[I_FU] : a.in[I_FG]) + (size_t)l * D * FF; const int sc0 = (n0 >> 8) * 128 + (n0 & 127);
                transpose_tile(src, FF, sc0, kb * 64, a.in[I_NF] + l * D, WGU + (size_t)l * NGU * D, D, n0, scr, lane); continue; } r -= 2 * IT_WGU;
            if (r < 2 * IT_WD) { const int l = r / IT_WD; r -= l * IT_WD; const int kb = r / 32, nb = r % 32;
                transpose_tile(a.in[I_FD] + (size_t)l * FF * D, D, nb * 32, kb * 64, nullptr, WD + (size_t)l * D * FF, FF, nb * 32, scr, lane); continue; } r -= 2 * IT_WD;
            { const int g = r / IT_WP; r -= g * IT_WP; const int kb = r / 8, nb = r % 8;
                transpose_tile(a.in[I_PW] + (size_t)g * 256 * 256, 256, nb * 32, kb * 64, nullptr, WP, 256, g * 256 + nb * 32, scr, lane, a.in[I_PS]); }
        }
        for (int i = gt; i < 1024 * 128; i += NGT) { const int np = i >> 7, kk = i & 127; const int pn = np >> 8, bj = (np >> 7) & 1, j = np & 127; const int c = 128 * pn + j, cin = 128 * pn + kk;
            float v = 0.f; if ((cin >> 6) == (c >> 6)) v = (bj ? a.in[I_IGW] : a.in[I_RGW])[(size_t)(c >> 6) * 4096 + (cin & 63) * 64 + (c & 63)];
            WG[i] = (bf16_t)(cvt_pk_bf16(v, 0.f) & 0xffffu); }
        for (int m0 = gw; m0 < M; m0 += 2 * NGW) { const int m1 = m0 + NGW; const bool has1 = m1 < M;
            const float* xr0 = (m0 < MP) ? a.in[I_XP] + (size_t)m0 * D : a.in[I_XS] + (size_t)(m0 - MP) * D;
            const float* xr1 = has1 ? ((m1 < MP) ? a.in[I_XP] + (size_t)m1 * D : a.in[I_XS] + (size_t)(m1 - MP) * D) : xr0;
            f32x4 v0[4], v1[4]; float s0 = 0.f, s1 = 0.f;
#pragma unroll
            for (int j = 0; j < 4; ++j) { v0[j] = __builtin_nontemporal_load((const f32x4*)xr0 + lane + 64 * j); v1[j] = __builtin_nontemporal_load((const f32x4*)xr1 + lane + 64 * j); }
#pragma unroll
            for (int j = 0; j < 4; ++j) { s0 += (v0[j][0] * v0[j][0] + v0[j][1] * v0[j][1]) + (v0[j][2] * v0[j][2] + v0[j][3] * v0[j][3]); s1 += (v1[j][0] * v1[j][0] + v1[j][1] * v1[j][1]) + (v1[j][2] * v1[j][2] + v1[j][3] * v1[j][3]); }
            const float rs0 = rsqrtf(wave_sum(s0) * (1.f / D) + EPS), rs1 = rsqrtf(wave_sum(s1) * (1.f / D) + EPS);
#pragma unroll
            for (int j = 0; j < 4; ++j) { u32x2 w; w.x = cvt_pk_bf16(v0[j][0] * rs0, v0[j][1] * rs0); w.y = cvt_pk_bf16(v0[j][2] * rs0, v0[j][3] * rs0); ((u32x2*)(XB + (size_t)m0 * D))[lane + 64 * j] = w; }
            if (has1) {
#pragma unroll
                for (int j = 0; j < 4; ++j) { u32x2 w; w.x = cvt_pk_bf16(v1[j][0] * rs1, v1[j][1] * rs1); w.y = cvt_pk_bf16(v1[j][2] * rs1, v1[j][3] * rs1); ((u32x2*)(XB + (size_t)m1 * D))[lane + 64 * j] = w; } } }
    }
    xcd_barrier(xbar);
    if (a.out == nullptr) grid.sync();
    pg8::StaticOrder S;
    PH(1)
    { pg8::Gemm g{XB, WIN, M, NIN, D, D, 0}; pg8::G1Order S1; S1.init(G, bx); EpiG1 E{QB, GG, U, out, KB, VT}; pg8::gemm_phase(L, g, S1, E); }
    xcd_barrier(xbar);
    PH(2)
    { const float* cw = a.in[I_CW]; const float* cbias = a.in[I_CB]; S.init(M, 1024, G, bx);
      for (int i = 0; ; ++i) { pg8::Unit tu; if (!S.next(i, tu)) break;
        for (int item = tid; item < 32 * 32; item += 512) { const int c4 = tu.pn * 128 + (item & 31) * 4; const int row0 = tu.pm * 256 + (item >> 5) * 8;
            int pos0, T, seq; const bool samp = row0 >= MP; if (!samp) { pos0 = row0 & 4095; T = 4096; seq = row0 >> 12; } else { pos0 = (row0 - MP) & 31; T = 32; seq = (row0 - MP) >> 5; }
            f32x4 uu[11];
#pragma unroll
            for (int j = 0; j < 11; ++j) { const int p = pos0 - 3 + j;
                if (p >= 0) uu[j] = bf4(*(const u32x2*)(U + (size_t)(row0 - 3 + j) * 512 + c4));
                else if (samp) uu[j] = *(const f32x4*)(a.in[I_LC] + ((size_t)seq * 3 + (3 + p)) * 512 + c4);
                else uu[j] = (f32x4){0.f, 0.f, 0.f, 0.f}; }
            const f32x4 cb4 = *(const f32x4*)(cbias + c4), w0 = *(const f32x4*)(cw + c4), w1 = *(const f32x4*)(cw + 512 + c4), w2 = *(const f32x4*)(cw + 1024 + c4), w3 = *(const f32x4*)(cw + 1536 + c4);
#pragma unroll
            for (int t = 0; t < 8; ++t) { const f32x4 accv = cb4 + uu[t] * w0 + uu[t + 1] * w1 + uu[t + 2] * w2 + uu[t + 3] * w3;
                u32x2 w; w.x = cvt_pk_bf16(accv[0], accv[1]); w.y = cvt_pk_bf16(accv[2], accv[3]); *(u32x2*)(UCB + (size_t)(row0 + t) * 512 + c4) = w;
                if (pos0 + t >= T - 3) *(f32x4*)(out + (samp ? OFF_CS : OFF_CP) + ((size_t)seq * 3 + (pos0 + t - (T - 3))) * 512 + c4) = uu[t + 3]; } } }
      asm volatile("s_waitcnt vmcnt(0)" ::: "memory"); __syncthreads(); }
    PH(3)
    { pg8::Gemm g{UCB, WG, M, 1024, 128, 512, 128}; S.init(M, 1024, G, bx); EpiGate E{a.in[I_RGB], a.in[I_IGB], SPL, UCB, AX}; pg8::gemm_phase(L, g, S, E); }
    PH(4)
    for (int i = 0; ; ++i) { pg8::Unit tu; if (!S.next(i, tu)) break; if (tu.pm >= 128) continue;
        const int chunk = 4 * tu.pm + (wave >> 1), c = (2 * tu.pn + (wave & 1)) * 64 + lane; const size_t base = (size_t)chunk * 64 * 512 + c;
        float hl = 0.f, ap = 1.f;
#pragma unroll 32
        for (int t = 0; t < 64; ++t) { const unsigned pk = AX[base + (size_t)t * 512]; const float av = 1.f - __uint_as_float(pk << 16), xv = __uint_as_float(pk & 0xffff0000u); hl = av * hl + xv; ap *= av; }
        SUMA[chunk * 512 + c] = ap; SUMH[chunk * 512 + c] = hl; }
    PH(3)
    { pg8::Gemm g{XB, WIN, M, NIN, D, D, 0}; pg8::G1Tail S2; S2.init(G, bx); EpiG1 E{QB, GG, U, out, KB, VT}; pg8::gemm_phase(L, g, S2, E); }
    PH(14) { unsigned* actr = (unsigned*)(ws + WS_BAR) + 3584;
        unsigned u = (unsigned)gw;
        while (u < 1056u * 8u) {
            unsigned nx = 0; if (lane == 0) nx = atomicAdd(actr, 1u) + (unsigned)NGW;
            if (u < 256u) { const int uu = (int)(8192u + u); attn_unit<false>(a, QB, AO, KB, VT, uu >> 3, uu & 7, lane); } else { const int uu = (int)(u - 256u); attn_unit<true>(a, QB, AO, KB, VT, uu >> 3, uu & 7, lane); }
            u = (unsigned)__builtin_amdgcn_readfirstlane((int)nx); } }
    xcd_barrier(xbar);
    PH(5)
    for (int u = gw; u < 512 * 8 + 32 * 8; u += NGW) {
        const bool samp = u >= 4096; int row0, nt, c; float hcur; bool lastc; float* hout;
        if (!samp) { const int chunk = u >> 3; c = (u & 7) * 64 + lane; const int b = chunk >> 6, ci = chunk & 63; row0 = chunk * 64; nt = 64; hcur = 0.f;
            for (int j0 = 0; j0 < ci; j0 += 8) { float sa[8], sh[8];
#pragma unroll
                for (int k = 0; k < 8; ++k) { const bool ok = (j0 + k) < ci; const int jj = ok ? (j0 + k) : j0; sa[k] = SUMA[(b * 64 + jj) * 512 + c]; sh[k] = SUMH[(b * 64 + jj) * 512 + c]; if (!ok) { sa[k] = 1.f; sh[k] = 0.f; } }
#pragma unroll
                for (int k = 0; k < 8; ++k) hcur = sa[k] * hcur + sh[k]; }
            lastc = (ci == 63); hout = out + OFF_HP + b * 512 + c; }
        else { const int v = u - 4096; const int bs = v >> 3; c = (v & 7) * 64 + lane; row0 = MP + bs * 32; nt = 32; hcur = a.in[I_LH][bs * 512 + c]; lastc = true; hout = out + OFF_HS + bs * 512 + c; }
        const size_t base = (size_t)row0 * 512 + c;
        for (int t0 = 0; t0 < nt; t0 += 32) { unsigned pk[32]; bf16_t gg[32];
#pragma unroll
            for (int k = 0; k < 32; ++k) { pk[k] = AX[base + (size_t)(t0 + k) * 512]; gg[k] = GG[base + (size_t)(t0 + k) * 512]; }
#pragma unroll
            for (int k = 0; k < 32; ++k) { const float av = 1.f - __uint_as_float(pk[k] << 16), xv = __uint_as_float(pk[k] & 0xffff0000u); hcur = av * hcur + xv;
                AO[(size_t)(row0 + t0 + k) * D + 512 + c] = (bf16_t)(cvt_pk_bf16(hcur * bf2f(gg[k]), 0.f) & 0xffffu); } }
        if (lastc) *hout = hcur; }
    xcd_barrier(xbar);
    PH(6)
    { pg8::Gemm g{AO, WOUT, M, D, D, D, 0}; S.init(M, D, G, bx); EpiRes<true> E{a.in[I_XP], a.in[I_XS], XB, SSQ, nullptr}; pg8::gemm_phase(L, g, S, E); }
    PH(6)
    { const int rem = (M / 256 * (D / 256)) % G; const int b0 = rem; const int nblk = G - b0;
      if (bx >= b0) { LAS float* scr = (LAS float*)(L + wave * 16384); const int dw = (bx - b0) * 8 + wave, NDW = nblk * 8;
        constexpr int IT_WGU = 16 * 176, IT_WD = 44 * 32, IT_WP = 4 * 8;
        for (int it = dw; it < IT_WGU + IT_WD + 4 * IT_WP; it += NDW) {
            int r = it;
            if (r < IT_WGU) { const int kb = r / 176, nb = r % 176; const int n0 = nb * 32;
                const float* src = (n0 & 128) ? a.in[I_FU] : a.in[I_FG]; const int sc0 = (n0 >> 8) * 128 + (n0 & 127);
                transpose_tile(src, FF, sc0, kb * 64, a.in[I_NF], WGU, D, n0, scr, lane); continue; } r -= IT_WGU;
            if (r < IT_WD) { const int kb = r / 32, nb = r % 32; transpose_tile(a.in[I_FD], D, nb * 32, kb * 64, nullptr, WD, FF, nb * 32, scr, lane); continue; } r -= IT_WD;
            { const int g = r / IT_WP; r -= g * IT_WP; const int kb = r / 8, nb = r % 8;
                transpose_tile(a.in[I_PW] + (size_t)g * 256 * 256, 256, nb * 32, kb * 64, nullptr, WP, 256, g * 256 + nb * 32, scr, lane, a.in[I_PS]); }
        } } }
    xcd_barrier(xbar);
    PH(7)
    { pg8::Gemm g{XB, WGU, M, NGU, D, D, 0}; S.init(M, NGU, G, bx); EpiSwiglu E{SSQ, H}; pg8::gemm_phase(L, g, S, E); }
    PH(7)
    { const int rem = (M / 256 * (NGU / 256)) % G; const int b0 = rem; const int nblk = G - b0;
      if (bx >= b0) { LAS float* scr = (LAS float*)(L + wave * 16384); const int dw = (bx - b0) * 8 + wave, NDW = nblk * 8;
        constexpr int IT_WGU = 16 * 176, IT_WD = 44 * 32;
        for (int it = dw; it < IT_WGU + IT_WD; it += NDW) {
            int r = it;
            if (r < IT_WGU) { const int kb = r / 176, nb = r % 176; const int n0 = nb * 32;
                const float* src = ((n0 & 128) ? a.in[I_FU] : a.in[I_FG]) + (size_t)D * FF; const int sc0 = (n0 >> 8) * 128 + (n0 & 127);
                transpose_tile(src, FF, sc0, kb * 64, a.in[I_NF] + D, WGU + (size_t)NGU * D, D, n0, scr, lane); continue; } r -= IT_WGU;
            { const int kb = r / 32, nb = r % 32; transpose_tile(a.in[I_FD] + (size_t)FF * D, D, nb * 32, kb * 64, nullptr, WD + (size_t)D * FF, FF, nb * 32, scr, lane); }
        } } }
    xcd_barrier(xbar);
    PH(8)
    { pg8::Gemm g{H, WD, M, D, FF, FF, 0}; pg8::TailOrder ST; ST.init(FF, G, bx); EpiRes<false, true> E{nullptr, nullptr, XB, SSQ + M, PART}; pg8::gemm_phase(L, g, ST, E); }
    xcd_barrier(xbar);
    PH(9)
    {
        const float* ssq2 = SSQ + M; const float* gm = a.in[I_NM] + D; const float* pbuf = a.in[I_SP]; const LAS float* ldsrs = (const LAS float*)L;
        for (int idx = gt; idx < (MP / PR) * 256; idx += NGT) { const int strip = idx >> 8, c4 = (idx & 255) * 4; const int row0 = strip * PR, pos0 = row0 & 4095, seq = row0 >> 12;
            switch (c4 >> 8) {
                case 0: pool_strip<2, false>(XB, AO, out + OFF_PP, ssq2, ldsrs, pbuf, gm, row0, pos0, seq, 4096, c4); break;
                case 1: pool_strip<4, false>(XB, AO, out + OFF_PP, ssq2, ldsrs, pbuf, gm, row0, pos0, seq, 4096, c4); break;
                case 2: pool_strip<8, false>(XB, AO, out + OFF_PP, ssq2, ldsrs, pbuf, gm, row0, pos0, seq, 4096, c4); break;
                default: pool_strip<16, false>(XB, AO, out + OFF_PP, ssq2, ldsrs, pbuf, gm, row0, pos0, seq, 4096, c4); break; } }
        for (int sidx = bx; sidx < 32; sidx += G) {
            __syncthreads();
#pragma unroll
            for (int j = 0; j < 4; ++j) { const int r = wave * 4 + j; u32x2* xr = (u32x2*)(XB + (size_t)(MP + sidx * 32 + r) * D); const f32x4* pr = (const f32x4*)(PART + (size_t)(sidx * 32 + r) * D); float sq = 0.f;
#pragma unroll
                for (int q = 0; q < 4; ++q) { f32x4 v = bf4(xr[lane + 64 * q]);
#pragma unroll
                    for (int ks = 0; ks < 11; ++ks) v = v + pr[(size_t)ks * (MS * D / 4) + lane + 64 * q];
                    u32x2 wv; wv.x = cvt_pk_bf16(v[0], v[1]); wv.y = cvt_pk_bf16(v[2], v[3]); xr[lane + 64 * q] = wv; sq += (v[0] * v[0] + v[1] * v[1]) + (v[2] * v[2] + v[3] * v[3]); }
                sq = wave_sum(sq); if (lane == 0) ((LAS float*)L)[r] = rsqrtf(sq * (1.f / D) + EPS); }
            asm volatile("s_waitcnt vmcnt(0)" ::: "memory"); __threadfence_block(); __syncthreads();
            const int c4 = (tid & 255) * 4, half = tid >> 8;
            for (int sub = 0; sub < 16 / PR; ++sub) { const int pos0 = half * 16 + sub * PR, row0 = MP + sidx * 32 + pos0;
            switch (c4 >> 8) {
                case 0: pool_strip<2, true>(XB, AO, out + OFF_PS, ssq2, ldsrs, pbuf, gm, row0, pos0, sidx, 32, c4); break;
                case 1: pool_strip<4, true>(XB, AO, out + OFF_PS, ssq2, ldsrs, pbuf, gm, row0, pos0, sidx, 32, c4); break;
                case 2: pool_strip<8, true>(XB, AO, out + OFF_PS, ssq2, ldsrs, pbuf, gm, row0, pos0, sidx, 32, c4); break;
                default: pool_strip<16, true>(XB, AO, out + OFF_PS, ssq2, ldsrs, pbuf, gm, row0, pos0, sidx, 32, c4); break; } } }
    }
    xcd_barrier(xbar);
    PH(10)
    { pg8::Gemm g{AO  , WP, M, D, 256, D, 256}; S.init(M, D, G, bx); EpiRes<false> E{nullptr, nullptr, XB, SSQ + 2 * M, nullptr}; pg8::gemm_phase(L, g, S, E); }
    xcd_barrier(xbar);
    PH(11)
    { pg8::Gemm g{XB, WGU + (size_t)NGU * D, M, NGU, D, D, 0}; S.init(M, NGU, G, bx); EpiSwiglu E{SSQ + 2 * M, H}; pg8::gemm_phase(L, g, S, E); }
    xcd_barrier(xbar);
    PH(12)
    { pg8::Gemm g{H, WD + (size_t)D * FF, M, D, FF, FF, 0}; pg8::TailOrder ST; ST.init(FF, G, bx); EpiRes<false, true> E{nullptr, nullptr, XB, SSQ + 3 * M, PART}; pg8::gemm_phase(L, g, ST, E); }
    xcd_barrier(xbar);
    PH(13)
    { const float* ssq4 = SSQ + 3 * M; const f32x4* gf = (const f32x4*)a.in[I_NFIN];
      for (int m0 = gw; m0 < M; m0 += 2 * NGW) {
          const int m1 = (m0 + NGW < M) ? m0 + NGW : m0; const bool has1 = m0 + NGW < M;
          const u32x2* p0 = (const u32x2*)(XB + (size_t)m0 * D); const u32x2* p1 = (const u32x2*)(XB + (size_t)m1 * D); u32x2 r0[4], r1[4];
#pragma unroll
          for (int q = 0; q < 4; ++q) { r0[q] = p0[lane + 64 * q]; r1[q] = p1[lane + 64 * q]; }
#pragma unroll
          for (int rr = 0; rr < 2; ++rr) { if (rr == 1 && !has1) break; const int m = rr ? m1 : m0; f32x4 v[4]; float sq = 0.f;
#pragma unroll
              for (int q = 0; q < 4; ++q) v[q] = bf4(rr ? r1[q] : r0[q]);
              if (m >= MP) { const f32x4* pr = (const f32x4*)(PART + (size_t)(m - MP) * D);
#pragma unroll
                  for (int ks = 0; ks < 11; ++ks)
#pragma unroll
                      for (int q = 0; q < 4; ++q) v[q] = v[q] + pr[(size_t)ks * (MS * D / 4) + lane + 64 * q]; }
#pragma unroll
              for (int q = 0; q < 4; ++q) sq += (v[q][0] * v[q][0] + v[q][1] * v[q][1]) + (v[q][2] * v[q][2] + v[q][3] * v[q][3]);
              const float ss = (m >= MP) ? wave_sum(sq) : ssq4[m]; const float rs = rsqrtf(ss * (1.f / D) + EPS);
              f32x4* yo = (f32x4*)(out + OFF_Y + (size_t)m * D);
#pragma unroll
              for (int q = 0; q < 4; ++q) __builtin_nontemporal_store(v[q] * rs * gf[lane + 64 * q], yo + lane + 64 * q); } } }
}

#undef ws
#undef SSQ
#undef SUMA
#undef SUMH
#undef KB
#undef VT
#undef PART
#undef SPL
#undef WIN
#undef WG
#undef WOUT
#undef WGU
#undef WD
#undef WP
#undef XB
#undef QB
#undef GG
#undef UCB
#undef U
#undef AX
#undef AO
#undef H
extern "C" void kernel_launch(void* const* d_in, const int* in_sizes, int n_in, void* d_out, int out_size, void* d_ws, size_t ws_size, hipStream_t stream) {
    static int grid = 0;
    if (grid == 0) {
        if (n_in != 24 || out_size != (int)OUT_TOTAL || ws_size < WS_END) { fprintf(stderr, "kernel_launch: unexpected shapes (n_in %d out %d ws %zu)\n", n_in, out_size, ws_size); grid = -1; return; }
        int dev = 0, cus = 0, per_cu = 0;
        hipGetDevice(&dev); hipDeviceGetAttribute(&cus, hipDeviceAttributeMultiprocessorCount, dev);
        hipFuncSetAttribute((const void*)fwd_kernel, hipFuncAttributeMaxDynamicSharedMemorySize, LDS_BYTES);
        hipOccupancyMaxActiveBlocksPerMultiprocessor(&per_cu, (const void*)fwd_kernel, 512, LDS_BYTES);
        if (per_cu < 1) { fprintf(stderr, "kernel_launch: occupancy query says %d blocks/CU\n", per_cu); per_cu = 1; }
        (void)hipGetLastError();
        grid = cus * per_cu;
    }
    if (grid < 0) return;
    (void)hipMemsetAsync((char*)d_ws + WS_BAR, 0, 16384, stream);
    Args a{};
    for (int i = 0; i < 24; ++i) a.in[i] = (const float*)d_in[i];
    a.out = (float*)d_out; a.ws = (unsigned char*)d_ws;
    void* params[] = {&a};
    hipError_t e = hipLaunchCooperativeKernel((const void*)fwd_kernel, dim3(grid), dim3(512), params, LDS_BYTES, stream);
    if (e != hipSuccess) fprintf(stderr, "cooperative launch failed: %s (grid %d)\n", hipGetErrorString(e), grid);
}
```

```cpp
#include <hip/hip_runtime.h>
#include <hip/hip_cooperative_groups.h>
#include <cstdio>
#include <cstdint>
namespace cg = cooperative_groups;

constexpr int MP = 32768;
constexpr int MS = 1024;
constexpr int M = MP + MS;
constexpr int D = 1024, NIN = 2560, FF = 2816, NGU = 2 * FF;
constexpr float EPS = 1e-6f;
constexpr size_t OFF_Y = 0, OFF_KP = 34603008, OFF_VP = 51380224, OFF_HP = 68157440, OFF_CP = 68161536, OFF_PP = 68173824,
                 OFF_KS = 68296704, OFF_VS = 68820992, OFF_HS = 69345280, OFF_CS = 69361664, OFF_PS = 69410816, OUT_TOTAL = 69902336;
constexpr size_t MiB = 1u << 20;
constexpr size_t WS_SSQ = 0, WS_SUM = 1 * MiB, WS_SPL = 3 * MiB, WS_BAR = 3 * MiB + 512 * 1024, WS_WIN = 4 * MiB, WS_WG = 9 * MiB, WS_WOUT = 10 * MiB, WS_WGU = 12 * MiB, WS_WD = 34 * MiB, WS_WP = 45 * MiB,
                 WS_XB = 48 * MiB, WS_QB = 114 * MiB, WS_GG = 147 * MiB, WS_UCB = 180 * MiB, WS_U = 213 * MiB, WS_UC = 279 * MiB, WS_KB = 279 * MiB  , WS_VT = 312 * MiB  , WS_AA = 345 * MiB, WS_XIN = 411 * MiB,
                 WS_AO = 477 * MiB, WS_H = 213 * MiB  , WS_PART = 543 * MiB  , WS_END = 587 * MiB;
static_assert(WS_H + (size_t)M * FF * 2 <= WS_AO, "H overlay");
constexpr int LDS_BYTES = 147456;

namespace pg8 {
#define PG8_LAS __attribute__((address_space(3)))
typedef unsigned short bf16_t;
typedef short bf16x8 __attribute__((ext_vector_type(8)));
typedef float f32x4 __attribute__((ext_vector_type(4)));
typedef unsigned u32x4 __attribute__((ext_vector_type(4)));
typedef unsigned u32x2 __attribute__((ext_vector_type(2)));
constexpr int BM = 256, BK = 64, HALF = 128, HTB = HALF * BK * 2, STAGE_BYTES = 8 * HTB, NXCD = 8, WGM = 8;

__host__ __device__ __forceinline__ int lds_byte(int r, int c) { const int st = (r >> 4) * 2 + (c >> 5), rr = r & 15, cc = c & 31, ob = rr * 64 + cc * 2; return st * 1024 + (ob ^ (((ob >> 9) & 1) << 5)); }
__host__ __device__ __forceinline__ void stage_rc(int b, int& R, int& C) { const int st = b / 1024, sb = b % 1024, swz = sb ^ (((sb >> 9) & 1) << 5); R = (st >> 1) * 16 + swz / 64; C = (st & 1) * 32 + (swz % 64) / 2; }
__host__ __device__ __forceinline__ int perm32(int rho) { const int n = rho >> 4, i = rho & 15; return 8 * (i >> 2) + 4 * n + (i & 3); }

struct Unit { int pm, pn, kb, nk; };
struct Gemm { const bf16_t* A; const bf16_t* Bt; int M, N, K, lda, acs; };

__device__ __forceinline__ bool static_tile(int i, int nM, int nN, int G, int c, int& pm, int& pn) {
    const int nwg = nM * nN; const long Lx = (long)i * G + c; if (Lx >= nwg) return false;
    int wgid = (int)Lx; { const int q = nwg / NXCD, r = nwg % NXCD, xcd = wgid % NXCD, off = wgid / NXCD; wgid = (xcd < r ? xcd * (q + 1) : r * (q + 1) + (xcd - r) * q) + off; }
    const int nig = WGM * nN, gid = wgid / nig, fm = gid * WGM, gsz = (nM - fm) < WGM ? (nM - fm) : WGM;
    pm = fm + ((wgid % nig) % gsz); pn = (wgid % nig) / gsz; return true;
}
struct StaticOrder {
    static constexpr bool SPLIT = false;
    int nM, nN, G, c;
    __device__ __forceinline__ void init(int M_, int N_, int G_, int c_) { nM = M_ / BM; nN = N_ / BM; G = G_; c = c_; }
    __device__ __forceinline__ bool next(int i, Unit& u) const { u.kb = 0; u.nk = 0; return static_tile(i, nM, nN, G, c, u.pm, u.pn); }
};

struct G1Order {
    static constexpr bool SPLIT = false;
    int G, c;
    __device__ __forceinline__ void init(int G_, int c_) { G = G_; c = c_; }
    __device__ __forceinline__ bool next(int i, Unit& u) const { u.kb = 0; u.nk = 0; const int Lx = i * G + c; if (Lx >= 1280) return false;
        if (Lx < 1056) { static_tile(0, 132, 8, 0, Lx, u.pm, u.pn); return true; }
        const int idx = Lx - 1056; u.pm = idx >> 1; u.pn = 8 + (idx & 1); return true; }
};
struct G1Tail {
    static constexpr bool SPLIT = false;
    int G, c;
    __device__ __forceinline__ void init(int G_, int c_) { G = G_; c = c_; }
    __device__ __forceinline__ bool next(int i, Unit& u) const { u.kb = 0; u.nk = 0; const int idx = i * G + ((c + G - 16) % G); if (idx >= 40) return false;
        u.pm = 112 + (idx >> 1); u.pn = 8 + (idx & 1); return true; }
};

struct TailOrder {
    static constexpr bool SPLIT = true;
    int G, c, nm, nkfull;
    __device__ __forceinline__ void init(int K_, int G_, int c_) { G = G_; c = c_; nm = (c_ < 512) ? (512 - c_ + G_ - 1) / G_ : 0; nkfull = K_ / BK; }
    __device__ __forceinline__ bool next(int i, Unit& u) const {
        if (i < nm) { static_tile(i, 128, 4, G, c, u.pm, u.pn); u.kb = 0; u.nk = nkfull; return true; }
        const int t = (i - nm) * G + c; if (t >= 16 * 11) return false;
        const int tile = t / 11, ks = t - tile * 11; u.pm = 128 + (tile >> 2); u.pn = tile & 3; u.kb = ks * 4; u.nk = 4; return true;
    }
};

__device__ __forceinline__ unsigned cvt_pk_bf16(float lo, float hi) { unsigned r; asm volatile("v_cvt_pk_bf16_f32 %0, %1, %2" : "=v"(r) : "v"(lo), "v"(hi)); return r; }

template <class Epi, class Sched>
__device__ __forceinline__ void gemm_phase(PG8_LAS unsigned char* lds, const Gemm g, const Sched& S, const Epi& E) {
    int tid = threadIdx.x; asm volatile("" : "+v"(tid));
    const int wid = __builtin_amdgcn_readfirstlane(tid >> 6), lane = tid & 63, wr = wid >> 2, wc = wid & 3, fr = lane & 15, fq = lane >> 4;
    int K = g.K; asm volatile("" : "+s"(K));
    const int ntfull = K / BK;
    unsigned voffA[2], voffB[2];
#pragma unroll
    for (int i = 0; i < 2; ++i) { int R, C; stage_rc(tid * 16 + i * 8192, R, C); const int Rb = (R & ~31) + perm32(R & 31);
        voffA[i] = (unsigned)(R * g.lda + C) * 2u; voffB[i] = (unsigned)(Rb * K + C) * 2u; }
    const size_t kstep = (size_t)(BK * 2);
    const size_t hstepA = (size_t)HALF * g.lda * 2, hstepB = (size_t)HALF * K * 2;
    const unsigned ldsw = (unsigned)wid * 1024u;
    const int aoff = lds_byte(wr * 64 + fr, fq * 8), boff = lds_byte(wc * 32 + fr, fq * 8);
#define PG8_TA(u) ((const char*)g.A + ((size_t)(u).pm * BM * g.lda + (size_t)(u).pn * g.acs) * 2 + (Sched::SPLIT ? (size_t)(u).kb * (BK * 2) : 0))
#define PG8_TB(u) ((const char*)g.Bt + (size_t)(u).pn * BM * K * 2 + (Sched::SPLIT ? (size_t)(u).kb * (BK * 2) : 0))
#define PG8_SA(b, h) (((b) * 2 + (h)) * HTB)
#define PG8_SB(b, h) ((4 + (b) * 2 + (h)) * HTB)
#define PG8_STAGE(bufoff, gbase, voff) do { _Pragma("unroll") for (int _i = 0; _i < 2; ++_i) \
        __builtin_amdgcn_global_load_lds((const unsigned*)((const char*)(gbase) + (voff)[_i]), (PG8_LAS unsigned*)(lds + (bufoff) + ldsw + _i * 8192), 16, 0, 0); } while (0)
#define PG8_LDA(dst, b, h) do { _Pragma("unroll") for (int m = 0; m < 4; ++m) _Pragma("unroll") for (int k = 0; k < 2; ++k) dst[m][k] = *(const PG8_LAS bf16x8*)(lds + PG8_SA(b, h) + aoff + m * 2048 + k * 1024); } while (0)
#define PG8_LDB(dst, b, h) do { _Pragma("unroll") for (int n = 0; n < 2; ++n) _Pragma("unroll") for (int k = 0; k < 2; ++k) dst[n][k] = *(const PG8_LAS bf16x8*)(lds + PG8_SB(b, h) + boff + n * 2048 + k * 1024); } while (0)
#define PG8_MMA(ai, bj, At, Bt) do { __builtin_amdgcn_s_setprio(1); _Pragma("unroll") for (int m = 0; m < 4; ++m) _Pragma("unroll") for (int n = 0; n < 2; ++n) _Pragma("unroll") for (int k = 0; k < 2; ++k) \
        acc[ai][bj][m][n] = __builtin_amdgcn_mfma_f32_16x16x32_bf16(Bt[n][k], At[m][k], acc[ai][bj][m][n], 0, 0, 0); __builtin_amdgcn_s_setprio(0); } while (0)
#define PG8_WAIT_V(n) asm volatile("s_waitcnt vmcnt(" #n ")" ::: "memory")
#define PG8_WAIT_L(n) asm volatile("s_waitcnt lgkmcnt(" #n ")" ::: "memory")
#define PG8_BAR __builtin_amdgcn_s_barrier()
#define PG8_SCHED __builtin_amdgcn_sched_barrier(0)
    Unit cur, nxt; int ui = 0;
    if (!S.next(0, cur)) return;
    f32x4 acc[2][2][4][2];
    E.init(acc, cur, wr, wc, fr, fq);
    bf16x8 At[4][2], B0[2][2], B1[2][2];
    const char* cA = PG8_TA(cur); const char* cB = PG8_TB(cur);
    PG8_STAGE(PG8_SB(0, 0), cB, voffB); PG8_STAGE(PG8_SB(0, 1), cB + hstepB, voffB); PG8_STAGE(PG8_SA(0, 0), cA, voffA); PG8_STAGE(PG8_SA(0, 1), cA + hstepA, voffA);
    if (wr == 1) PG8_BAR;
    PG8_WAIT_V(2); PG8_BAR;
    PG8_STAGE(PG8_SB(1, 0), cB + kstep, voffB); PG8_STAGE(PG8_SA(1, 0), cA + kstep, voffA); PG8_STAGE(PG8_SB(1, 1), cB + hstepB + kstep, voffB);
    PG8_WAIT_V(6); PG8_BAR;
    for (;;) {
        const bool has_next = S.next(ui + 1, nxt);
        const char* nA = has_next ? PG8_TA(nxt) : cA; const char* nB = has_next ? PG8_TB(nxt) : cB;
        const int nt = Sched::SPLIT ? cur.nk : ntfull;
        for (int t = 0; t < nt; t += 2) {
            const bool last = (t == nt - 2);
            const char* a1 = cA + (size_t)(t + 1) * kstep;
            const char* a2 = last ? nA : cA + (size_t)(t + 2) * kstep; const char* b2 = last ? nB : cB + (size_t)(t + 2) * kstep;
            const char* a3 = a2 + kstep; const char* b3 = b2 + kstep;
            PG8_LDB(B0, 0, 0); PG8_LDB(B1, 0, 1); PG8_SCHED; PG8_LDA(At, 0, 0); PG8_STAGE(PG8_SA(1, 1), a1 + hstepA, voffA);
            PG8_WAIT_V(8); PG8_WAIT_L(0); PG8_BAR; PG8_MMA(0, 0, At, B0); PG8_MMA(0, 1, At, B1); PG8_BAR; PG8_SCHED;
            PG8_LDA(At, 0, 1); PG8_STAGE(PG8_SB(0, 0), b2, voffB); PG8_STAGE(PG8_SB(0, 1), b2 + hstepB, voffB); PG8_STAGE(PG8_SA(0, 0), a2, voffA);
            PG8_WAIT_V(8); PG8_WAIT_L(0); PG8_BAR; PG8_MMA(1, 0, At, B0); PG8_MMA(1, 1, At, B1); PG8_BAR; PG8_SCHED;
            PG8_LDB(B0, 1, 0); PG8_LDB(B1, 1, 1); PG8_SCHED; PG8_LDA(At, 1, 0); PG8_STAGE(PG8_SA(0, 1), a2 + hstepA, voffA);
            PG8_WAIT_V(8); PG8_WAIT_L(0); PG8_BAR; PG8_MMA(0, 0, At, B0); PG8_MMA(0, 1, At, B1); PG8_BAR; PG8_SCHED;
            PG8_LDA(At, 1, 1); PG8_STAGE(PG8_SB(1, 0), b3, voffB); PG8_STAGE(PG8_SB(1, 1), b3 + hstepB, voffB); PG8_STAGE(PG8_SA(1, 0), a3, voffA);
            PG8_WAIT_V(8); PG8_WAIT_L(0); PG8_BAR; PG8_MMA(1, 0, At, B0); PG8_MMA(1, 1, At, B1); PG8_BAR; PG8_SCHED;
        }
        if (wr == 0) PG8_BAR;
        E(acc, cur, wr, wc, fr, fq);
        if (!has_next) break;
        E.init(acc, nxt, wr, wc, fr, fq);
        cur = nxt; cA = nA; cB = nB; ++ui;
        if (wr == 1) PG8_BAR;
    }
    PG8_WAIT_V(0);
    PG8_BAR;
#undef PG8_TA
#undef PG8_TB
#undef PG8_SA
#undef PG8_SB
#undef PG8_STAGE
#undef PG8_LDA
#undef PG8_LDB
#undef PG8_MMA
#undef PG8_WAIT_V
#undef PG8_WAIT_L
#undef PG8_BAR
#undef PG8_SCHED
}
}

using pg8::bf16_t; using pg8::bf16x8; using pg8::f32x4; using pg8::u32x4; using pg8::u32x2; using pg8::Unit; using pg8::cvt_pk_bf16;
typedef float f32x16 __attribute__((ext_vector_type(16)));
#define LAS __attribute__((address_space(3)))

__device__ __forceinline__ float bf2f(bf16_t v) { return __uint_as_float((unsigned)v << 16); }
__device__ __forceinline__ float sigmoidf_(float x) { return 1.f / (1.f + __expf(-x)); }
__device__ __forceinline__ float gelu_tanh(float x) { const float y2 = 1.5957691216f * (x + 0.044715f * x * x * x); return x / (1.f + __expf(-y2)); }
__device__ __forceinline__ bf16x8 pack8(float a0, float a1, float a2, float a3, float a4, float a5, float a6, float a7) {
    u32x4 w; w.x = cvt_pk_bf16(a0, a1); w.y = cvt_pk_bf16(a2, a3); w.z = cvt_pk_bf16(a4, a5); w.w = cvt_pk_bf16(a6, a7); return __builtin_bit_cast(bf16x8, w); }

__device__ __forceinline__ f32x4 bf4lo(u32x4 r) { return (f32x4){__uint_as_float(r.x << 16), __uint_as_float(r.x & 0xffff0000u), __uint_as_float(r.y << 16), __uint_as_float(r.y & 0xffff0000u)}; }
__device__ __forceinline__ f32x4 bf4hi(u32x4 r) { return (f32x4){__uint_as_float(r.z << 16), __uint_as_float(r.z & 0xffff0000u), __uint_as_float(r.w << 16), __uint_as_float(r.w & 0xffff0000u)}; }
__device__ __forceinline__ f32x4 bf4(u32x2 r) { return (f32x4){__uint_as_float(r.x << 16), __uint_as_float(r.x & 0xffff0000u), __uint_as_float(r.y << 16), __uint_as_float(r.y & 0xffff0000u)}; }
__device__ __forceinline__ void acc_zero(f32x4 (&acc)[2][2][4][2]) {
#pragma unroll
    for (int a = 0; a < 2; ++a)
#pragma unroll
        for (int b = 0; b < 2; ++b)
#pragma unroll
            for (int m = 0; m < 4; ++m)
#pragma unroll
                for (int n = 0; n < 2; ++n) acc[a][b][m][n] = (f32x4){0.f, 0.f, 0.f, 0.f};
}
struct EpiG1 {
    bf16_t* QB; bf16_t* GG; bf16_t* U; float* out; bf16_t* KBp; bf16_t* VTp;
    __device__ __forceinline__ void init(f32x4 (&acc)[2][2][4][2], const Unit&, int, int, int, int) const { acc_zero(acc); }
    __device__ __forceinline__ void operator()(const f32x4 (&acc)[2][2][4][2], const Unit& u, int wr, int wc, int fr, int fq) const {
        const int region = u.pn >> 1; const int cb = (u.pn & 1) * 256 + wc * 32 + 8 * fq; const int row0 = u.pm * 256 + wr * 64 + fr;
        const bool samp = u.pm >= 128;
#pragma unroll
        for (int ai = 0; ai < 2; ++ai)
#pragma unroll
            for (int m = 0; m < 4; ++m) { const int row = row0 + ai * 128 + m * 16;
#pragma unroll
                for (int bj = 0; bj < 2; ++bj) { const int col = cb + bj * 128; const f32x4 v0 = acc[ai][bj][m][0], v1 = acc[ai][bj][m][1];
                    if (region == 0) { u32x4 w; const float qs = 0.125f * 1.44269504089f;     w.x = cvt_pk_bf16(v0[0] * qs, v0[1] * qs); w.y = cvt_pk_bf16(v0[2] * qs, v0[3] * qs); w.z = cvt_pk_bf16(v1[0] * qs, v1[1] * qs); w.w = cvt_pk_bf16(v1[2] * qs, v1[3] * qs);
                        *(u32x4*)(QB + (size_t)row * 512 + col) = w; }
                    else if (region == 1 || region == 2) {
                        float* o = out + (region == 1 ? (samp ? OFF_KS : OFF_KP) : (samp ? OFF_VS : OFF_VP)) + (size_t)(samp ? row - MP : row) * 512 + col;
                        if (samp) { *(f32x4*)o = v0; *(f32x4*)(o + 4) = v1; } else { __builtin_nontemporal_store(v0, (f32x4*)o); __builtin_nontemporal_store(v1, (f32x4*)(o + 4)); }
                        if (!samp) { const unsigned w0 = cvt_pk_bf16(v0[0], v0[1]), w1 = cvt_pk_bf16(v0[2], v0[3]), w2 = cvt_pk_bf16(v1[0], v1[1]), w3 = cvt_pk_bf16(v1[2], v1[3]);
                            const int bh = (row >> 12) * 8 + (col >> 6), pos = row & 4095, d0 = col & 63;
                            if (region == 1) { u32x4 w; w.x = w0; w.y = w1; w.z = w2; w.w = w3; *(u32x4*)(KBp + ((size_t)((bh * 128 + (pos >> 5)) * 4 + (d0 >> 4)) * 512 + (pos & 31) * 16 + (d0 & 15))) = w; }
                            else { bf16_t* vt = VTp + ((size_t)(bh * 1024 + (pos >> 2)) * 64 + d0) * 4 + (pos & 3);
                                vt[0] = (bf16_t)(w0 & 0xffffu); vt[4] = (bf16_t)(w0 >> 16); vt[8] = (bf16_t)(w1 & 0xffffu); vt[12] = (bf16_t)(w1 >> 16);
                                vt[16] = (bf16_t)(w2 & 0xffffu); vt[20] = (bf16_t)(w2 >> 16); vt[24] = (bf16_t)(w3 & 0xffffu); vt[28] = (bf16_t)(w3 >> 16); } } }
                    else if (region == 3) { u32x4 w; w.x = cvt_pk_bf16(v0[0], v0[1]); w.y = cvt_pk_bf16(v0[2], v0[3]); w.z = cvt_pk_bf16(v1[0], v1[1]); w.w = cvt_pk_bf16(v1[2], v1[3]); *(u32x4*)(U + (size_t)row * 512 + col) = w; }
                    else { u32x4 w; w.x = cvt_pk_bf16(gelu_tanh(v0[0]), gelu_tanh(v0[1])); w.y = cvt_pk_bf16(gelu_tanh(v0[2]), gelu_tanh(v0[3])); w.z = cvt_pk_bf16(gelu_tanh(v1[0]), gelu_tanh(v1[1])); w.w = cvt_pk_bf16(gelu_tanh(v1[2]), gelu_tanh(v1[3]));
                        *(u32x4*)(GG + (size_t)row * 512 + col) = w; }
                } asm volatile("" ::: "memory"); }
    }
};
struct EpiGate {
    const float *rgb, *igb, *lam; const bf16_t* UCBp; unsigned* AX;
    __device__ __forceinline__ void init(f32x4 (&acc)[2][2][4][2], const Unit&, int, int, int, int) const { acc_zero(acc); }
    __device__ __forceinline__ void operator()(const f32x4 (&acc)[2][2][4][2], const Unit& u, int wr, int wc, int fr, int fq) const {
        const int row0 = u.pm * 256 + wr * 64 + fr; const int cb = u.pn * 128 + wc * 32 + 8 * fq;
        const f32x4 sp0 = *(const f32x4*)(lam + cb), sp1 = *(const f32x4*)(lam + cb + 4), rb0 = *(const f32x4*)(rgb + cb), rb1 = *(const f32x4*)(rgb + cb + 4), ib0 = *(const f32x4*)(igb + cb), ib1 = *(const f32x4*)(igb + cb + 4);
#pragma unroll
        for (int ai = 0; ai < 2; ++ai) {
            f32x4 ucv[4][2];
#pragma unroll
            for (int m = 0; m < 4; ++m) { const u32x4 raw = *(const u32x4*)(UCBp + (size_t)(row0 + ai * 128 + m * 16) * 512 + cb); ucv[m][0] = bf4lo(raw); ucv[m][1] = bf4hi(raw); }
#pragma unroll
            for (int m = 0; m < 4; ++m)
#pragma unroll
                for (int n = 0; n < 2; ++n) { const size_t off = (size_t)(row0 + ai * 128 + m * 16) * 512 + cb + 4 * n;
                    const f32x4 uv = ucv[m][n], sp = n ? sp1 : sp0, rb = n ? rb1 : rb0, ib = n ? ib1 : ib0; u32x4 pk;
#pragma unroll
                    for (int j = 0; j < 4; ++j) { const float r = sigmoidf_(acc[ai][0][m][n][j] + rb[j]), ig = sigmoidf_(acc[ai][1][m][n][j] + ib[j]);
                        const float la = sp[j] * r; const float ae = __expf(la); const float om = 1.f - ae; pk[j] = cvt_pk_bf16(om, sqrtf(om * (1.f + ae)) * ig * uv[j]); }
                    *(u32x4*)(AX + off) = pk; }
            asm volatile("" ::: "memory"); }
    }
};
template <bool FROMX, bool TAIL = false> struct EpiRes {
    const float* xP; const float* xS; bf16_t* XB; float* ssq; float* part;
    __device__ __forceinline__ void init(f32x4 (&acc)[2][2][4][2], const Unit& u, int wr, int wc, int fr, int fq) const {
        const bool samp = u.pm >= 128;
        if (TAIL && samp) { acc_zero(acc); return; }
        const int cb = u.pn * 256 + wc * 32 + 8 * fq; const int row0 = u.pm * 256 + wr * 64 + fr;
        if (FROMX) { const float* rbase = (samp ? xS : xP) + (size_t)(row0 - (samp ? MP : 0)) * D + cb;
#pragma unroll
            for (int ai = 0; ai < 2; ++ai)
#pragma unroll
                for (int m = 0; m < 4; ++m)
#pragma unroll
                    for (int bj = 0; bj < 2; ++bj) { const float* rp = rbase + (size_t)(ai * 128 + m * 16) * D + bj * 128; acc[ai][bj][m][0] = __builtin_nontemporal_load((const f32x4*)rp); acc[ai][bj][m][1] = __builtin_nontemporal_load((const f32x4*)(rp + 4)); } }
        else { const bf16_t* rbase = XB + (size_t)row0 * D + cb;
#pragma unroll
            for (int ai = 0; ai < 2; ++ai)
#pragma unroll
                for (int m = 0; m < 4; ++m)
#pragma unroll
                    for (int bj = 0; bj < 2; ++bj) { const u32x4 raw = *(const u32x4*)(rbase + (size_t)(ai * 128 + m * 16) * D + bj * 128); acc[ai][bj][m][0] = bf4lo(raw); acc[ai][bj][m][1] = bf4hi(raw); } }
    }
    __device__ __forceinline__ void operator()(const f32x4 (&acc)[2][2][4][2], const Unit& u, int wr, int wc, int fr, int fq) const {
        const int cb = u.pn * 256 + wc * 32 + 8 * fq; const int row0 = u.pm * 256 + wr * 64 + fr; const bool samp = u.pm >= 128;
        if (TAIL && samp) {
#pragma unroll
            for (int ai = 0; ai < 2; ++ai)
#pragma unroll
                for (int m = 0; m < 4; ++m) { const int row = row0 + ai * 128 + m * 16;
#pragma unroll
                    for (int bj = 0; bj < 2; ++bj) { float* xo = part + ((size_t)(u.kb >> 2) * MS + (row - MP)) * D + cb + bj * 128;
                        *(f32x4*)xo = acc[ai][bj][m][0]; *(f32x4*)(xo + 4) = acc[ai][bj][m][1]; } }
            return;
        }
#pragma unroll
        for (int ai = 0; ai < 2; ++ai)
#pragma unroll
            for (int m = 0; m < 4; ++m) { const int row = row0 + ai * 128 + m * 16; float s = 0.f;
#pragma unroll
                for (int bj = 0; bj < 2; ++bj) { const int col = cb + bj * 128; const f32x4 v0 = acc[ai][bj][m][0], v1 = acc[ai][bj][m][1];
                    u32x4 w; w.x = cvt_pk_bf16(v0[0], v0[1]); w.y = cvt_pk_bf16(v0[2], v0[3]); w.z = cvt_pk_bf16(v1[0], v1[1]); w.w = cvt_pk_bf16(v1[2], v1[3]); *(u32x4*)(XB + (size_t)row * D + col) = w;
                    s += (v0[0] * v0[0] + v0[1] * v0[1]) + (v0[2] * v0[2] + v0[3] * v0[3]) + (v1[0] * v1[0] + v1[1] * v1[1]) + (v1[2] * v1[2] + v1[3] * v1[3]); }
                s += __shfl_xor(s, 16); s += __shfl_xor(s, 32);
                if (fq == 0) atomicAdd(ssq + row, s); }
    }
};
struct EpiSwiglu {
    const float* ssq; bf16_t* H;
    __device__ __forceinline__ void init(f32x4 (&acc)[2][2][4][2], const Unit&, int, int, int, int) const { acc_zero(acc); }
    __device__ __forceinline__ void operator()(const f32x4 (&acc)[2][2][4][2], const Unit& u, int wr, int wc, int fr, int fq) const {
        const int col = u.pn * 128 + wc * 32 + 8 * fq; const int row0 = u.pm * 256 + wr * 64 + fr;
        float rsv[8];
#pragma unroll
        for (int i = 0; i < 8; ++i) rsv[i] = ssq[row0 + (i >> 2) * 128 + (i & 3) * 16];
#pragma unroll
        for (int ai = 0; ai < 2; ++ai)
#pragma unroll
            for (int m = 0; m < 4; ++m) { const int row = row0 + ai * 128 + m * 16; const float rs = rsqrtf(rsv[ai * 4 + m] * (1.f / D) + EPS); float h[8];
#pragma unroll
                for (int j = 0; j < 8; ++j) { const float gv = acc[ai][0][m][j >> 2][j & 3] * rs, uv = acc[ai][1][m][j >> 2][j & 3] * rs; h[j] = gv / (1.f + __expf(-gv)) * uv; }
                u32x4 w; w.x = cvt_pk_bf16(h[0], h[1]); w.y = cvt_pk_bf16(h[2], h[3]); w.z = cvt_pk_bf16(h[4], h[5]); w.w = cvt_pk_bf16(h[6], h[7]);
                *(u32x4*)(H + (size_t)row * FF + col) = w; }
    }
};

struct Args { const float* in[24]; float* out; unsigned char* ws; };
enum { I_XP = 0, I_XS, I_CK, I_CV, I_LH, I_LC, I_SP, I_WIN, I_CW, I_CB, I_RGW, I_RGB, I_IGW, I_IGB, I_LAM, I_WOUT, I_PW, I_PS, I_NM, I_NF, I_FG, I_FU, I_FD, I_NFIN };

__device__ __forceinline__ void transpose_tile(const float* W, int ldw, int srccol0, int k0, const float* gamma, bf16_t* WT, int ldwt, int dstrow0, LAS float* scr, int lane, const float* nscale = nullptr) {
    const float ns = nscale ? nscale[dstrow0 + (lane & 31)] : 1.f;
#pragma unroll
    for (int i = 0; i < 32; ++i) { const int kk = 2 * i + (lane >> 5); float v = __builtin_nontemporal_load(W + (size_t)(k0 + kk) * ldw + srccol0 + (lane & 31)); if (gamma) v *= gamma[k0 + kk]; scr[kk * 33 + (lane & 31)] = v * ns; }
    asm volatile("s_waitcnt lgkmcnt(0)" ::: "memory");
    const int c = lane & 7;
#pragma unroll
    for (int j = 0; j < 4; ++j) { const int n = (lane >> 3) + 8 * j; const LAS float* s = scr + (8 * c) * 33 + n;
        u32x4 o; o.x = cvt_pk_bf16(s[0 * 33], s[1 * 33]); o.y = cvt_pk_bf16(s[2 * 33], s[3 * 33]); o.z = cvt_pk_bf16(s[4 * 33], s[5 * 33]); o.w = cvt_pk_bf16(s[6 * 33], s[7 * 33]);
        *(u32x4*)(WT + (size_t)(dstrow0 + n) * ldwt + k0 + 8 * c) = o; }
    asm volatile("s_waitcnt lgkmcnt(0)" ::: "memory");
}
__device__ __forceinline__ float wave_sum(float v) {
#pragma unroll
    for (int o = 1; o < 64; o <<= 1) v += __shfl_xor(v, o);
    return v;
}
__device__ __forceinline__ int crow(int r, int hi) { return (r & 3) + 8 * (r >> 2) + 4 * hi; }

template <bool PR>
__device__ __forceinline__ void attn_unit(const Args& a, const bf16_t* QB, bf16_t* AO, const bf16_t* KBp, const bf16_t* VTp, int qt, int h, int lane) {
    const int r32 = lane & 31, hi = lane >> 5;
    const float *Kd, *Vd, *Kc, *Vc; int nprev; size_t qrow0;
    if (qt < 1024) { const int b = qt >> 7, tq = qt & 127; qrow0 = (size_t)qt * 32;
        Kc = a.out + OFF_KP + (size_t)b * 4096 * 512 + h * 64; Vc = a.out + OFF_VP + (size_t)b * 4096 * 512 + h * 64;
        Kd = Kc + (size_t)tq * 32 * 512; Vd = Vc + (size_t)tq * 32 * 512; nprev = tq; }
    else { const int bs = qt - 1024; qrow0 = (size_t)MP + (size_t)bs * 32;
        Kd = a.out + OFF_KS + (size_t)bs * 32 * 512 + h * 64; Vd = a.out + OFF_VS + (size_t)bs * 32 * 512 + h * 64;
        Kc = a.in[I_CK] + (size_t)bs * 4096 * 512 + h * 64; Vc = a.in[I_CV] + (size_t)bs * 4096 * 512 + h * 64; nprev = 128; }
    bf16x8 qf[4];
    { const bf16_t* Qp = QB + (qrow0 + r32) * 512 + h * 64 + hi * 8;
#pragma unroll
      for (int kk = 0; kk < 4; ++kk) qf[kk] = *(const bf16x8*)(Qp + kk * 16); }
    f32x16 o0, o1;
#pragma unroll
    for (int r = 0; r < 16; ++r) { o0[r] = 0.f; o1[r] = 0.f; }
    float Cm = 1.f; int Ce = 0;
    constexpr int DP = PR ? 3 : 1;
    f32x4 kr[8]; float vr[32];
    bf16x8 krb[DP][4]; u32x2 vrb[DP][8];
    const bf16_t* Kbb = KBp + (size_t)(((qt >> 7) * 8 + h) * 128) * 2048 + r32 * 16 + hi * 8;
    const bf16_t* Vtb = VTp + ((size_t)(((qt >> 7) * 8 + h) * 1024 + hi) * 64 + r32) * 4;
#define ATT_LOAD(Kt_, Vt_) do { const float* kp_ = (Kt_) + (size_t)r32 * 512 + hi * 8; \
        _Pragma("unroll") for (int kk = 0; kk < 4; ++kk) { kr[2 * kk] = *(const f32x4*)(kp_ + kk * 16); kr[2 * kk + 1] = *(const f32x4*)(kp_ + kk * 16 + 4); } \
        const float* vp_ = (Vt_) + (size_t)(4 * hi) * 512 + r32; \
        _Pragma("unroll") for (int sI = 0; sI < 2; ++sI) _Pragma("unroll") for (int dh = 0; dh < 2; ++dh) _Pragma("unroll") for (int i = 0; i < 8; ++i) \
            vr[(sI * 2 + dh) * 8 + i] = vp_[(size_t)(16 * sI + (i & 3) + 8 * (i >> 2)) * 512 + dh * 32]; } while (0)
#define ATT_LOADB(J_, key0_) do { const bf16_t* kp_ = Kbb + (size_t)((key0_) >> 5) * 2048; \
        _Pragma("unroll") for (int kk = 0; kk < 4; ++kk) krb[J_][kk] = *(const bf16x8*)(kp_ + kk * 512); \
        _Pragma("unroll") for (int sI = 0; sI < 2; ++sI) _Pragma("unroll") for (int dh = 0; dh < 2; ++dh) { const bf16_t* vp_ = Vtb + ((size_t)(((key0_) >> 2) + 4 * sI) * 64 + 32 * dh) * 4; \
            vrb[J_][(sI * 2 + dh) * 2] = *(const u32x2*)vp_; vrb[J_][(sI * 2 + dh) * 2 + 1] = *(const u32x2*)(vp_ + 2 * 64 * 4); } } while (0)
    if (PR) {
#pragma unroll
        for (int j = 0; j < DP; ++j) if (j <= nprev) ATT_LOADB(j, (nprev - j) * 32);
    } else ATT_LOAD(Kd, Vd);
    bool done = false;
    for (int it0 = 0; it0 <= nprev && !done; it0 += DP) {
#pragma unroll
      for (int j = 0; j < DP; ++j) { const int it = it0 + j; if (it > nprev) { done = true; break; }
        bf16x8 kf[4], vb[4];
        if (PR) {
#pragma unroll
            for (int kk = 0; kk < 4; ++kk) kf[kk] = krb[j][kk];
#pragma unroll
            for (int q = 0; q < 4; ++q) { u32x4 w; w.x = vrb[j][2 * q].x; w.y = vrb[j][2 * q].y; w.z = vrb[j][2 * q + 1].x; w.w = vrb[j][2 * q + 1].y; vb[q] = __builtin_bit_cast(bf16x8, w); }
            if (it + DP <= nprev) ATT_LOADB(j, (nprev - it - DP) * 32);
        } else {
#pragma unroll
            for (int kk = 0; kk < 4; ++kk) kf[kk] = pack8(kr[2 * kk][0], kr[2 * kk][1], kr[2 * kk][2], kr[2 * kk][3], kr[2 * kk + 1][0], kr[2 * kk + 1][1], kr[2 * kk + 1][2], kr[2 * kk + 1][3]);
#pragma unroll
            for (int q = 0; q < 4; ++q) vb[q] = pack8(vr[q * 8 + 0], vr[q * 8 + 1], vr[q * 8 + 2], vr[q * 8 + 3], vr[q * 8 + 4], vr[q * 8 + 5], vr[q * 8 + 6], vr[q * 8 + 7]);
            if (it < nprev) { const size_t toff = (size_t)(nprev - it - 1) * 32 * 512; ATT_LOAD(Kc + toff, Vc + toff); }
        }
        f32x16 s;
#pragma unroll
        for (int r = 0; r < 16; ++r) s[r] = 0.f;
#pragma unroll
        for (int kk = 0; kk < 4; ++kk) s = __builtin_amdgcn_mfma_f32_32x32x16_bf16(kf[kk], qf[kk], s, 0, 0, 0);
        float sg[16], om[16];
#pragma unroll
        for (int r = 0; r < 16; ++r) { const float z2 = s[r]; const float e = __builtin_amdgcn_exp2f(-fabsf(z2)); const float rc = __builtin_amdgcn_rcpf(1.f + e); const float t = e * rc;
            const bool pos = z2 >= 0.f; const bool valid = (it != 0) || (crow(r, hi) < r32);
            sg[r] = valid ? (pos ? rc : t) : 0.f; om[r] = valid ? (pos ? t : rc) : 1.f; }
        const float G0 = (om[0] * om[1]) * (om[2] * om[3]), G1 = (om[4] * om[5]) * (om[6] * om[7]), G2 = (om[8] * om[9]) * (om[10] * om[11]), G3 = (om[12] * om[13]) * (om[14] * om[15]);
        const float P0 = __shfl_xor(G0, 32), P1 = __shfl_xor(G1, 32), P2 = __shfl_xor(G2, 32), P3 = __shfl_xor(G3, 32);
        const float t3 = G3 * P3, t2 = G2 * P2, t1 = G1 * P1, t0 = G0 * P0;
        const float Cs = ldexpf(Cm, Ce);
        float base[4];
        base[3] = Cs * (hi ? 1.f : P3); base[2] = Cs * t3 * (hi ? 1.f : P2); base[1] = Cs * (t3 * t2) * (hi ? 1.f : P1); base[0] = Cs * ((t3 * t2) * t1) * (hi ? 1.f : P0);
        float w[16];
#pragma unroll
        for (int g = 0; g < 4; ++g) { float bt = base[g];
#pragma unroll
            for (int rr = 3; rr >= 0; --rr) { const int r = 4 * g + rr; w[r] = sg[r] * bt; bt *= om[r]; } }
        { const float nc = Cm * ((t0 * t1) * (t2 * t3)); Cm = __builtin_amdgcn_frexp_mantf(nc); Ce += __builtin_amdgcn_frexp_expf(nc); }
        const bf16x8 wa0 = pack8(w[0], w[1], w[2], w[3], w[4], w[5], w[6], w[7]), wa1 = pack8(w[8], w[9], w[10], w[11], w[12], w[13], w[14], w[15]);
        o0 = __builtin_amdgcn_mfma_f32_32x32x16_bf16(wa0, vb[0], o0, 0, 0, 0); o0 = __builtin_amdgcn_mfma_f32_32x32x16_bf16(wa1, vb[2], o0, 0, 0, 0);
        o1 = __builtin_amdgcn_mfma_f32_32x32x16_bf16(wa0, vb[1], o1, 0, 0, 0); o1 = __builtin_amdgcn_mfma_f32_32x32x16_bf16(wa1, vb[3], o1, 0, 0, 0);
        if (__all(Cm == 0.f || Ce < -150)) { done = true; break; }
      }
    }
#undef ATT_LOAD
#undef ATT_LOADB
    bf16_t* op = AO + qrow0 * D + h * 64 + r32;
#pragma unroll
    for (int r = 0; r < 16; ++r) { const size_t ro = (size_t)crow(r, hi) * D; op[ro] = (bf16_t)(cvt_pk_bf16(o0[r], 0.f) & 0xffffu); op[ro + 32] = (bf16_t)(cvt_pk_bf16(o1[r], 0.f) & 0xffffu); }
}


constexpr int PR = 8;
template <int W, bool SAMP>
__device__ __forceinline__ void pool_strip(const bf16_t* XRp, bf16_t* XBp, float* pout, const float* ssq2, const LAS float* ldsrs, const float* pbuf, const float* gm,
                                           int row0, int pos0, int seq, int Tseq, int c4) {
    const f32x4 gv = *(const f32x4*)(gm + c4);
    f32x4 xn[PR + W - 1];
#pragma unroll
    for (int j = 0; j < PR + W - 1; ++j) { const int p = pos0 - (W - 1) + j, rr = row0 - (W - 1) + j;
        if (p >= 0) { const float rs = SAMP ? ldsrs[p] : rsqrtf(ssq2[rr] * (1.f / D) + EPS); xn[j] = bf4(*(const u32x2*)(XRp + (size_t)rr * D + c4)) * rs * gv; }
        else if (SAMP) xn[j] = *(const f32x4*)(pbuf + ((size_t)seq * 15 + (15 + p)) * D + c4);
        else xn[j] = (f32x4){0.f, 0.f, 0.f, 0.f}; }
    f32x4 Sw = (f32x4){0.f, 0.f, 0.f, 0.f};
#pragma unroll
    for (int j = 0; j < W - 1; ++j) Sw = Sw + xn[j];
#pragma unroll
    for (int t = 0; t < PR; ++t) { const int pos = pos0 + t; const f32x4 x = xn[t + W - 1]; Sw = Sw + x;
        const float cnt = SAMP ? (float)W : (float)((pos + 1 < W) ? pos + 1 : W); const f32x4 dv = Sw * (1.f / cnt) - x;
        u32x2 wv; wv.x = cvt_pk_bf16(dv[0], dv[1]); wv.y = cvt_pk_bf16(dv[2], dv[3]); *(u32x2*)(XBp + (size_t)(row0 + t) * D + c4) = wv;
        if (pos >= Tseq - 15) *(f32x4*)(pout + ((size_t)seq * 15 + (pos - (Tseq - 15))) * D + c4) = x;
        Sw = Sw - xn[t]; }
}

#define XB_TMO      128
#define XB_XCNT(j)  (256  + 64 * (j))
#define XB_XSUB(j)  (1280 + 64 * (j))
#define XB_XGEN(j)  (2304 + 64 * (j))
#define XB_TOP      3328
#define XB_TOPGEN   3392
#define XCD_BAR_WORDS 3456
#define XB_SPIN_CAP (1u << 18)

__device__ __forceinline__ unsigned xb_ld(unsigned* p)              { return __hip_atomic_load(p, __ATOMIC_RELAXED, __HIP_MEMORY_SCOPE_AGENT); }
__device__ __forceinline__ unsigned xb_add(unsigned* p, unsigned v) { return __hip_atomic_fetch_add(p, v, __ATOMIC_RELAXED, __HIP_MEMORY_SCOPE_AGENT); }
__device__ __forceinline__ unsigned xb_xcc_id() { return (unsigned)__builtin_amdgcn_s_getreg((3 << 11) | 20) & 0xFu; }
#define XB_SPIN(cond, bar) do { unsigned _sp = 0; while (cond) { __builtin_amdgcn_s_sleep(1); \
    if ((++_sp & 255u) == 0u) { if (xb_ld(&(bar)[XB_TMO])) break; if (_sp > XB_SPIN_CAP) { atomicAdd(&(bar)[XB_TMO], 1u); break; } } } } while (0)

struct XcdBarrier {
    unsigned* bar; unsigned x;
    volatile LAS unsigned* st;
};

__device__ __forceinline__ XcdBarrier xcd_barrier_post(unsigned* bar, volatile LAS unsigned* st) {
    XcdBarrier b; b.bar = bar; b.x = xb_xcc_id(); b.st = st;
    if (threadIdx.x == 0) (void)xb_add(&bar[XB_XCNT(b.x)], 1u);
    return b;
}
__device__ __forceinline__ void xcd_barrier_complete(unsigned* bar, unsigned x, unsigned& nloc, unsigned& nx) {
    const unsigned G = gridDim.x * gridDim.y * gridDim.z;
    unsigned sum, cnt, mine, sp = 0u;
    for (;;) {
        sum = 0u; cnt = 0u; mine = 0u;
#pragma unroll
        for (unsigned j = 0; j < 16; ++j) { const unsigned c = xb_ld(&bar[XB_XCNT(j)]); sum += c; cnt += (c > 0u) ? 1u : 0u; mine = (j == x) ? c : mine; }
        if (sum == G) break;
        __builtin_amdgcn_s_sleep(1);
        if ((++sp & 255u) == 0u) { if (xb_ld(&bar[XB_TMO])) break; if (sp > XB_SPIN_CAP) { atomicAdd(&bar[XB_TMO], 1u); break; } }
    }
    nloc = mine > 0u ? mine : 1u; nx = cnt > 0u ? cnt : 1u;
}

__device__ __forceinline__ void xcd_barrier(const XcdBarrier& b) {
    asm volatile("s_waitcnt vmcnt(0)" ::: "memory");
    __syncthreads();
    if (threadIdx.x == 0) {
        unsigned* bar = b.bar;
        __builtin_amdgcn_s_waitcnt(0);
        unsigned nloc = b.st[0], nx = b.st[1];
        if (nloc == 0u) { xcd_barrier_complete(bar, b.x, nloc, nx); b.st[0] = nloc; b.st[1] = nx; }
        const unsigned old = xb_add(&bar[XB_XSUB(b.x)], 1u);
        const unsigned gen = old / nloc;
        if (old + 1u == (gen + 1u) * nloc) {
            __builtin_amdgcn_fence(__ATOMIC_RELEASE, "agent");
            asm volatile("s_waitcnt vmcnt(0)" ::: "memory");
            const unsigned og = xb_add(&bar[XB_TOP], 1u);
            const unsigned tg = og / nx;
            if (og + 1u == (tg + 1u) * nx) xb_add(&bar[XB_TOPGEN], 1u);
            else XB_SPIN(xb_ld(&bar[XB_TOPGEN]) == tg, bar);
            __builtin_amdgcn_fence(__ATOMIC_ACQUIRE, "agent");
            xb_add(&bar[XB_XGEN(b.x)], 1u);
            asm volatile("s_waitcnt vmcnt(0)" ::: "memory");
        } else {
            XB_SPIN(xb_ld(&bar[XB_XGEN(b.x)]) == gen, bar);
            __builtin_amdgcn_fence(__ATOMIC_ACQUIRE, "agent");
            asm volatile("s_waitcnt vmcnt(0)" ::: "memory");
        }
    }
    __syncthreads();
}


#ifndef SKIPMASK
#define SKIPMASK 0
#endif
#define PH(n) if (!((SKIPMASK >> (n)) & 1))
__global__ void __launch_bounds__(512, 2) fwd_kernel(Args a) {
    extern __shared__ __attribute__((aligned(16))) unsigned char lds[];
    cg::grid_group grid = cg::this_grid();
    PG8_LAS unsigned char* L = (PG8_LAS unsigned char*)lds;
    const int tid = threadIdx.x, lane = tid & 63, wave = __builtin_amdgcn_readfirstlane(tid >> 6);
    const int G = gridDim.x, bx = blockIdx.x;
    const int gw = bx * 8 + wave, NGW = G * 8; const int gt = bx * 512 + tid, NGT = G * 512;
    float* const out = a.out;
    volatile LAS unsigned* bst = (volatile LAS unsigned*)(L + 131072 + 64);
    if (tid < 4) bst[tid] = 0u;
    __syncthreads();
    const XcdBarrier xbar = xcd_barrier_post((unsigned*)(a.ws + WS_BAR), bst);
#define ws (a.ws)
#define SSQ ((float*)(ws + WS_SSQ))
#define SUMA ((float*)(ws + WS_SUM))
#define SUMH (SUMA + 512 * 512)
#define SPL ((float*)(ws + WS_SPL))
#define WIN ((bf16_t*)(ws + WS_WIN))
#define WG ((bf16_t*)(ws + WS_WG))
#define WOUT ((bf16_t*)(ws + WS_WOUT))
#define WGU ((bf16_t*)(ws + WS_WGU))
#define WD ((bf16_t*)(ws + WS_WD))
#define WP ((bf16_t*)(ws + WS_WP))
#define XB ((bf16_t*)(ws + WS_XB))
#define QB ((bf16_t*)(ws + WS_QB))
#define GG ((bf16_t*)(ws + WS_GG))
#define UCB ((bf16_t*)(ws + WS_UCB))
#define KB ((bf16_t*)(ws + WS_KB))
#define VT ((bf16_t*)(ws + WS_VT))
#define U ((bf16_t*)(ws + WS_U))
#define AX ((unsigned*)(ws + WS_AA))
#define AO ((bf16_t*)(ws + WS_AO))
#define H ((bf16_t*)(ws + WS_H))
#define PART ((float*)(ws + WS_PART))

    PH(0)
    {
        for (int i = gt; i < 4 * M; i += NGT) SSQ[i] = 0.f;
        if (gt < 512) SPL[gt] = -8.f * log1pf(expf(-a.in[I_LAM][gt]));
        LAS float* scr = (LAS float*)(L + wave * 16384);
        constexpr int IT_WIN = 16 * 80, IT_WOUT = 16 * 32, IT_WGU = 16 * 176, IT_WD = 44 * 32, IT_WP = 4 * 8;
        constexpr int NITEMS = IT_WIN + IT_WOUT + 2 * IT_WGU + 2 * IT_WD + 4 * IT_WP;
        for (int it = gw; it < NITEMS; it += NGW) {
            int r = it;
            if (r >= IT_WIN + IT_WOUT) break;
            if (r < IT_WIN) { const int kb = r / 80, nb = r % 80; transpose_tile(a.in[I_WIN], NIN, nb * 32, kb * 64, a.in[I_NM], WIN, D, nb * 32, scr, lane); continue; } r -= IT_WIN;
            if (r < IT_WOUT) { const int kb = r / 32, nb = r % 32; transpose_tile(a.in[I_WOUT], D, nb * 32, kb * 64, nullptr, WOUT, D, nb * 32, scr, lane); continue; } r -= IT_WOUT;
            if (r < 2 * IT_WGU) { const int l = r / IT_WGU; r -= l * IT_WGU; const int kb = r / 176, nb = r % 176; const int n0 = nb * 32;
                const float* src = ((n0 & 128) ? a.in[I_FU] : a.in[I_FG]) + (size_t)l * D * FF; const int sc0 = (n0 >> 8) * 128 + (n0 & 127);
                transpose_tile(src, FF, sc0, kb * 64, a.in[I_NF] + l * D, WGU + (size_t)l * NGU * D, D, n0, scr, lane); continue; } r -= 2 * IT_WGU;
            if (r < 2 * IT_WD) { const int l = r / IT_WD; r -= l * IT_WD; const int kb = r / 32, nb = r % 32;
                transpose_tile(a.in[I_FD] + (size_t)l * FF * D, D, nb * 32, kb * 64, nullptr, WD + (size_t)l * D * FF, FF, nb * 32, scr, lane); continue; } r -= 2 * IT_WD;
            { const int g = r / IT_WP; r -= g * IT_WP; const int kb = r / 8, nb = r % 8;
                transpose_tile(a.in[I_PW] + (size_t)g * 256 * 256, 256, nb * 32, kb * 64, nullptr, WP, 256, g * 256 + nb * 32, scr, lane, a.in[I_PS]); }
        }
        for (int i = gt; i < 1024 * 128; i += NGT) { const int np = i >> 7, kk = i & 127; const int pn = np >> 8, bj = (np >> 7) & 1, j = np & 127; const int c = 128 * pn + j, cin = 128 * pn + kk;
            float v = 0.f; if ((cin >> 6) == (c >> 6)) v = (bj ? a.in[I_IGW] : a.in[I_RGW])[(size_t)(c >> 6) * 4096 + (cin & 63) * 64 + (c & 63)];
            WG[i] = (bf16_t)(cvt_pk_bf16(v, 0.f) & 0xffffu); }
        for (int m0 = gw; m0 < M; m0 += 2 * NGW) { const int m1 = m0 + NGW; const bool has1 = m1 < M;
            const float* xr0 = (m0 < MP) ? a.in[I_XP] + (size_t)m0 * D : a.in[I_XS] + (size_t)(m0 - MP) * D;
            const float* xr1 = has1 ? ((m1 < MP) ? a.in[I_XP] + (size_t)m1 * D : a.in[I_XS] + (size_t)(m1 - MP) * D) : xr0;
            f32x4 v0[4], v1[4]; float s0 = 0.f, s1 = 0.f;
#pragma unroll
            for (int j = 0; j < 4; ++j) { v0[j] = __builtin_nontemporal_load((const f32x4*)xr0 + lane + 64 * j); v1[j] = __builtin_nontemporal_load((const f32x4*)xr1 + lane + 64 * j); }
#pragma unroll
            for (int j = 0; j < 4; ++j) { s0 += (v0[j][0] * v0[j][0] + v0[j][1] * v0[j][1]) + (v0[j][2] * v0[j][2] + v0[j][3] * v0[j][3]); s1 += (v1[j][0] * v1[j][0] + v1[j][1] * v1[j][1]) + (v1[j][2] * v1[j][2] + v1[j][3] * v1[j][3]); }
            const float rs0 = rsqrtf(wave_sum(s0) * (1.f / D) + EPS), rs1 = rsqrtf(wave_sum(s1) * (1.f / D) + EPS);
#pragma unroll
            for (int j = 0; j < 4; ++j) { u32x2 w; w.x = cvt_pk_bf16(v0[j][0] * rs0, v0[j][1] * rs0); w.y = cvt_pk_bf16(v0[j][2] * rs0, v0[j][3] * rs0); ((u32x2*)(XB + (size_t)m0 * D))[lane + 64 * j] = w; }
            if (has1) {
#pragma unroll
                for (int j = 0; j < 4; ++j) { u32x2 w; w.x = cvt_pk_bf16(v1[j][0] * rs1, v1[j][1] * rs1); w.y = cvt_pk_bf16(v1[j][2] * rs1, v1[j][3] * rs1); ((u32x2*)(XB + (size_t)m1 * D))[lane + 64 * j] = w; } } }
    }
    xcd_barrier(xbar);
    if (a.out == nullptr) grid.sync();
    pg8::StaticOrder S;
    PH(1)
    { pg8::Gemm g{XB, WIN, M, NIN, D, D, 0}; pg8::G1Order S1; S1.init(G, bx); EpiG1 E{QB, GG, U, out, KB, VT}; pg8::gemm_phase(L, g, S1, E); }
    xcd_barrier(xbar);
    PH(2)
    { const float* cw = a.in[I_CW]; const float* cbias = a.in[I_CB]; S.init(M, 1024, G, bx);
      for (int i = 0; ; ++i) { pg8::Unit tu; if (!S.next(i, tu)) break;
        for (int item = tid; item < 32 * 32; item += 512) { const int c4 = tu.pn * 128 + (item & 31) * 4; const int row0 = tu.pm * 256 + (item >> 5) * 8;
            int pos0, T, seq; const bool samp = row0 >= MP; if (!samp) { pos0 = row0 & 4095; T = 4096; seq = row0 >> 12; } else { pos0 = (row0 - MP) & 31; T = 32; seq = (row0 - MP) >> 5; }
            f32x4 uu[11];
#pragma unroll
            for (int j = 0; j < 11; ++j) { const int p = pos0 - 3 + j;
                if (p >= 0) uu[j] = bf4(*(const u32x2*)(U + (size_t)(row0 - 3 + j) * 512 + c4));
                else if (samp) uu[j] = *(const f32x4*)(a.in[I_LC] + ((size_t)seq * 3 + (3 + p)) * 512 + c4);
                else uu[j] = (f32x4){0.f, 0.f, 0.f, 0.f}; }
            const f32x4 cb4 = *(const f32x4*)(cbias + c4), w0 = *(const f32x4*)(cw + c4), w1 = *(const f32x4*)(cw + 512 + c4), w2 = *(const f32x4*)(cw + 1024 + c4), w3 = *(const f32x4*)(cw + 1536 + c4);
#pragma unroll
            for (int t = 0; t < 8; ++t) { const f32x4 accv = cb4 + uu[t] * w0 + uu[t + 1] * w1 + uu[t + 2] * w2 + uu[t + 3] * w3;
                u32x2 w; w.x = cvt_pk_bf16(accv[0], accv[1]); w.y = cvt_pk_bf16(accv[2], accv[3]); *(u32x2*)(UCB + (size_t)(row0 + t) * 512 + c4) = w;
                if (pos0 + t >= T - 3) *(f32x4*)(out + (samp ? OFF_CS : OFF_CP) + ((size_t)seq * 3 + (pos0 + t - (T - 3))) * 512 + c4) = uu[t + 3]; } } }
      asm volatile("s_waitcnt vmcnt(0)" ::: "memory"); __syncthreads(); }
    PH(3)
    { pg8::Gemm g{UCB, WG, M, 1024, 128, 512, 128}; S.init(M, 1024, G, bx); EpiGate E{a.in[I_RGB], a.in[I_IGB], SPL, UCB, AX}; pg8::gemm_phase(L, g, S, E); }
    PH(4)
    for (int i = 0; ; ++i) { pg8::Unit tu; if (!S.next(i, tu)) break; if (tu.pm >= 128) continue;
        const int chunk = 4 * tu.pm + (wave >> 1), c = (2 * tu.pn + (wave & 1)) * 64 + lane; const size_t base = (size_t)chunk * 64 * 512 + c;
        float hl = 0.f, ap = 1.f;
#pragma unroll 32
        for (int t = 0; t < 64; ++t) { const unsigned pk = AX[base + (size_t)t * 512]; const float av = 1.f - __uint_as_float(pk << 16), xv = __uint_as_float(pk & 0xffff0000u); hl = av * hl + xv; ap *= av; }
        SUMA[chunk * 512 + c] = ap; SUMH[chunk * 512 + c] = hl; }
    PH(3)
    { pg8::Gemm g{XB, WIN, M, NIN, D, D, 0}; pg8::G1Tail S2; S2.init(G, bx); EpiG1 E{QB, GG, U, out, KB, VT}; pg8::gemm_phase(L, g, S2, E); }
    PH(14) { unsigned* actr = (unsigned*)(ws + WS_BAR) + 3584;
        unsigned u = (unsigned)gw;
        while (u < 1056u * 8u) {
            unsigned nx = 0; if (lane == 0) nx = atomicAdd(actr, 1u) + (unsigned)NGW;
            if (u < 256u) { const int uu = (int)(8192u + u); attn_unit<false>(a, QB, AO, KB, VT, uu >> 3, uu & 7, lane); } else { const int uu = (int)(u - 256u); attn_unit<true>(a, QB, AO, KB, VT, uu >> 3, uu & 7, lane); }
            u = (unsigned)__builtin_amdgcn_readfirstlane((int)nx); } }
    xcd_barrier(xbar);
    PH(5)
    for (int u = gw; u < 512 * 8 + 32 * 8; u += NGW) {
        const bool samp = u >= 4096; int row0, nt, c; float hcur; bool lastc; float* hout;
        if (!samp) { const int chunk = u >> 3; c = (u & 7) * 64 + lane; const int b = chunk >> 6, ci = chunk & 63; row0 = chunk * 64; nt = 64; hcur = 0.f;
            for (int j0 = 0; j0 < ci; j0 += 8) { float sa[8], sh[8];
#pragma unroll
                for (int k = 0; k < 8; ++k) { const bool ok = (j0 + k) < ci; const int jj = ok ? (j0 + k) : j0; sa[k] = SUMA[(b * 64 + jj) * 512 + c]; sh[k] = SUMH[(b * 64 + jj) * 512 + c]; if (!ok) { sa[k] = 1.f; sh[k] = 0.f; } }
#pragma unroll
                for (int k = 0; k < 8; ++k) hcur = sa[k] * hcur + sh[k]; }
            lastc = (ci == 63); hout = out + OFF_HP + b * 512 + c; }
        else { const int v = u - 4096; const int bs = v >> 3; c = (v & 7) * 64 + lane; row0 = MP + bs * 32; nt = 32; hcur = a.in[I_LH][bs * 512 + c]; lastc = true; hout = out + OFF_HS + bs * 512 + c; }
        const size_t base = (size_t)row0 * 512 + c;
        for (int t0 = 0; t0 < nt; t0 += 32) { unsigned pk[32]; bf16_t gg[32];
#pragma unroll
            for (int k = 0; k < 32; ++k) { pk[k] = __builtin_nontemporal_load(AX + base + (size_t)(t0 + k) * 512); gg[k] = __builtin_nontemporal_load(GG + base + (size_t)(t0 + k) * 512); }
#pragma unroll
            for (int k = 0; k < 32; ++k) { const float av = 1.f - __uint_as_float(pk[k] << 16), xv = __uint_as_float(pk[k] & 0xffff0000u); hcur = av * hcur + xv;
                AO[(size_t)(row0 + t0 + k) * D + 512 + c] = (bf16_t)(cvt_pk_bf16(hcur * bf2f(gg[k]), 0.f) & 0xffffu); } }
        if (lastc) *hout = hcur; }
    xcd_barrier(xbar);
    PH(6)
    { pg8::Gemm g{AO, WOUT, M, D, D, D, 0}; S.init(M, D, G, bx); EpiRes<true> E{a.in[I_XP], a.in[I_XS], XB, SSQ, nullptr}; pg8::gemm_phase(L, g, S, E); }
    PH(6)
    { const int rem = (M / 256 * (D / 256)) % G; const int b0 = rem; const int nblk = G - b0;
      if (bx >= b0) { LAS float* scr = (LAS float*)(L + wave * 16384); const int dw = (bx - b0) * 8 + wave, NDW = nblk * 8;
        constexpr int IT_WGU = 16 * 176, IT_WD = 44 * 32, IT_WP = 4 * 8;
        for (int it = dw; it < IT_WGU + IT_WD + 4 * IT_WP; it += NDW) {
            int r = it;
            if (r < IT_WGU) { const int kb = r / 176, nb = r % 176; const int n0 = nb * 32;
                const float* src = (n0 & 128) ? a.in[I_FU] : a.in[I_FG]; const int sc0 = (n0 >> 8) * 128 + (n0 & 127);
                transpose_tile(src, FF, sc0, kb * 64, a.in[I_NF], WGU, D, n0, scr, lane); continue; } r -= IT_WGU;
            if (r < IT_WD) { const int kb = r / 32, nb = r % 32; transpose_tile(a.in[I_FD], D, nb * 32, kb * 64, nullptr, WD, FF, nb * 32, scr, lane); continue; } r -= IT_WD;
            { const int g = r / IT_WP; r -= g * IT_WP; const int kb = r / 8, nb = r % 8;
                transpose_tile(a.in[I_PW] + (size_t)g * 256 * 256, 256, nb * 32, kb * 64, nullptr, WP, 256, g * 256 + nb * 32, scr, lane, a.in[I_PS]); }
        } } }
    xcd_barrier(xbar);
    PH(7)
    { pg8::Gemm g{XB, WGU, M, NGU, D, D, 0}; S.init(M, NGU, G, bx); EpiSwiglu E{SSQ, H}; pg8::gemm_phase(L, g, S, E); }
    PH(7)
    { const int rem = (M / 256 * (NGU / 256)) % G; const int b0 = rem; const int nblk = G - b0;
      if (bx >= b0) { LAS float* scr = (LAS float*)(L + wave * 16384); const int dw = (bx - b0) * 8 + wave, NDW = nblk * 8;
        constexpr int IT_WGU = 16 * 176, IT_WD = 44 * 32;
        for (int it = dw; it < IT_WGU + IT_WD; it += NDW) {
            int r = it;
            if (r < IT_WGU) { const int kb = r / 176, nb = r % 176; const int n0 = nb * 32;
                const float* src = ((n0 & 128) ? a.in[I_FU] : a.in[I_FG]) + (size_t)D * FF; const int sc0 = (n0 >> 8) * 128 + (n0 & 127);
                transpose_tile(src, FF, sc0, kb * 64, a.in[I_NF] + D, WGU + (size_t)NGU * D, D, n0, scr, lane); continue; } r -= IT_WGU;
            { const int kb = r / 32, nb = r % 32; transpose_tile(a.in[I_FD] + (size_t)FF * D, D, nb * 32, kb * 64, nullptr, WD + (size_t)D * FF, FF, nb * 32, scr, lane); }
        } } }
    xcd_barrier(xbar);
    PH(8)
    { pg8::Gemm g{H, WD, M, D, FF, FF, 0}; pg8::TailOrder ST; ST.init(FF, G, bx); EpiRes<false, true> E{nullptr, nullptr, XB, SSQ + M, PART}; pg8::gemm_phase(L, g, ST, E); }
    xcd_barrier(xbar);
    PH(9)
    {
        const float* ssq2 = SSQ + M; const float* gm = a.in[I_NM] + D; const float* pbuf = a.in[I_SP]; const LAS float* ldsrs = (const LAS float*)L;
        for (int idx = gt; idx < (MP / PR) * 256; idx += NGT) { const int strip = idx >> 8, c4 = (idx & 255) * 4; const int row0 = strip * PR, pos0 = row0 & 4095, seq = row0 >> 12;
            switch (c4 >> 8) {
                case 0: pool_strip<2, false>(XB, AO, out + OFF_PP, ssq2, ldsrs, pbuf, gm, row0, pos0, seq, 4096, c4); break;
                case 1: pool_strip<4, false>(XB, AO, out + OFF_PP, ssq2, ldsrs, pbuf, gm, row0, pos0, seq, 4096, c4); break;
                case 2: pool_strip<8, false>(XB, AO, out + OFF_PP, ssq2, ldsrs, pbuf, gm, row0, pos0, seq, 4096, c4); break;
                default: pool_strip<16, false>(XB, AO, out + OFF_PP, ssq2, ldsrs, pbuf, gm, row0, pos0, seq, 4096, c4); break; } }
        for (int sidx = bx; sidx < 32; sidx += G) {
            __syncthreads();
#pragma unroll
            for (int j = 0; j < 4; ++j) { const int r = wave * 4 + j; u32x2* xr = (u32x2*)(XB + (size_t)(MP + sidx * 32 + r) * D); const f32x4* pr = (const f32x4*)(PART + (size_t)(sidx * 32 + r) * D); float sq = 0.f;
#pragma unroll
                for (int q = 0; q < 4; ++q) { f32x4 v = bf4(xr[lane + 64 * q]);
#pragma unroll
                    for (int ks = 0; ks < 11; ++ks) v = v + pr[(size_t)ks * (MS * D / 4) + lane + 64 * q];
                    u32x2 wv; wv.x = cvt_pk_bf16(v[0], v[1]); wv.y = cvt_pk_bf16(v[2], v[3]); xr[lane + 64 * q] = wv; sq += (v[0] * v[0] + v[1] * v[1]) + (v[2] * v[2] + v[3] * v[3]); }
                sq = wave_sum(sq); if (lane == 0) ((LAS float*)L)[r] = rsqrtf(sq * (1.f / D) + EPS); }
            asm volatile("s_waitcnt vmcnt(0)" ::: "memory"); __threadfence_block(); __syncthreads();
            const int c4 = (tid & 255) * 4, half = tid >> 8;
            for (int sub = 0; sub < 16 / PR; ++sub) { const int pos0 = half * 16 + sub * PR, row0 = MP + sidx * 32 + pos0;
            switch (c4 >> 8) {
                case 0: pool_strip<2, true>(XB, AO, out + OFF_PS, ssq2, ldsrs, pbuf, gm, row0, pos0, sidx, 32, c4); break;
                case 1: pool_strip<4, true>(XB, AO, out + OFF_PS, ssq2, ldsrs, pbuf, gm, row0, pos0, sidx, 32, c4); break;
                case 2: pool_strip<8, true>(XB, AO, out + OFF_PS, ssq2, ldsrs, pbuf, gm, row0, pos0, sidx, 32, c4); break;
                default: pool_strip<16, true>(XB, AO, out + OFF_PS, ssq2, ldsrs, pbuf, gm, row0, pos0, sidx, 32, c4); break; } } }
    }
    xcd_barrier(xbar);
    PH(10)
    { pg8::Gemm g{AO  , WP, M, D, 256, D, 256}; S.init(M, D, G, bx); EpiRes<false> E{nullptr, nullptr, XB, SSQ + 2 * M, nullptr}; pg8::gemm_phase(L, g, S, E); }
    xcd_barrier(xbar);
    PH(11)
    { pg8::Gemm g{XB, WGU + (size_t)NGU * D, M, NGU, D, D, 0}; S.init(M, NGU, G, bx); EpiSwiglu E{SSQ + 2 * M, H}; pg8::gemm_phase(L, g, S, E); }
    xcd_barrier(xbar);
    PH(12)
    { pg8::Gemm g{H, WD + (size_t)D * FF, M, D, FF, FF, 0}; pg8::TailOrder ST; ST.init(FF, G, bx); EpiRes<false, true> E{nullptr, nullptr, XB, SSQ + 3 * M, PART}; pg8::gemm_phase(L, g, ST, E); }
    xcd_barrier(xbar);
    PH(13)
    { const float* ssq4 = SSQ + 3 * M; const f32x4* gf = (const f32x4*)a.in[I_NFIN];
      for (int m0 = gw; m0 < M; m0 += 2 * NGW) {
          const int m1 = (m0 + NGW < M) ? m0 + NGW : m0; const bool has1 = m0 + NGW < M;
          const u32x2* p0 = (const u32x2*)(XB + (size_t)m0 * D); const u32x2* p1 = (const u32x2*)(XB + (size_t)m1 * D); u32x2 r0[4], r1[4];
#pragma unroll
          for (int q = 0; q < 4; ++q) { r0[q] = __builtin_nontemporal_load(p0 + lane + 64 * q); r1[q] = __builtin_nontemporal_load(p1 + lane + 64 * q); }
#pragma unroll
          for (int rr = 0; rr < 2; ++rr) { if (rr == 1 && !has1) break; const int m = rr ? m1 : m0; f32x4 v[4]; float sq = 0.f;
#pragma unroll
              for (int q = 0; q < 4; ++q) v[q] = bf4(rr ? r1[q] : r0[q]);
              if (m >= MP) { const f32x4* pr = (const f32x4*)(PART + (size_t)(m - MP) * D);
#pragma unroll
                  for (int ks = 0; ks < 11; ++ks)
#pragma unroll
                      for (int q = 0; q < 4; ++q) v[q] = v[q] + pr[(size_t)ks * (MS * D / 4) + lane + 64 * q]; }
#pragma unroll
              for (int q = 0; q < 4; ++q) sq += (v[q][0] * v[q][0] + v[q][1] * v[q][1]) + (v[q][2] * v[q][2] + v[q][3] * v[q][3]);
              const float ss = (m >= MP) ? wave_sum(sq) : ssq4[m]; const float rs = rsqrtf(ss * (1.f / D) + EPS);
              f32x4* yo = (f32x4*)(out + OFF_Y + (size_t)m * D);
#pragma unroll
              for (int q = 0; q < 4; ++q) __builtin_nontemporal_store(v[q] * rs * gf[lane + 64 * q], yo + lane + 64 * q); } } }
}

#undef ws
#undef SSQ
#undef SUMA
#undef SUMH
#undef KB
#undef VT
#undef PART
#undef SPL
#undef WIN
#undef WG
#undef WOUT
#undef WGU
#undef WD
#undef WP
#undef XB
#undef QB
#undef GG
#undef UCB
#undef U
#undef AX
#undef AO
#undef H
extern "C" void kernel_launch(void* const* d_in, const int* in_sizes, int n_in, void* d_out, int out_size, void* d_ws, size_t ws_size, hipStream_t stream) {
    static int grid = 0;
    if (grid == 0) {
        if (n_in != 24 || out_size != (int)OUT_TOTAL || ws_size < WS_END) { fprintf(stderr, "kernel_launch: unexpected shapes (n_in %d out %d ws %zu)\n", n_in, out_size, ws_size); grid = -1; return; }
        int dev = 0, cus = 0, per_cu = 0;
        hipGetDevice(&dev); hipDeviceGetAttribute(&cus, hipDeviceAttributeMultiprocessorCount, dev);
        hipFuncSetAttribute((const void*)fwd_kernel, hipFuncAttributeMaxDynamicSharedMemorySize, LDS_BYTES);
        hipOccupancyMaxActiveBlocksPerMultiprocessor(&per_cu, (const void*)fwd_kernel, 512, LDS_BYTES);
        if (per_cu < 1) { fprintf(stderr, "kernel_launch: occupancy query says %d blocks/CU\n", per_cu); per_cu = 1; }
        (void)hipGetLastError();
        grid = cus * per_cu;
    }
    if (grid < 0) return;
    (void)hipMemsetAsync((char*)d_ws + WS_BAR, 0, 16384, stream);
    Args a{};
    for (int i = 0; i < 24; ++i) a.in[i] = (const float*)d_in[i];
    a.out = (float*)d_out; a.ws = (unsigned char*)d_ws;
    void* params[] = {&a};
    hipError_t e = hipLaunchCooperativeKernel((const void*)fwd_kernel, dim3(grid), dim3(512), params, LDS_BYTES, stream);
    if (e != hipSuccess) fprintf(stderr, "cooperative launch failed: %s (grid %d)\n", hipGetErrorString(e), grid);
}
```

```cpp
#include <hip/hip_runtime.h>
#include <hip/hip_cooperative_groups.h>
#include <cstdio>
#include <cstdint>
namespace cg = cooperative_groups;

constexpr int MP = 32768;
constexpr int MS = 1024;
constexpr int M = MP + MS;
constexpr int D = 1024, NIN = 2560, FF = 2816, NGU = 2 * FF;
constexpr float EPS = 1e-6f;
constexpr size_t OFF_Y = 0, OFF_KP = 34603008, OFF_VP = 51380224, OFF_HP = 68157440, OFF_CP = 68161536, OFF_PP = 68173824,
                 OFF_KS = 68296704, OFF_VS = 68820992, OFF_HS = 69345280, OFF_CS = 69361664, OFF_PS = 69410816, OUT_TOTAL = 69902336;
constexpr size_t MiB = 1u << 20;
constexpr size_t WS_SSQ = 0, WS_SUM = 1 * MiB, WS_SPL = 3 * MiB, WS_BAR = 3 * MiB + 512 * 1024, WS_WIN = 4 * MiB, WS_WG = 9 * MiB, WS_WOUT = 10 * MiB, WS_WGU = 12 * MiB, WS_WD = 34 * MiB, WS_WP = 45 * MiB,
                 WS_XB = 48 * MiB, WS_QB = 114 * MiB, WS_GG = 147 * MiB, WS_UCB = 180 * MiB, WS_U = 213 * MiB, WS_UC = 279 * MiB, WS_KB = 279 * MiB  , WS_VT = 312 * MiB  , WS_AA = 345 * MiB, WS_XIN = 411 * MiB,
                 WS_AO = 477 * MiB, WS_H = 213 * MiB  , WS_PART = 543 * MiB  , WS_END = 587 * MiB;
static_assert(WS_H + (size_t)M * FF * 2 <= WS_AO, "H overlay");
constexpr int LDS_BYTES = 147456;

namespace pg8 {
#define PG8_LAS __attribute__((address_space(3)))
typedef unsigned short bf16_t;
typedef short bf16x8 __attribute__((ext_vector_type(8)));
typedef float f32x4 __attribute__((ext_vector_type(4)));
typedef unsigned u32x4 __attribute__((ext_vector_type(4)));
typedef unsigned u32x2 __attribute__((ext_vector_type(2)));
constexpr int BM = 256, BK = 64, HALF = 128, HTB = HALF * BK * 2, STAGE_BYTES = 8 * HTB, NXCD = 8, WGM = 8;

__host__ __device__ __forceinline__ int lds_byte(int r, int c) { const int st = (r >> 4) * 2 + (c >> 5), rr = r & 15, cc = c & 31, ob = rr * 64 + cc * 2; return st * 1024 + (ob ^ (((ob >> 9) & 1) << 5)); }
__host__ __device__ __forceinline__ void stage_rc(int b, int& R, int& C) { const int st = b / 1024, sb = b % 1024, swz = sb ^ (((sb >> 9) & 1) << 5); R = (st >> 1) * 16 + swz / 64; C = (st & 1) * 32 + (swz % 64) / 2; }
__host__ __device__ __forceinline__ int perm32(int rho) { const int n = rho >> 4, i = rho & 15; return 8 * (i >> 2) + 4 * n + (i & 3); }

struct Unit { int pm, pn, kb, nk; };
struct Gemm { const bf16_t* A; const bf16_t* Bt; int M, N, K, lda, acs; };

__device__ __forceinline__ bool static_tile(int i, int nM, int nN, int G, int c, int& pm, int& pn) {
    const int nwg = nM * nN; const long Lx = (long)i * G + c; if (Lx >= nwg) return false;
    int wgid = (int)Lx; { const int q = nwg / NXCD, r = nwg % NXCD, xcd = wgid % NXCD, off = wgid / NXCD; wgid = (xcd < r ? xcd * (q + 1) : r * (q + 1) + (xcd - r) * q) + off; }
    const int nig = WGM * nN, gid = wgid / nig, fm = gid * WGM, gsz = (nM - fm) < WGM ? (nM - fm) : WGM;
    pm = fm + ((wgid % nig) % gsz); pn = (wgid % nig) / gsz; return true;
}
struct StaticOrder {
    static constexpr bool SPLIT = false;
    int nM, nN, G, c;
    __device__ __forceinline__ void init(int M_, int N_, int G_, int c_) { nM = M_ / BM; nN = N_ / BM; G = G_; c = c_; }
    __device__ __forceinline__ bool next(int i, Unit& u) const { u.kb = 0; u.nk = 0; return static_tile(i, nM, nN, G, c, u.pm, u.pn); }
};

struct G1Order {
    static constexpr bool SPLIT = false;
    int G, c;
    __device__ __forceinline__ void init(int G_, int c_) { G = G_; c = c_; }
    __device__ __forceinline__ bool next(int i, Unit& u) const { u.kb = 0; u.nk = 0; const int Lx = i * G + c; if (Lx >= 1280) return false;
        if (Lx < 1056) { static_tile(0, 132, 8, 0, Lx, u.pm, u.pn); return true; }
        const int idx = Lx - 1056; u.pm = idx >> 1; u.pn = 8 + (idx & 1); return true; }
};
struct G1Tail {
    static constexpr bool SPLIT = false;
    int G, c;
    __device__ __forceinline__ void init(int G_, int c_) { G = G_; c = c_; }
    __device__ __forceinline__ bool next(int i, Unit& u) const { u.kb = 0; u.nk = 0; const int idx = i * G + ((c + G - 16) % G); if (idx >= 40) return false;
        u.pm = 112 + (idx >> 1); u.pn = 8 + (idx & 1); return true; }
};

struct TailOrder {
    static constexpr bool SPLIT = true;
    int G, c, nm, nkfull;
    __device__ __forceinline__ void init(int K_, int G_, int c_) { G = G_; c = c_; nm = (c_ < 512) ? (512 - c_ + G_ - 1) / G_ : 0; nkfull = K_ / BK; }
    __device__ __forceinline__ bool next(int i, Unit& u) const {
        if (i < nm) { static_tile(i, 128, 4, G, c, u.pm, u.pn); u.kb = 0; u.nk = nkfull; return true; }
        const int t = (i - nm) * G + c; if (t >= 16 * 11) return false;
        const int tile = t / 11, ks = t - tile * 11; u.pm = 128 + (tile >> 2); u.pn = tile & 3; u.kb = ks * 4; u.nk = 4; return true;
    }
};

__device__ __forceinline__ unsigned cvt_pk_bf16(float lo, float hi) { unsigned r; asm volatile("v_cvt_pk_bf16_f32 %0, %1, %2" : "=v"(r) : "v"(lo), "v"(hi)); return r; }

template <class Epi, class Sched>
__device__ __forceinline__ void gemm_phase(PG8_LAS unsigned char* lds, const Gemm g, const Sched& S, const Epi& E) {
    int tid = threadIdx.x; asm volatile("" : "+v"(tid));
    const int wid = __builtin_amdgcn_readfirstlane(tid >> 6), lane = tid & 63, wr = wid >> 2, wc = wid & 3, fr = lane & 15, fq = lane >> 4;
    int K = g.K; asm volatile("" : "+s"(K));
    const int ntfull = K / BK;
    unsigned voffA[2], voffB[2];
#pragma unroll
    for (int i = 0; i < 2; ++i) { int R, C; stage_rc(tid * 16 + i * 8192, R, C); const int Rb = (R & ~31) + perm32(R & 31);
        voffA[i] = (unsigned)(R * g.lda + C) * 2u; voffB[i] = (unsigned)(Rb * K + C) * 2u; }
    const size_t kstep = (size_t)(BK * 2);
    const size_t hstepA = (size_t)HALF * g.lda * 2, hstepB = (size_t)HALF * K * 2;
    const unsigned ldsw = (unsigned)wid * 1024u;
    const int aoff = lds_byte(wr * 64 + fr, fq * 8), boff = lds_byte(wc * 32 + fr, fq * 8);
#define PG8_TA(u) ((const char*)g.A + ((size_t)(u).pm * BM * g.lda + (size_t)(u).pn * g.acs) * 2 + (Sched::SPLIT ? (size_t)(u).kb * (BK * 2) : 0))
#define PG8_TB(u) ((const char*)g.Bt + (size_t)(u).pn * BM * K * 2 + (Sched::SPLIT ? (size_t)(u).kb * (BK * 2) : 0))
#define PG8_SA(b, h) (((b) * 2 + (h)) * HTB)
#define PG8_SB(b, h) ((4 + (b) * 2 + (h)) * HTB)
#define PG8_STAGE(bufoff, gbase, voff) do { _Pragma("unroll") for (int _i = 0; _i < 2; ++_i) \
        __builtin_amdgcn_global_load_lds((const unsigned*)((const char*)(gbase) + (voff)[_i]), (PG8_LAS unsigned*)(lds + (bufoff) + ldsw + _i * 8192), 16, 0, 0); } while (0)
#define PG8_LDA(dst, b, h) do { _Pragma("unroll") for (int m = 0; m < 4; ++m) _Pragma("unroll") for (int k = 0; k < 2; ++k) dst[m][k] = *(const PG8_LAS bf16x8*)(lds + PG8_SA(b, h) + aoff + m * 2048 + k * 1024); } while (0)
#define PG8_LDB(dst, b, h) do { _Pragma("unroll") for (int n = 0; n < 2; ++n) _Pragma("unroll") for (int k = 0; k < 2; ++k) dst[n][k] = *(const PG8_LAS bf16x8*)(lds + PG8_SB(b, h) + boff + n * 2048 + k * 1024); } while (0)
#define PG8_MMA(ai, bj, At, Bt) do { __builtin_amdgcn_s_setprio(1); _Pragma("unroll") for (int m = 0; m < 4; ++m) _Pragma("unroll") for (int n = 0; n < 2; ++n) _Pragma("unroll") for (int k = 0; k < 2; ++k) \
        acc[ai][bj][m][n] = __builtin_amdgcn_mfma_f32_16x16x32_bf16(Bt[n][k], At[m][k], acc[ai][bj][m][n], 0, 0, 0); __builtin_amdgcn_s_setprio(0); } while (0)
#define PG8_WAIT_V(n) asm volatile("s_waitcnt vmcnt(" #n ")" ::: "memory")
#define PG8_WAIT_L(n) asm volatile("s_waitcnt lgkmcnt(" #n ")" ::: "memory")
#define PG8_BAR __builtin_amdgcn_s_barrier()
#define PG8_SCHED __builtin_amdgcn_sched_barrier(0)
    Unit cur, nxt; int ui = 0;
    if (!S.next(0, cur)) return;
    f32x4 acc[2][2][4][2];
    E.init(acc, cur, wr, wc, fr, fq);
    bf16x8 At[4][2], B0[2][2], B1[2][2];
    const char* cA = PG8_TA(cur); const char* cB = PG8_TB(cur);
    PG8_STAGE(PG8_SB(0, 0), cB, voffB); PG8_STAGE(PG8_SB(0, 1), cB + hstepB, voffB); PG8_STAGE(PG8_SA(0, 0), cA, voffA); PG8_STAGE(PG8_SA(0, 1), cA + hstepA, voffA);
    if (wr == 1) PG8_BAR;
    PG8_WAIT_V(2); PG8_BAR;
    PG8_STAGE(PG8_SB(1, 0), cB + kstep, voffB); PG8_STAGE(PG8_SA(1, 0), cA + kstep, voffA); PG8_STAGE(PG8_SB(1, 1), cB + hstepB + kstep, voffB);
    PG8_WAIT_V(6); PG8_BAR;
    for (;;) {
        const bool has_next = S.next(ui + 1, nxt);
        const char* nA = has_next ? PG8_TA(nxt) : cA; const char* nB = has_next ? PG8_TB(nxt) : cB;
        const int nt = Sched::SPLIT ? cur.nk : ntfull;
        for (int t = 0; t < nt; t += 2) {
            const bool last = (t == nt - 2);
            const char* a1 = cA + (size_t)(t + 1) * kstep;
            const char* a2 = last ? nA : cA + (size_t)(t + 2) * kstep; const char* b2 = last ? nB : cB + (size_t)(t + 2) * kstep;
            const char* a3 = a2 + kstep; const char* b3 = b2 + kstep;
            PG8_LDB(B0, 0, 0); PG8_LDB(B1, 0, 1); PG8_SCHED; PG8_LDA(At, 0, 0); PG8_STAGE(PG8_SA(1, 1), a1 + hstepA, voffA);
            PG8_WAIT_V(8); PG8_WAIT_L(0); PG8_BAR; PG8_MMA(0, 0, At, B0); PG8_MMA(0, 1, At, B1); PG8_BAR; PG8_SCHED;
            PG8_LDA(At, 0, 1); PG8_STAGE(PG8_SB(0, 0), b2, voffB); PG8_STAGE(PG8_SB(0, 1), b2 + hstepB, voffB); PG8_STAGE(PG8_SA(0, 0), a2, voffA);
            PG8_WAIT_V(8); PG8_WAIT_L(0); PG8_BAR; PG8_MMA(1, 0, At, B0); PG8_MMA(1, 1, At, B1); PG8_BAR; PG8_SCHED;
            PG8_LDB(B0, 1, 0); PG8_LDB(B1, 1, 1); PG8_SCHED; PG8_LDA(At, 1, 0); PG8_STAGE(PG8_SA(0, 1), a2 + hstepA, voffA);
            PG8_WAIT_V(8); PG8_WAIT_L(0); PG8_BAR; PG8_MMA(0, 0, At, B0); PG8_MMA(0, 1, At, B1); PG8_BAR; PG8_SCHED;
            PG8_LDA(At, 1, 1); PG8_STAGE(PG8_SB(1, 0), b3, voffB); PG8_STAGE(PG8_SB(1, 1), b3 + hstepB, voffB); PG8_STAGE(PG8_SA(1, 0), a3, voffA);
            PG8_WAIT_V(8); PG8_WAIT_L(0); PG8_BAR; PG8_MMA(1, 0, At, B0); PG8_MMA(1, 1, At, B1); PG8_BAR; PG8_SCHED;
        }
        if (wr == 0) PG8_BAR;
        E(acc, cur, wr, wc, fr, fq);
        if (!has_next) break;
        E.init(acc, nxt, wr, wc, fr, fq);
        cur = nxt; cA = nA; cB = nB; ++ui;
        if (wr == 1) PG8_BAR;
    }
    PG8_WAIT_V(0);
    PG8_BAR;
#undef PG8_TA
#undef PG8_TB
#undef PG8_SA
#undef PG8_SB
#undef PG8_STAGE
#undef PG8_LDA
#undef PG8_LDB
#undef PG8_MMA
#undef PG8_WAIT_V
#undef PG8_WAIT_L
#undef PG8_BAR
#undef PG8_SCHED
}
}

using pg8::bf16_t; using pg8::bf16x8; using pg8::f32x4; using pg8::u32x4; using pg8::u32x2; using pg8::Unit; using pg8::cvt_pk_bf16;
typedef float f32x16 __attribute__((ext_vector_type(16)));
#define LAS __attribute__((address_space(3)))

__device__ __forceinline__ float bf2f(bf16_t v) { return __uint_as_float((unsigned)v << 16); }
__device__ __forceinline__ float sigmoidf_(float x) { return 1.f / (1.f + __expf(-x)); }
__device__ __forceinline__ float gelu_tanh(float x) { const float y2 = 1.5957691216f * (x + 0.044715f * x * x * x); return x / (1.f + __expf(-y2)); }
__device__ __forceinline__ bf16x8 pack8(float a0, float a1, float a2, float a3, float a4, float a5, float a6, float a7) {
    u32x4 w; w.x = cvt_pk_bf16(a0, a1); w.y = cvt_pk_bf16(a2, a3); w.z = cvt_pk_bf16(a4, a5); w.w = cvt_pk_bf16(a6, a7); return __builtin_bit_cast(bf16x8, w); }

__device__ __forceinline__ f32x4 bf4lo(u32x4 r) { return (f32x4){__uint_as_float(r.x << 16), __uint_as_float(r.x & 0xffff0000u), __uint_as_float(r.y << 16), __uint_as_float(r.y & 0xffff0000u)}; }
__device__ __forceinline__ f32x4 bf4hi(u32x4 r) { return (f32x4){__uint_as_float(r.z << 16), __uint_as_float(r.z & 0xffff0000u), __uint_as_float(r.w << 16), __uint_as_float(r.w & 0xffff0000u)}; }
__device__ __forceinline__ f32x4 bf4(u32x2 r) { return (f32x4){__uint_as_float(r.x << 16), __uint_as_float(r.x & 0xffff0000u), __uint_as_float(r.y << 16), __uint_as_float(r.y & 0xffff0000u)}; }
__device__ __forceinline__ void acc_zero(f32x4 (&acc)[2][2][4][2]) {
#pragma unroll
    for (int a = 0; a < 2; ++a)
#pragma unroll
        for (int b = 0; b < 2; ++b)
#pragma unroll
            for (int m = 0; m < 4; ++m)
#pragma unroll
                for (int n = 0; n < 2; ++n) acc[a][b][m][n] = (f32x4){0.f, 0.f, 0.f, 0.f};
}
struct EpiG1 {
    bf16_t* QB; bf16_t* GG; bf16_t* U; float* out; bf16_t* KBp; bf16_t* VTp;
    __device__ __forceinline__ void init(f32x4 (&acc)[2][2][4][2], const Unit&, int, int, int, int) const { acc_zero(acc); }
    __device__ __forceinline__ void operator()(const f32x4 (&acc)[2][2][4][2], const Unit& u, int wr, int wc, int fr, int fq) const {
        const int region = u.pn >> 1; const int cb = (u.pn & 1) * 256 + wc * 32 + 8 * fq; const int row0 = u.pm * 256 + wr * 64 + fr;
        const bool samp = u.pm >= 128;
#pragma unroll
        for (int ai = 0; ai < 2; ++ai)
#pragma unroll
            for (int m = 0; m < 4; ++m) { const int row = row0 + ai * 128 + m * 16;
#pragma unroll
                for (int bj = 0; bj < 2; ++bj) { const int col = cb + bj * 128; const f32x4 v0 = acc[ai][bj][m][0], v1 = acc[ai][bj][m][1];
                    if (region == 0) { u32x4 w; const float qs = 0.125f * 1.44269504089f;     w.x = cvt_pk_bf16(v0[0] * qs, v0[1] * qs); w.y = cvt_pk_bf16(v0[2] * qs, v0[3] * qs); w.z = cvt_pk_bf16(v1[0] * qs, v1[1] * qs); w.w = cvt_pk_bf16(v1[2] * qs, v1[3] * qs);
                        *(u32x4*)(QB + (size_t)row * 512 + col) = w; }
                    else if (region == 1 || region == 2) {
                        float* o = out + (region == 1 ? (samp ? OFF_KS : OFF_KP) : (samp ? OFF_VS : OFF_VP)) + (size_t)(samp ? row - MP : row) * 512 + col;
                        if (samp) { *(f32x4*)o = v0; *(f32x4*)(o + 4) = v1; } else { __builtin_nontemporal_store(v0, (f32x4*)o); __builtin_nontemporal_store(v1, (f32x4*)(o + 4)); }
                        if (!samp) { const unsigned w0 = cvt_pk_bf16(v0[0], v0[1]), w1 = cvt_pk_bf16(v0[2], v0[3]), w2 = cvt_pk_bf16(v1[0], v1[1]), w3 = cvt_pk_bf16(v1[2], v1[3]);
                            const int bh = (row >> 12) * 8 + (col >> 6), pos = row & 4095, d0 = col & 63;
                            if (region == 1) { u32x4 w; w.x = w0; w.y = w1; w.z = w2; w.w = w3; *(u32x4*)(KBp + ((size_t)((bh * 128 + (pos >> 5)) * 4 + (d0 >> 4)) * 512 + (pos & 31) * 16 + (d0 & 15))) = w; }
                            else { bf16_t* vt = VTp + ((size_t)(bh * 1024 + (pos >> 2)) * 64 + d0) * 4 + (pos & 3);
                                vt[0] = (bf16_t)(w0 & 0xffffu); vt[4] = (bf16_t)(w0 >> 16); vt[8] = (bf16_t)(w1 & 0xffffu); vt[12] = (bf16_t)(w1 >> 16);
                                vt[16] = (bf16_t)(w2 & 0xffffu); vt[20] = (bf16_t)(w2 >> 16); vt[24] = (bf16_t)(w3 & 0xffffu); vt[28] = (bf16_t)(w3 >> 16); } } }
                    else if (region == 3) { u32x4 w; w.x = cvt_pk_bf16(v0[0], v0[1]); w.y = cvt_pk_bf16(v0[2], v0[3]); w.z = cvt_pk_bf16(v1[0], v1[1]); w.w = cvt_pk_bf16(v1[2], v1[3]); *(u32x4*)(U + (size_t)row * 512 + col) = w; }
                    else { u32x4 w; w.x = cvt_pk_bf16(gelu_tanh(v0[0]), gelu_tanh(v0[1])); w.y = cvt_pk_bf16(gelu_tanh(v0[2]), gelu_tanh(v0[3])); w.z = cvt_pk_bf16(gelu_tanh(v1[0]), gelu_tanh(v1[1])); w.w = cvt_pk_bf16(gelu_tanh(v1[2]), gelu_tanh(v1[3]));
                        *(u32x4*)(GG + (size_t)row * 512 + col) = w; }
                } asm volatile("" ::: "memory"); }
    }
};
struct EpiGate {
    const float *rgb, *igb, *lam; const bf16_t* UCBp; unsigned* AX;
    __device__ __forceinline__ void init(f32x4 (&acc)[2][2][4][2], const Unit&, int, int, int, int) const { acc_zero(acc); }
    __device__ __forceinline__ void operator()(const f32x4 (&acc)[2][2][4][2], const Unit& u, int wr, int wc, int fr, int fq) const {
        const int row0 = u.pm * 256 + wr * 64 + fr; const int cb = u.pn * 128 + wc * 32 + 8 * fq;
        const f32x4 sp0 = *(const f32x4*)(lam + cb), sp1 = *(const f32x4*)(lam + cb + 4), rb0 = *(const f32x4*)(rgb + cb), rb1 = *(const f32x4*)(rgb + cb + 4), ib0 = *(const f32x4*)(igb + cb), ib1 = *(const f32x4*)(igb + cb + 4);
#pragma unroll
        for (int ai = 0; ai < 2; ++ai) {
            f32x4 ucv[4][2];
#pragma unroll
            for (int m = 0; m < 4; ++m) { const u32x4 raw = *(const u32x4*)(UCBp + (size_t)(row0 + ai * 128 + m * 16) * 512 + cb); ucv[m][0] = bf4lo(raw); ucv[m][1] = bf4hi(raw); }
#pragma unroll
            for (int m = 0; m < 4; ++m)
#pragma unroll
                for (int n = 0; n < 2; ++n) { const size_t off = (size_t)(row0 + ai * 128 + m * 16) * 512 + cb + 4 * n;
                    const f32x4 uv = ucv[m][n], sp = n ? sp1 : sp0, rb = n ? rb1 : rb0, ib = n ? ib1 : ib0; u32x4 pk;
#pragma unroll
                    for (int j = 0; j < 4; ++j) { const float r = sigmoidf_(acc[ai][0][m][n][j] + rb[j]), ig = sigmoidf_(acc[ai][1][m][n][j] + ib[j]);
                        const float la = sp[j] * r; const float ae = __expf(la); const float om = 1.f - ae; pk[j] = cvt_pk_bf16(om, sqrtf(om * (1.f + ae)) * ig * uv[j]); }
                    *(u32x4*)(AX + off) = pk; }
            asm volatile("" ::: "memory"); }
    }
};
template <bool FROMX, bool TAIL = false> struct EpiRes {
    const float* xP; const float* xS; bf16_t* XB; float* ssq; float* part;
    __device__ __forceinline__ void init(f32x4 (&acc)[2][2][4][2], const Unit& u, int wr, int wc, int fr, int fq) const {
        const bool samp = u.pm >= 128;
        if (TAIL && samp) { acc_zero(acc); return; }
        const int cb = u.pn * 256 + wc * 32 + 8 * fq; const int row0 = u.pm * 256 + wr * 64 + fr;
        if (FROMX) { const float* rbase = (samp ? xS : xP) + (size_t)(row0 - (samp ? MP : 0)) * D + cb;
#pragma unroll
            for (int ai = 0; ai < 2; ++ai)
#pragma unroll
                for (int m = 0; m < 4; ++m)
#pragma unroll
                    for (int bj = 0; bj < 2; ++bj) { const float* rp = rbase + (size_t)(ai * 128 + m * 16) * D + bj * 128; acc[ai][bj][m][0] = __builtin_nontemporal_load((const f32x4*)rp); acc[ai][bj][m][1] = __builtin_nontemporal_load((const f32x4*)(rp + 4)); } }
        else { const bf16_t* rbase = XB + (size_t)row0 * D + cb;
#pragma unroll
            for (int ai = 0; ai < 2; ++ai)
#pragma unroll
                for (int m = 0; m < 4; ++m)
#pragma unroll
                    for (int bj = 0; bj < 2; ++bj) { const u32x4 raw = *(const u32x4*)(rbase + (size_t)(ai * 128 + m * 16) * D + bj * 128); acc[ai][bj][m][0] = bf4lo(raw); acc[ai][bj][m][1] = bf4hi(raw); } }
    }
    __device__ __forceinline__ void operator()(const f32x4 (&acc)[2][2][4][2], const Unit& u, int wr, int wc, int fr, int fq) const {
        const int cb = u.pn * 256 + wc * 32 + 8 * fq; const int row0 = u.pm * 256 + wr * 64 + fr; const bool samp = u.pm >= 128;
        if (TAIL && samp) {
#pragma unroll
            for (int ai = 0; ai < 2; ++ai)
#pragma unroll
                for (int m = 0; m < 4; ++m) { const int row = row0 + ai * 128 + m * 16;
#pragma unroll
                    for (int bj = 0; bj < 2; ++bj) { float* xo = part + ((size_t)(u.kb >> 2) * MS + (row - MP)) * D + cb + bj * 128;
                        *(f32x4*)xo = acc[ai][bj][m][0]; *(f32x4*)(xo + 4) = acc[ai][bj][m][1]; } }
            return;
        }
#pragma unroll
        for (int ai = 0; ai < 2; ++ai)
#pragma unroll
            for (int m = 0; m < 4; ++m) { const int row = row0 + ai * 128 + m * 16; float s = 0.f;
#pragma unroll
                for (int bj = 0; bj < 2; ++bj) { const int col = cb + bj * 128; const f32x4 v0 = acc[ai][bj][m][0], v1 = acc[ai][bj][m][1];
                    u32x4 w; w.x = cvt_pk_bf16(v0[0], v0[1]); w.y = cvt_pk_bf16(v0[2], v0[3]); w.z = cvt_pk_bf16(v1[0], v1[1]); w.w = cvt_pk_bf16(v1[2], v1[3]); *(u32x4*)(XB + (size_t)row * D + col) = w;
                    s += (v0[0] * v0[0] + v0[1] * v0[1]) + (v0[2] * v0[2] + v0[3] * v0[3]) + (v1[0] * v1[0] + v1[1] * v1[1]) + (v1[2] * v1[2] + v1[3] * v1[3]); }
                s += __shfl_xor(s, 16); s += __shfl_xor(s, 32);
                if (fq == 0) atomicAdd(ssq + row, s); }
    }
};
struct EpiSwiglu {
    const float* ssq; bf16_t* H;
    __device__ __forceinline__ void init(f32x4 (&acc)[2][2][4][2], const Unit&, int, int, int, int) const { acc_zero(acc); }
    __device__ __forceinline__ void operator()(const f32x4 (&acc)[2][2][4][2], const Unit& u, int wr, int wc, int fr, int fq) const {
        const int col = u.pn * 128 + wc * 32 + 8 * fq; const int row0 = u.pm * 256 + wr * 64 + fr;
        float rsv[8];
#pragma unroll
        for (int i = 0; i < 8; ++i) rsv[i] = ssq[row0 + (i >> 2) * 128 + (i & 3) * 16];
#pragma unroll
        for (int ai = 0; ai < 2; ++ai)
#pragma unroll
            for (int m = 0; m < 4; ++m) { const int row = row0 + ai * 128 + m * 16; const float rs = rsqrtf(rsv[ai * 4 + m] * (1.f / D) + EPS); float h[8];
#pragma unroll
                for (int j = 0; j < 8; ++j) { const float gv = acc[ai][0][m][j >> 2][j & 3] * rs, uv = acc[ai][1][m][j >> 2][j & 3] * rs; h[j] = gv / (1.f + __expf(-gv)) * uv; }
                u32x4 w; w.x = cvt_pk_bf16(h[0], h[1]); w.y = cvt_pk_bf16(h[2], h[3]); w.z = cvt_pk_bf16(h[4], h[5]); w.w = cvt_pk_bf16(h[6], h[7]);
                *(u32x4*)(H + (size_t)row * FF + col) = w; }
    }
};

struct Args { const float* in[24]; float* out; unsigned char* ws; };
enum { I_XP = 0, I_XS, I_CK, I_CV, I_LH, I_LC, I_SP, I_WIN, I_CW, I_CB, I_RGW, I_RGB, I_IGW, I_IGB, I_LAM, I_WOUT, I_PW, I_PS, I_NM, I_NF, I_FG, I_FU, I_FD, I_NFIN };

__device__ __forceinline__ void transpose_tile(const float* W, int ldw, int srccol0, int k0, const float* gamma, bf16_t* WT, int ldwt, int dstrow0, LAS float* scr, int lane, const float* nscale = nullptr) {
    const float ns = nscale ? nscale[dstrow0 + (lane & 31)] : 1.f;
#pragma unroll
    for (int i = 0; i < 32; ++i) { const int kk = 2 * i + (lane >> 5); float v = __builtin_nontemporal_load(W + (size_t)(k0 + kk) * ldw + srccol0 + (lane & 31)); if (gamma) v *= gamma[k0 + kk]; scr[kk * 33 + (lane & 31)] = v * ns; }
    asm volatile("s_waitcnt lgkmcnt(0)" ::: "memory");
    const int c = lane & 7;
#pragma unroll
    for (int j = 0; j < 4; ++j) { const int n = (lane >> 3) + 8 * j; const LAS float* s = scr + (8 * c) * 33 + n;
        u32x4 o; o.x = cvt_pk_bf16(s[0 * 33], s[1 * 33]); o.y = cvt_pk_bf16(s[2 * 33], s[3 * 33]); o.z = cvt_pk_bf16(s[4 * 33], s[5 * 33]); o.w = cvt_pk_bf16(s[6 * 33], s[7 * 33]);
        *(u32x4*)(WT + (size_t)(dstrow0 + n) * ldwt + k0 + 8 * c) = o; }
    asm volatile("s_waitcnt lgkmcnt(0)" ::: "memory");
}
__device__ __forceinline__ float wave_sum(float v) {
#pragma unroll
    for (int o = 1; o < 64; o <<= 1) v += __shfl_xor(v, o);
    return v;
}
__device__ __forceinline__ int crow(int r, int hi) { return (r & 3) + 8 * (r >> 2) + 4 * hi; }

template <bool PR>
__device__ __forceinline__ void attn_unit(const Args& a, const bf16_t* QB, bf16_t* AO, const bf16_t* KBp, const bf16_t* VTp, int qt, int h, int lane) {
    const int r32 = lane & 31, hi = lane >> 5;
    const float *Kd, *Vd, *Kc, *Vc; int nprev; size_t qrow0;
    if (qt < 1024) { const int b = qt >> 7, tq = qt & 127; qrow0 = (size_t)qt * 32;
        Kc = a.out + OFF_KP + (size_t)b * 4096 * 512 + h * 64; Vc = a.out + OFF_VP + (size_t)b * 4096 * 512 + h * 64;
        Kd = Kc + (size_t)tq * 32 * 512; Vd = Vc + (size_t)tq * 32 * 512; nprev = tq; }
    else { const int bs = qt - 1024; qrow0 = (size_t)MP + (size_t)bs * 32;
        Kd = a.out + OFF_KS + (size_t)bs * 32 * 512 + h * 64; Vd = a.out + OFF_VS + (size_t)bs * 32 * 512 + h * 64;
        Kc = a.in[I_CK] + (size_t)bs * 4096 * 512 + h * 64; Vc = a.in[I_CV] + (size_t)bs * 4096 * 512 + h * 64; nprev = 128; }
    bf16x8 qf[4];
    { const bf16_t* Qp = QB + (qrow0 + r32) * 512 + h * 64 + hi * 8;
#pragma unroll
      for (int kk = 0; kk < 4; ++kk) qf[kk] = __builtin_nontemporal_load((const bf16x8*)(Qp + kk * 16)); }
    f32x16 o0, o1;
#pragma unroll
    for (int r = 0; r < 16; ++r) { o0[r] = 0.f; o1[r] = 0.f; }
    float Cm = 1.f; int Ce = 0;
    constexpr int DP = PR ? 3 : 1;
    f32x4 kr[8]; float vr[32];
    bf16x8 krb[DP][4]; u32x2 vrb[DP][8];
    const bf16_t* Kbb = KBp + (size_t)(((qt >> 7) * 8 + h) * 128) * 2048 + r32 * 16 + hi * 8;
    const bf16_t* Vtb = VTp + ((size_t)(((qt >> 7) * 8 + h) * 1024 + hi) * 64 + r32) * 4;
#define ATT_LOAD(Kt_, Vt_) do { const float* kp_ = (Kt_) + (size_t)r32 * 512 + hi * 8; \
        _Pragma("unroll") for (int kk = 0; kk < 4; ++kk) { kr[2 * kk] = *(const f32x4*)(kp_ + kk * 16); kr[2 * kk + 1] = *(const f32x4*)(kp_ + kk * 16 + 4); } \
        const float* vp_ = (Vt_) + (size_t)(4 * hi) * 512 + r32; \
        _Pragma("unroll") for (int sI = 0; sI < 2; ++sI) _Pragma("unroll") for (int dh = 0; dh < 2; ++dh) _Pragma("unroll") for (int i = 0; i < 8; ++i) \
            vr[(sI * 2 + dh) * 8 + i] = vp_[(size_t)(16 * sI + (i & 3) + 8 * (i >> 2)) * 512 + dh * 32]; } while (0)
#define ATT_LOADB(J_, key0_) do { const bf16_t* kp_ = Kbb + (size_t)((key0_) >> 5) * 2048; \
        _Pragma("unroll") for (int kk = 0; kk < 4; ++kk) krb[J_][kk] = *(const bf16x8*)(kp_ + kk * 512); \
        _Pragma("unroll") for (int sI = 0; sI < 2; ++sI) _Pragma("unroll") for (int dh = 0; dh < 2; ++dh) { const bf16_t* vp_ = Vtb + ((size_t)(((key0_) >> 2) + 4 * sI) * 64 + 32 * dh) * 4; \
            vrb[J_][(sI * 2 + dh) * 2] = *(const u32x2*)vp_; vrb[J_][(sI * 2 + dh) * 2 + 1] = *(const u32x2*)(vp_ + 2 * 64 * 4); } } while (0)
    if (PR) {
#pragma unroll
        for (int j = 0; j < DP; ++j) if (j <= nprev) ATT_LOADB(j, (nprev - j) * 32);
    } else ATT_LOAD(Kd, Vd);
    bool done = false;
    for (int it0 = 0; it0 <= nprev && !done; it0 += DP) {
#pragma unroll
      for (int j = 0; j < DP; ++j) { const int it = it0 + j; if (it > nprev) { done = true; break; }
        bf16x8 kf[4], vb[4];
        if (PR) {
#pragma unroll
            for (int kk = 0; kk < 4; ++kk) kf[kk] = krb[j][kk];
#pragma unroll
            for (int q = 0; q < 4; ++q) { u32x4 w; w.x = vrb[j][2 * q].x; w.y = vrb[j][2 * q].y; w.z = vrb[j][2 * q + 1].x; w.w = vrb[j][2 * q + 1].y; vb[q] = __builtin_bit_cast(bf16x8, w); }
            if (it + DP <= nprev) ATT_LOADB(j, (nprev - it - DP) * 32);
        } else {
#pragma unroll
            for (int kk = 0; kk < 4; ++kk) kf[kk] = pack8(kr[2 * kk][0], kr[2 * kk][1], kr[2 * kk][2], kr[2 * kk][3], kr[2 * kk + 1][0], kr[2 * kk + 1][1], kr[2 * kk + 1][2], kr[2 * kk + 1][3]);
#pragma unroll
            for (int q = 0; q < 4; ++q) vb[q] = pack8(vr[q * 8 + 0], vr[q * 8 + 1], vr[q * 8 + 2], vr[q * 8 + 3], vr[q * 8 + 4], vr[q * 8 + 5], vr[q * 8 + 6], vr[q * 8 + 7]);
            if (it < nprev) { const size_t toff = (size_t)(nprev - it - 1) * 32 * 512; ATT_LOAD(Kc + toff, Vc + toff); }
        }
        f32x16 s;
#pragma unroll
        for (int r = 0; r < 16; ++r) s[r] = 0.f;
#pragma unroll
        for (int kk = 0; kk < 4; ++kk) s = __builtin_amdgcn_mfma_f32_32x32x16_bf16(kf[kk], qf[kk], s, 0, 0, 0);
        float sg[16], om[16];
#pragma unroll
        for (int r = 0; r < 16; ++r) { const float z2 = s[r]; const float e = __builtin_amdgcn_exp2f(-fabsf(z2)); const float rc = __builtin_amdgcn_rcpf(1.f + e); const float t = e * rc;
            const bool pos = z2 >= 0.f; const bool valid = (it != 0) || (crow(r, hi) < r32);
            sg[r] = valid ? (pos ? rc : t) : 0.f; om[r] = valid ? (pos ? t : rc) : 1.f; }
        const float G0 = (om[0] * om[1]) * (om[2] * om[3]), G1 = (om[4] * om[5]) * (om[6] * om[7]), G2 = (om[8] * om[9]) * (om[10] * om[11]), G3 = (om[12] * om[13]) * (om[14] * om[15]);
        const float P0 = __shfl_xor(G0, 32), P1 = __shfl_xor(G1, 32), P2 = __shfl_xor(G2, 32), P3 = __shfl_xor(G3, 32);
        const float t3 = G3 * P3, t2 = G2 * P2, t1 = G1 * P1, t0 = G0 * P0;
        const float Cs = ldexpf(Cm, Ce);
        float base[4];
        base[3] = Cs * (hi ? 1.f : P3); base[2] = Cs * t3 * (hi ? 1.f : P2); base[1] = Cs * (t3 * t2) * (hi ? 1.f : P1); base[0] = Cs * ((t3 * t2) * t1) * (hi ? 1.f : P0);
        float w[16];
#pragma unroll
        for (int g = 0; g < 4; ++g) { float bt = base[g];
#pragma unroll
            for (int rr = 3; rr >= 0; --rr) { const int r = 4 * g + rr; w[r] = sg[r] * bt; bt *= om[r]; } }
        { const float nc = Cm * ((t0 * t1) * (t2 * t3)); Cm = __builtin_amdgcn_frexp_mantf(nc); Ce += __builtin_amdgcn_frexp_expf(nc); }
        const bf16x8 wa0 = pack8(w[0], w[1], w[2], w[3], w[4], w[5], w[6], w[7]), wa1 = pack8(w[8], w[9], w[10], w[11], w[12], w[13], w[14], w[15]);
        o0 = __builtin_amdgcn_mfma_f32_32x32x16_bf16(wa0, vb[0], o0, 0, 0, 0); o0 = __builtin_amdgcn_mfma_f32_32x32x16_bf16(wa1, vb[2], o0, 0, 0, 0);
        o1 = __builtin_amdgcn_mfma_f32_32x32x16_bf16(wa0, vb[1], o1, 0, 0, 0); o1 = __builtin_amdgcn_mfma_f32_32x32x16_bf16(wa1, vb[3], o1, 0, 0, 0);
        if (__all(Cm == 0.f || Ce < -150)) { done = true; break; }
      }
    }
#undef ATT_LOAD
#undef ATT_LOADB
    bf16_t* op = AO + qrow0 * D + h * 64 + r32;
#pragma unroll
    for (int r = 0; r < 16; ++r) { const size_t ro = (size_t)crow(r, hi) * D; op[ro] = (bf16_t)(cvt_pk_bf16(o0[r], 0.f) & 0xffffu); op[ro + 32] = (bf16_t)(cvt_pk_bf16(o1[r], 0.f) & 0xffffu); }
}


constexpr int PR = 8;
template <int W, bool SAMP>
__device__ __forceinline__ void pool_strip(const bf16_t* XRp, bf16_t* XBp, float* pout, const float* ssq2, const LAS float* ldsrs, const float* pbuf, const float* gm,
                                           int row0, int pos0, int seq, int Tseq, int c4) {
    const f32x4 gv = *(const f32x4*)(gm + c4);
    f32x4 xn[PR + W - 1];
#pragma unroll
    for (int j = 0; j < PR + W - 1; ++j) { const int p = pos0 - (W - 1) + j, rr = row0 - (W - 1) + j;
        if (p >= 0) { const float rs = SAMP ? ldsrs[p] : rsqrtf(ssq2[rr] * (1.f / D) + EPS); xn[j] = bf4(*(const u32x2*)(XRp + (size_t)rr * D + c4)) * rs * gv; }
        else if (SAMP) xn[j] = *(const f32x4*)(pbuf + ((size_t)seq * 15 + (15 + p)) * D + c4);
        else xn[j] = (f32x4){0.f, 0.f, 0.f, 0.f}; }
    f32x4 Sw = (f32x4){0.f, 0.f, 0.f, 0.f};
#pragma unroll
    for (int j = 0; j < W - 1; ++j) Sw = Sw + xn[j];
#pragma unroll
    for (int t = 0; t < PR; ++t) { const int pos = pos0 + t; const f32x4 x = xn[t + W - 1]; Sw = Sw + x;
        const float cnt = SAMP ? (float)W : (float)((pos + 1 < W) ? pos + 1 : W); const f32x4 dv = Sw * (1.f / cnt) - x;
        u32x2 wv; wv.x = cvt_pk_bf16(dv[0], dv[1]); wv.y = cvt_pk_bf16(dv[2], dv[3]); *(u32x2*)(XBp + (size_t)(row0 + t) * D + c4) = wv;
        if (pos >= Tseq - 15) *(f32x4*)(pout + ((size_t)seq * 15 + (pos - (Tseq - 15))) * D + c4) = x;
        Sw = Sw - xn[t]; }
}

#define XB_TMO      128
#define XB_XCNT(j)  (256  + 64 * (j))
#define XB_XSUB(j)  (1280 + 64 * (j))
#define XB_XGEN(j)  (2304 + 64 * (j))
#define XB_TOP      3328
#define XB_TOPGEN   3392
#define XCD_BAR_WORDS 3456
#define XB_SPIN_CAP (1u << 18)

__device__ __forceinline__ unsigned xb_ld(unsigned* p)              { return __hip_atomic_load(p, __ATOMIC_RELAXED, __HIP_MEMORY_SCOPE_AGENT); }
__device__ __forceinline__ unsigned xb_add(unsigned* p, unsigned v) { return __hip_atomic_fetch_add(p, v, __ATOMIC_RELAXED, __HIP_MEMORY_SCOPE_AGENT); }
__device__ __forceinline__ unsigned xb_xcc_id() { return (unsigned)__builtin_amdgcn_s_getreg((3 << 11) | 20) & 0xFu; }
#define XB_SPIN(cond, bar) do { unsigned _sp = 0; while (cond) { __builtin_amdgcn_s_sleep(1); \
    if ((++_sp & 255u) == 0u) { if (xb_ld(&(bar)[XB_TMO])) break; if (_sp > XB_SPIN_CAP) { atomicAdd(&(bar)[XB_TMO], 1u); break; } } } } while (0)

struct XcdBarrier {
    unsigned* bar; unsigned x;
    volatile LAS unsigned* st;
};

__device__ __forceinline__ XcdBarrier xcd_barrier_post(unsigned* bar, volatile LAS unsigned* st) {
    XcdBarrier b; b.bar = bar; b.x = xb_xcc_id(); b.st = st;
    if (threadIdx.x == 0) (void)xb_add(&bar[XB_XCNT(b.x)], 1u);
    return b;
}
__device__ __forceinline__ void xcd_barrier_complete(unsigned* bar, unsigned x, unsigned& nloc, unsigned& nx) {
    const unsigned G = gridDim.x * gridDim.y * gridDim.z;
    unsigned sum, cnt, mine, sp = 0u;
    for (;;) {
        sum = 0u; cnt = 0u; mine = 0u;
#pragma unroll
        for (unsigned j = 0; j < 16; ++j) { const unsigned c = xb_ld(&bar[XB_XCNT(j)]); sum += c; cnt += (c > 0u) ? 1u : 0u; mine = (j == x) ? c : mine; }
        if (sum == G) break;
        __builtin_amdgcn_s_sleep(1);
        if ((++sp & 255u) == 0u) { if (xb_ld(&bar[XB_TMO])) break; if (sp > XB_SPIN_CAP) { atomicAdd(&bar[XB_TMO], 1u); break; } }
    }
    nloc = mine > 0u ? mine : 1u; nx = cnt > 0u ? cnt : 1u;
}

__device__ __forceinline__ void xcd_barrier(const XcdBarrier& b) {
    asm volatile("s_waitcnt vmcnt(0)" ::: "memory");
    __syncthreads();
    if (threadIdx.x == 0) {
        unsigned* bar = b.bar;
        __builtin_amdgcn_s_waitcnt(0);
        unsigned nloc = b.st[0], nx = b.st[1];
        if (nloc == 0u) { xcd_barrier_complete(bar, b.x, nloc, nx); b.st[0] = nloc; b.st[1] = nx; }
        const unsigned old = xb_add(&bar[XB_XSUB(b.x)], 1u);
        const unsigned gen = old / nloc;
        if (old + 1u == (gen + 1u) * nloc) {
            __builtin_amdgcn_fence(__ATOMIC_RELEASE, "agent");
            asm volatile("s_waitcnt vmcnt(0)" ::: "memory");
            const unsigned og = xb_add(&bar[XB_TOP], 1u);
            const unsigned tg = og / nx;
            if (og + 1u == (tg + 1u) * nx) xb_add(&bar[XB_TOPGEN], 1u);
            else XB_SPIN(xb_ld(&bar[XB_TOPGEN]) == tg, bar);
            __builtin_amdgcn_fence(__ATOMIC_ACQUIRE, "agent");
            xb_add(&bar[XB_XGEN(b.x)], 1u);
            asm volatile("s_waitcnt vmcnt(0)" ::: "memory");
        } else {
            XB_SPIN(xb_ld(&bar[XB_XGEN(b.x)]) == gen, bar);
            __builtin_amdgcn_fence(__ATOMIC_ACQUIRE, "agent");
            asm volatile("s_waitcnt vmcnt(0)" ::: "memory");
        }
    }
    __syncthreads();
}


#ifndef SKIPMASK
#define SKIPMASK 0
#endif
#define PH(n) if (!((SKIPMASK >> (n)) & 1))
__global__ void __launch_bounds__(512, 2) fwd_kernel(Args a) {
    extern __shared__ __attribute__((aligned(16))) unsigned char lds[];
    cg::grid_group grid = cg::this_grid();
    PG8_LAS unsigned char* L = (PG8_LAS unsigned char*)lds;
    const int tid = threadIdx.x, lane = tid & 63, wave = __builtin_amdgcn_readfirstlane(tid >> 6);
    const int G = gridDim.x, bx = blockIdx.x;
    const int gw = bx * 8 + wave, NGW = G * 8; const int gt = bx * 512 + tid, NGT = G * 512;
    float* const out = a.out;
    volatile LAS unsigned* bst = (volatile LAS unsigned*)(L + 131072 + 64);
    if (tid < 4) bst[tid] = 0u;
    __syncthreads();
    const XcdBarrier xbar = xcd_barrier_post((unsigned*)(a.ws + WS_BAR), bst);
#define ws (a.ws)
#define SSQ ((float*)(ws + WS_SSQ))
#define SUMA ((float*)(ws + WS_SUM))
#define SUMH (SUMA + 512 * 512)
#define SPL ((float*)(ws + WS_SPL))
#define WIN ((bf16_t*)(ws + WS_WIN))
#define WG ((bf16_t*)(ws + WS_WG))
#define WOUT ((bf16_t*)(ws + WS_WOUT))
#define WGU ((bf16_t*)(ws + WS_WGU))
#define WD ((bf16_t*)(ws + WS_WD))
#define WP ((bf16_t*)(ws + WS_WP))
#define XB ((bf16_t*)(ws + WS_XB))
#define QB ((bf16_t*)(ws + WS_QB))
#define GG ((bf16_t*)(ws + WS_GG))
#define UCB ((bf16_t*)(ws + WS_UCB))
#define KB ((bf16_t*)(ws + WS_KB))
#define VT ((bf16_t*)(ws + WS_VT))
#define U ((bf16_t*)(ws + WS_U))
#define AX ((unsigned*)(ws + WS_AA))
#define AO ((bf16_t*)(ws + WS_AO))
#define H ((bf16_t*)(ws + WS_H))
#define PART ((float*)(ws + WS_PART))

    PH(0)
    {
        for (int i = gt; i < 4 * M; i += NGT) SSQ[i] = 0.f;
        if (gt < 512) SPL[gt] = -8.f * log1pf(expf(-a.in[I_LAM][gt]));
        LAS float* scr = (LAS float*)(L + wave * 16384);
        constexpr int IT_WIN = 16 * 80, IT_WOUT = 16 * 32, IT_WGU = 16 * 176, IT_WD = 44 * 32, IT_WP = 4 * 8;
        constexpr int NITEMS = IT_WIN + IT_WOUT + 2 * IT_WGU + 2 * IT_WD + 4 * IT_WP;
        for (int it = gw; it < NITEMS; it += NGW) {
            int r = it;
            if (r >= IT_WIN + IT_WOUT) break;
            if (r < IT_WIN) { const int kb = r / 80, nb = r % 80; transpose_tile(a.in[I_WIN], NIN, nb * 32, kb * 64, a.in[I_NM], WIN, D, nb * 32, scr, lane); continue; } r -= IT_WIN;
            if (r < IT_WOUT) { const int kb = r / 32, nb = r % 32; transpose_tile(a.in[I_WOUT], D, nb * 32, kb * 64, nullptr, WOUT, D, nb * 32, scr, lane); continue; } r -= IT_WOUT;
            if (r < 2 * IT_WGU) { const int l = r / IT_WGU; r -= l * IT_WGU; const int kb = r / 176, nb = r % 176; const int n0 = nb * 32;
                const float* src = ((n0 & 128) ? a.in[I_FU] : a.in[I_FG]) + (size_t)l * D * FF; const int sc0 = (n0 >> 8) * 128 + (n0 & 127);
                transpose_tile(src, FF, sc0, kb * 64, a.in[I_NF] + l * D, WGU + (size_t)l * NGU * D, D, n0, scr, lane); continue; } r -= 2 * IT_WGU;
            if (r < 2 * IT_WD) { const int l = r / IT_WD; r -= l * IT_WD; const int kb = r / 32, nb = r % 32;
                transpose_tile(a.in[I_FD] + (size_t)l * FF * D, D, nb * 32, kb * 64, nullptr, WD + (size_t)l * D * FF, FF, nb * 32, scr, lane); continue; } r -= 2 * IT_WD;
            { const int g = r / IT_WP; r -= g * IT_WP; const int kb = r / 8, nb = r % 8;
                transpose_tile(a.in[I_PW] + (size_t)g * 256 * 256, 256, nb * 32, kb * 64, nullptr, WP, 256, g * 256 + nb * 32, scr, lane, a.in[I_PS]); }
        }
        for (int i = gt; i < 1024 * 128; i += NGT) { const int np = i >> 7, kk = i & 127; const int pn = np >> 8, bj = (np >> 7) & 1, j = np & 127; const int c = 128 * pn + j, cin = 128 * pn + kk;
            float v = 0.f; if ((cin >> 6) == (c >> 6)) v = (bj ? a.in[I_IGW] : a.in[I_RGW])[(size_t)(c >> 6) * 4096 + (cin & 63) * 64 + (c & 63)];
            WG[i] = (bf16_t)(cvt_pk_bf16(v, 0.f) & 0xffffu); }
        for (int m0 = gw; m0 < M; m0 += 2 * NGW) { const int m1 = m0 + NGW; const bool has1 = m1 < M;
            const float* xr0 = (m0 < MP) ? a.in[I_XP] + (size_t)m0 * D : a.in[I_XS] + (size_t)(m0 - MP) * D;
            const float* xr1 = has1 ? ((m1 < MP) ? a.in[I_XP] + (size_t)m1 * D : a.in[I_XS] + (size_t)(m1 - MP) * D) : xr0;
            f32x4 v0[4], v1[4]; float s0 = 0.f, s1 = 0.f;
#pragma unroll
            for (int j = 0; j < 4; ++j) { v0[j] = __builtin_nontemporal_load((const f32x4*)xr0 + lane + 64 * j); v1[j] = __builtin_nontemporal_load((const f32x4*)xr1 + lane + 64 * j); }
#pragma unroll
            for (int j = 0; j < 4; ++j) { s0 += (v0[j][0] * v0[j][0] + v0[j][1] * v0[j][1]) + (v0[j][2] * v0[j][2] + v0[j][3] * v0[j][3]); s1 += (v1[j][0] * v1[j][0] + v1[j][1] * v1[j][1]) + (v1[j][2] * v1[j][2] + v1[j][3] * v1[j][3]); }
            const float rs0 = rsqrtf(wave_sum(s0) * (1.f / D) + EPS), rs1 = rsqrtf(wave_sum(s1) * (1.f / D) + EPS);
#pragma unroll
            for (int j = 0; j < 4; ++j) { u32x2 w; w.x = cvt_pk_bf16(v0[j][0] * rs0, v0[j][1] * rs0); w.y = cvt_pk_bf16(v0[j][2] * rs0, v0[j][3] * rs0); ((u32x2*)(XB + (size_t)m0 * D))[lane + 64 * j] = w; }
            if (has1) {
#pragma unroll
                for (int j = 0; j < 4; ++j) { u32x2 w; w.x = cvt_pk_bf16(v1[j][0] * rs1, v1[j][1] * rs1); w.y = cvt_pk_bf16(v1[j][2] * rs1, v1[j][3] * rs1); ((u32x2*)(XB + (size_t)m1 * D))[lane + 64 * j] = w; } } }
    }
    xcd_barrier(xbar);
    if (a.out == nullptr) grid.sync();
    pg8::StaticOrder S;
    PH(1)
    { pg8::Gemm g{XB, WIN, M, NIN, D, D, 0}; pg8::G1Order S1; S1.init(G, bx); EpiG1 E{QB, GG, U, out, KB, VT}; pg8::gemm_phase(L, g, S1, E); }
    xcd_barrier(xbar);
    PH(2)
    { const float* cw = a.in[I_CW]; const float* cbias = a.in[I_CB]; S.init(M, 1024, G, bx);
      for (int i = 0; ; ++i) { pg8::Unit tu; if (!S.next(i, tu)) break;
        for (int item = tid; item < 32 * 32; item += 512) { const int c4 = tu.pn * 128 + (item & 31) * 4; const int row0 = tu.pm * 256 + (item >> 5) * 8;
            int pos0, T, seq; const bool samp = row0 >= MP; if (!samp) { pos0 = row0 & 4095; T = 4096; seq = row0 >> 12; } else { pos0 = (row0 - MP) & 31; T = 32; seq = (row0 - MP) >> 5; }
            f32x4 uu[11];
#pragma unroll
            for (int j = 0; j < 11; ++j) { const int p = pos0 - 3 + j;
                if (p >= 0) uu[j] = bf4(*(const u32x2*)(U + (size_t)(row0 - 3 + j) * 512 + c4));
                else if (samp) uu[j] = *(const f32x4*)(a.in[I_LC] + ((size_t)seq * 3 + (3 + p)) * 512 + c4);
                else uu[j] = (f32x4){0.f, 0.f, 0.f, 0.f}; }
            const f32x4 cb4 = *(const f32x4*)(cbias + c4), w0 = *(const f32x4*)(cw + c4), w1 = *(const f32x4*)(cw + 512 + c4), w2 = *(const f32x4*)(cw + 1024 + c4), w3 = *(const f32x4*)(cw + 1536 + c4);
#pragma unroll
            for (int t = 0; t < 8; ++t) { const f32x4 accv = cb4 + uu[t] * w0 + uu[t + 1] * w1 + uu[t + 2] * w2 + uu[t + 3] * w3;
                u32x2 w; w.x = cvt_pk_bf16(accv[0], accv[1]); w.y = cvt_pk_bf16(accv[2], accv[3]); *(u32x2*)(UCB + (size_t)(row0 + t) * 512 + c4) = w;
                if (pos0 + t >= T - 3) *(f32x4*)(out + (samp ? OFF_CS : OFF_CP) + ((size_t)seq * 3 + (pos0 + t - (T - 3))) * 512 + c4) = uu[t + 3]; } } }
      asm volatile("s_waitcnt vmcnt(0)" ::: "memory"); __syncthreads(); }
    PH(3)
    { pg8::Gemm g{UCB, WG, M, 1024, 128, 512, 128}; S.init(M, 1024, G, bx); EpiGate E{a.in[I_RGB], a.in[I_IGB], SPL, UCB, AX}; pg8::gemm_phase(L, g, S, E); }
    PH(4)
    for (int i = 0; ; ++i) { pg8::Unit tu; if (!S.next(i, tu)) break; if (tu.pm >= 128) continue;
        const int chunk = 4 * tu.pm + (wave >> 1), c = (2 * tu.pn + (wave & 1)) * 64 + lane; const size_t base = (size_t)chunk * 64 * 512 + c;
        float hl = 0.f, ap = 1.f;
#pragma unroll 32
        for (int t = 0; t < 64; ++t) { const unsigned pk = AX[base + (size_t)t * 512]; const float av = 1.f - __uint_as_float(pk << 16), xv = __uint_as_float(pk & 0xffff0000u); hl = av * hl + xv; ap *= av; }
        SUMA[chunk * 512 + c] = ap; SUMH[chunk * 512 + c] = hl; }
    PH(3)
    { pg8::Gemm g{XB, WIN, M, NIN, D, D, 0}; pg8::G1Tail S2; S2.init(G, bx); EpiG1 E{QB, GG, U, out, KB, VT}; pg8::gemm_phase(L, g, S2, E); }
    PH(14) { unsigned* actr = (unsigned*)(ws + WS_BAR) + 3584;
        unsigned u = (unsigned)gw;
        while (u < 1056u * 8u) {
            unsigned nx = 0; if (lane == 0) nx = atomicAdd(actr, 1u) + (unsigned)NGW;
            if (u < 256u) { const int uu = (int)(8192u + u); attn_unit<false>(a, QB, AO, KB, VT, uu >> 3, uu & 7, lane); } else { const int uu = (int)(u - 256u); attn_unit<true>(a, QB, AO, KB, VT, uu >> 3, uu & 7, lane); }
            u = (unsigned)__builtin_amdgcn_readfirstlane((int)nx); } }
    xcd_barrier(xbar);
    PH(5)
    for (int u = gw; u < 512 * 8 + 32 * 8; u += NGW) {
        const bool samp = u >= 4096; int row0, nt, c; float hcur; bool lastc; float* hout;
        if (!samp) { const int chunk = u >> 3; c = (u & 7) * 64 + lane; const int b = chunk >> 6, ci = chunk & 63; row0 = chunk * 64; nt = 64; hcur = 0.f;
            for (int j0 = 0; j0 < ci; j0 += 8) { float sa[8], sh[8];
#pragma unroll
                for (int k = 0; k < 8; ++k) { const bool ok = (j0 + k) < ci; const int jj = ok ? (j0 + k) : j0; sa[k] = SUMA[(b * 64 + jj) * 512 + c]; sh[k] = SUMH[(b * 64 + jj) * 512 + c]; if (!ok) { sa[k] = 1.f; sh[k] = 0.f; } }
#pragma unroll
                for (int k = 0; k < 8; ++k) hcur = sa[k] * hcur + sh[k]; }
            lastc = (ci == 63); hout = out + OFF_HP + b * 512 + c; }
        else { const int v = u - 4096; const int bs = v >> 3; c = (v & 7) * 64 + lane; row0 = MP + bs * 32; nt = 32; hcur = a.in[I_LH][bs * 512 + c]; lastc = true; hout = out + OFF_HS + bs * 512 + c; }
        const size_t base = (size_t)row0 * 512 + c;
        for (int t0 = 0; t0 < nt; t0 += 32) { unsigned pk[32]; bf16_t gg[32];
#pragma unroll
            for (int k = 0; k < 32; ++k) { pk[k] = __builtin_nontemporal_load(AX + base + (size_t)(t0 + k) * 512); gg[k] = __builtin_nontemporal_load(GG + base + (size_t)(t0 + k) * 512); }
#pragma unroll
            for (int k = 0; k < 32; ++k) { const float av = 1.f - __uint_as_float(pk[k] << 16), xv = __uint_as_float(pk[k] & 0xffff0000u); hcur = av * hcur + xv;
                AO[(size_t)(row0 + t0 + k) * D + 512 + c] = (bf16_t)(cvt_pk_bf16(hcur * bf2f(gg[k]), 0.f) & 0xffffu); } }
        if (lastc) *hout = hcur; }
    xcd_barrier(xbar);
    PH(6)
    { pg8::Gemm g{AO, WOUT, M, D, D, D, 0}; S.init(M, D, G, bx); EpiRes<true> E{a.in[I_XP], a.in[I_XS], XB, SSQ, nullptr}; pg8::gemm_phase(L, g, S, E); }
    PH(6)
    { const int rem = (M / 256 * (D / 256)) % G; const int b0 = rem; const int nblk = G - b0;
      if (bx >= b0) { LAS float* scr = (LAS float*)(L + wave * 16384); const int dw = (bx - b0) * 8 + wave, NDW = nblk * 8;
        constexpr int IT_WGU = 16 * 176, IT_WD = 44 * 32, IT_WP = 4 * 8;
        for (int it = dw; it < IT_WGU + IT_WD + 4 * IT_WP; it += NDW) {
            int r = it;
            if (r < IT_WGU) { const int kb = r / 176, nb = r % 176; const int n0 = nb * 32;
                const float* src = (n0 & 128) ? a.in[I_FU] : a.in[I_FG]; const int sc0 = (n0 >> 8) * 128 + (n0 & 127);
                transpose_tile(src, FF, sc0, kb * 64, a.in[I_NF], WGU, D, n0, scr, lane); continue; } r -= IT_WGU;
            if (r < IT_WD) { const int kb = r / 32, nb = r % 32; transpose_tile(a.in[I_FD], D, nb * 32, kb * 64, nullptr, WD, FF, nb * 32, scr, lane); continue; } r -= IT_WD;
            { const int g = r / IT_WP; r -= g * IT_WP; const int kb = r / 8, nb = r % 8;
                transpose_tile(a.in[I_PW] + (size_t)g * 256 * 256, 256, nb * 32, kb * 64, nullptr, WP, 256, g * 256 + nb * 32, scr, lane, a.in[I_PS]); }
        } } }
    xcd_barrier(xbar);
    PH(7)
    { pg8::Gemm g{XB, WGU, M, NGU, D, D, 0}; S.init(M, NGU, G, bx); EpiSwiglu E{SSQ, H}; pg8::gemm_phase(L, g, S, E); }
    PH(7)
    { const int rem = (M / 256 * (NGU / 256)) % G; const int b0 = rem; const int nblk = G - b0;
      if (bx >= b0) { LAS float* scr = (LAS float*)(L + wave * 16384); const int dw = (bx - b0) * 8 + wave, NDW = nblk * 8;
        constexpr int IT_WGU = 16 * 176, IT_WD = 44 * 32;
        for (int it = dw; it < IT_WGU + IT_WD; it += NDW) {
            int r = it;
            if (r < IT_WGU) { const int kb = r / 176, nb = r % 176; const int n0 = nb * 32;
                const float* src = ((n0 & 128) ? a.in[I_FU] : a.in[I_FG]) + (size_t)D * FF; const int sc0 = (n0 >> 8) * 128 + (n0 & 127);
                transpose_tile(src, FF, sc0, kb * 64, a.in[I_NF] + D, WGU + (size_t)NGU * D, D, n0, scr, lane); continue; } r -= IT_WGU;
            { const int kb = r / 32, nb = r % 32; transpose_tile(a.in[I_FD] + (size_t)FF * D, D, nb * 32, kb * 64, nullptr, WD + (size_t)D * FF, FF, nb * 32, scr, lane); }
        } } }
    xcd_barrier(xbar);
    PH(8)
    { pg8::Gemm g{H, WD, M, D, FF, FF, 0}; pg8::TailOrder ST; ST.init(FF, G, bx); EpiRes<false, true> E{nullptr, nullptr, XB, SSQ + M, PART}; pg8::gemm_phase(L, g, ST, E); }
    xcd_barrier(xbar);
    PH(9)
    {
        const float* ssq2 = SSQ + M; const float* gm = a.in[I_NM] + D; const float* pbuf = a.in[I_SP]; const LAS float* ldsrs = (const LAS float*)L;
        for (int idx = gt; idx < (MP / PR) * 256; idx += NGT) { const int strip = idx >> 8, c4 = (idx & 255) * 4; const int row0 = strip * PR, pos0 = row0 & 4095, seq = row0 >> 12;
            switch (c4 >> 8) {
                case 0: pool_strip<2, false>(XB, AO, out + OFF_PP, ssq2, ldsrs, pbuf, gm, row0, pos0, seq, 4096, c4); break;
                case 1: pool_strip<4, false>(XB, AO, out + OFF_PP, ssq2, ldsrs, pbuf, gm, row0, pos0, seq, 4096, c4); break;
                case 2: pool_strip<8, false>(XB, AO, out + OFF_PP, ssq2, ldsrs, pbuf, gm, row0, pos0, seq, 4096, c4); break;
                default: pool_strip<16, false>(XB, AO, out + OFF_PP, ssq2, ldsrs, pbuf, gm, row0, pos0, seq, 4096, c4); break; } }
        for (int sidx = bx; sidx < 32; sidx += G) {
            __syncthreads();
#pragma unroll
            for (int j = 0; j < 4; ++j) { const int r = wave * 4 + j; u32x2* xr = (u32x2*)(XB + (size_t)(MP + sidx * 32 + r) * D); const f32x4* pr = (const f32x4*)(PART + (size_t)(sidx * 32 + r) * D); float sq = 0.f;
#pragma unroll
                for (int q = 0; q < 4; ++q) { f32x4 v = bf4(xr[lane + 64 * q]);
#pragma unroll
                    for (int ks = 0; ks < 11; ++ks) v = v + __builtin_nontemporal_load(pr + (size_t)ks * (MS * D / 4) + lane + 64 * q);
                    u32x2 wv; wv.x = cvt_pk_bf16(v[0], v[1]); wv.y = cvt_pk_bf16(v[2], v[3]); xr[lane + 64 * q] = wv; sq += (v[0] * v[0] + v[1] * v[1]) + (v[2] * v[2] + v[3] * v[3]); }
                sq = wave_sum(sq); if (lane == 0) ((LAS float*)L)[r] = rsqrtf(sq * (1.f / D) + EPS); }
            asm volatile("s_waitcnt vmcnt(0)" ::: "memory"); __threadfence_block(); __syncthreads();
            const int c4 = (tid & 255) * 4, half = tid >> 8;
            for (int sub = 0; sub < 16 / PR; ++sub) { const int pos0 = half * 16 + sub * PR, row0 = MP + sidx * 32 + pos0;
            switch (c4 >> 8) {
                case 0: pool_strip<2, true>(XB, AO, out + OFF_PS, ssq2, ldsrs, pbuf, gm, row0, pos0, sidx, 32, c4); break;
                case 1: pool_strip<4, true>(XB, AO, out + OFF_PS, ssq2, ldsrs, pbuf, gm, row0, pos0, sidx, 32, c4); break;
                case 2: pool_strip<8, true>(XB, AO, out + OFF_PS, ssq2, ldsrs, pbuf, gm, row0, pos0, sidx, 32, c4); break;
                default: pool_strip<16, true>(XB, AO, out + OFF_PS, ssq2, ldsrs, pbuf, gm, row0, pos0, sidx, 32, c4); break; } } }
    }
    xcd_barrier(xbar);
    PH(10)
    { pg8::Gemm g{AO  , WP, M, D, 256, D, 256}; S.init(M, D, G, bx); EpiRes<false> E{nullptr, nullptr, XB, SSQ + 2 * M, nullptr}; pg8::gemm_phase(L, g, S, E); }
    xcd_barrier(xbar);
    PH(11)
    { pg8::Gemm g{XB, WGU + (size_t)NGU * D, M, NGU, D, D, 0}; S.init(M, NGU, G, bx); EpiSwiglu E{SSQ + 2 * M, H}; pg8::gemm_phase(L, g, S, E); }
    xcd_barrier(xbar);
    PH(12)
    { pg8::Gemm g{H, WD + (size_t)D * FF, M, D, FF, FF, 0}; pg8::TailOrder ST; ST.init(FF, G, bx); EpiRes<false, true> E{nullptr, nullptr, XB, SSQ + 3 * M, PART}; pg8::gemm_phase(L, g, ST, E); }
    xcd_barrier(xbar);
    PH(13)
    { const float* ssq4 = SSQ + 3 * M; const f32x4* gf = (const f32x4*)a.in[I_NFIN];
      for (int m0 = gw; m0 < M; m0 += 2 * NGW) {
          const int m1 = (m0 + NGW < M) ? m0 + NGW : m0; const bool has1 = m0 + NGW < M;
          const u32x2* p0 = (const u32x2*)(XB + (size_t)m0 * D); const u32x2* p1 = (const u32x2*)(XB + (size_t)m1 * D); u32x2 r0[4], r1[4];
#pragma unroll
          for (int q = 0; q < 4; ++q) { r0[q] = __builtin_nontemporal_load(p0 + lane + 64 * q); r1[q] = __builtin_nontemporal_load(p1 + lane + 64 * q); }
#pragma unroll
          for (int rr = 0; rr < 2; ++rr) { if (rr == 1 && !has1) break; const int m = rr ? m1 : m0; f32x4 v[4]; float sq = 0.f;
#pragma unroll
              for (int q = 0; q < 4; ++q) v[q] = bf4(rr ? r1[q] : r0[q]);
              if (m >= MP) { const f32x4* pr = (const f32x4*)(PART + (size_t)(m - MP) * D);
#pragma unroll
                  for (int ks = 0; ks < 11; ++ks)
#pragma unroll
                      for (int q = 0; q < 4; ++q) v[q] = v[q] + __builtin_nontemporal_load(pr + (size_t)ks * (MS * D / 4) + lane + 64 * q); }
#pragma unroll
              for (int q = 0; q < 4; ++q) sq += (v[q][0] * v[q][0] + v[q][1] * v[q][1]) + (v[q][2] * v[q][2] + v[q][3] * v[q][3]);
              const float ss = (m >= MP) ? wave_sum(sq) : ssq4[m]; const float rs = rsqrtf(ss * (1.f / D) + EPS);
              f32x4* yo = (f32x4*)(out + OFF_Y + (size_t)m * D);
#pragma unroll
              for (int q = 0; q < 4; ++q) __builtin_nontemporal_store(v[q] * rs * gf[lane + 64 * q], yo + lane + 64 * q); } } }
}

#undef ws
#undef SSQ
#undef SUMA
#undef SUMH
#undef KB
#undef VT
#undef PART
#undef SPL
#undef WIN
#undef WG
#undef WOUT
#undef WGU
#undef WD
#undef WP
#undef XB
#undef QB
#undef GG
#undef UCB
#undef U
#undef AX
#undef AO
#undef H
extern "C" void kernel_launch(void* const* d_in, const int* in_sizes, int n_in, void* d_out, int out_size, void* d_ws, size_t ws_size, hipStream_t stream) {
    static int grid = 0;
    if (grid == 0) {
        if (n_in != 24 || out_size != (int)OUT_TOTAL || ws_size < WS_END) { fprintf(stderr, "kernel_launch: unexpected shapes (n_in %d out %d ws %zu)\n", n_in, out_size, ws_size); grid = -1; return; }
        int dev = 0, cus = 0, per_cu = 0;
        hipGetDevice(&dev); hipDeviceGetAttribute(&cus, hipDeviceAttributeMultiprocessorCount, dev);
        hipFuncSetAttribute((const void*)fwd_kernel, hipFuncAttributeMaxDynamicSharedMemorySize, LDS_BYTES);
        hipOccupancyMaxActiveBlocksPerMultiprocessor(&per_cu, (const void*)fwd_kernel, 512, LDS_BYTES);
        if (per_cu < 1) { fprintf(stderr, "kernel_launch: occupancy query says %d blocks/CU\n", per_cu); per_cu = 1; }
        (void)hipGetLastError();
        grid = cus * per_cu;
    }
    if (grid < 0) return;
    (void)hipMemsetAsync((char*)d_ws + WS_BAR, 0, 16384, stream);
    Args a{};
    for (int i = 0; i < 24; ++i) a.in[i] = (const float*)d_in[i];
    a.out = (float*)d_out; a.ws = (unsigned char*)d_ws;
    void* params[] = {&a};
    hipError_t e = hipLaunchCooperativeKernel((const void*)fwd_kernel, dim3(grid), dim3(512), params, LDS_BYTES, stream);
    if (e != hipSuccess) fprintf(stderr, "cooperative launch failed: %s (grid %d)\n", hipGetErrorString(e), grid);
}
```
